# Optimizing an MI355X kernel written in HIP

```python
import jax
import jax.numpy as jnp
from jax import lax
import numpy as np

D_MODEL = 1024
BATCH = 1
SEQ = 16384
DEPTH = 4

GRID_W = 64
CTX_LEN = 256
N_MIXERS = 3
RMS_EPS = 1e-6
ADA_CHUNKS = 6

D_RNN = D_MODEL
RG_BLOCK_W = 256
RG_BLOCKS = D_RNN // RG_BLOCK_W
CONV_WIDTH = 4
CONV_PAD = (2, 1)
LRU_C = 8.0

NA_HEAD_DIM = 64
NA_HEADS = D_MODEL // NA_HEAD_DIM
NA_ROWS_MAX = 8
NA_COLS = 16

FT_GROUPS = 4
FT_GROUP_W = D_MODEL // FT_GROUPS

D_FF = 7 * D_MODEL // 2
N_EXPERTS = 8
TOP_K = 2

kernel_name = "hybrid_rglru_natten_fnet_moe_dit"


def _layer_counts(depth):
    n_mix = [sum(1 for i in range(depth) if i % N_MIXERS == m) for m in range(N_MIXERS)]
    n_dense = sum(1 for i in range(depth) if i % 2 == 0)
    return n_mix, n_dense, depth - n_dense


def rmsnorm(x, g):
    xf = x.astype(jnp.float32)
    y = xf * lax.rsqrt(jnp.mean(xf * xf, axis=-1, keepdims=True) + RMS_EPS)
    return (y * g.astype(jnp.float32)).astype(x.dtype)


def dwconv_centred(z, w, b):
    y = lax.conv_general_dilated(z, w[:, None, :].astype(z.dtype), window_strides=(1,), padding=[CONV_PAD], dimension_numbers=("NWC", "WIO", "NWC"), feature_group_count=z.shape[-1])
    return y + b


def block_diag(z, w):
    bsz, length, _ = z.shape
    zb = z.reshape(bsz, length, RG_BLOCKS, RG_BLOCK_W)
    return jnp.einsum("blnc,ncd->blnd", zb, w).reshape(bsz, length, D_RNN)


def linear_scan(a, b, h0):
    def combine(p, q):
        return p[0] * q[0], q[0] * p[1] + q[1]
    a_cum, b_cum = lax.associative_scan(combine, (a, b), axis=1)
    return a_cum * h0[:, None, :] + b_cum


def rglru_coeffs(z, wa, ba, wi, bi, lam):
    zf = z.astype(jnp.float32)
    r = jax.nn.sigmoid(block_diag(zf, wa) + ba)
    i = jax.nn.sigmoid(block_diag(zf, wi) + bi)
    log_a = -LRU_C * r * jax.nn.softplus(-lam.astype(jnp.float32))
    a = jnp.exp(log_a)
    b = jnp.sqrt(-jnp.expm1(2.0 * log_a)) * (i * zf)
    return a, b


def rglru_mixer(h, hc, w_in, conv_w, conv_b, wa, ba, wi, bi, lam, w_out, need_ctx):
    def branches(z):
        xz, gz = jnp.split(z @ w_in, 2, axis=-1)
        return dwconv_centred(xz, conv_w, conv_b), gz
    xl, gl = branches(h)
    xc, gc = branches(hc)
    zeros = jnp.zeros((hc.shape[0], D_RNN), jnp.float32)
    hcf = linear_scan(*rglru_coeffs(xc, wa[0], ba[0], wi[0], bi[0], lam[0]), zeros)
    hlf = linear_scan(*rglru_coeffs(xl, wa[0], ba[0], wi[0], bi[0], lam[0]), hcf[:, -1])
    hcb = linear_scan(*rglru_coeffs(jnp.flip(xc, 1), wa[1], ba[1], wi[1], bi[1], lam[1]), zeros)
    hlb = jnp.flip(linear_scan(*rglru_coeffs(jnp.flip(xl, 1), wa[1], ba[1], wi[1], bi[1], lam[1]), hcb[:, -1]), 1)
    y = ((hlf + hlb).astype(h.dtype) * jax.nn.gelu(gl)) @ w_out
    yc = None
    if need_ctx:
        yc = ((hcf + jnp.flip(hcb, 1)).astype(h.dtype) * jax.nn.gelu(gc)) @ w_out
    return y, yc


def na_mixer(h, hc, w_qkv, q_g, k_g, rpb, w_o, need_ctx):
    bsz, seq, _ = h.shape
    rows = seq // GRID_W
    kr = min(NA_ROWS_MAX, rows)
    n_loc = kr * NA_COLS
    scale = NA_HEAD_DIM ** -0.5

    def proj(z):
        q, k, v = jnp.split(z @ w_qkv, 3, axis=-1)
        shp = z.shape[:2] + (NA_HEADS, NA_HEAD_DIM)
        return rmsnorm(q.reshape(shp), q_g), rmsnorm(k.reshape(shp), k_g), v.reshape(shp)

    q, k, v = proj(h)
    qc, kc, vc = proj(hc)
    grid = (bsz, rows, GRID_W, NA_HEADS, NA_HEAD_DIM)
    qg, kg, vg = q.reshape(grid), k.reshape(grid), v.reshape(grid)

    cols = np.arange(GRID_W)
    col_start = np.clip(cols - NA_COLS // 2, 0, GRID_W - NA_COLS)
    col_idx = col_start[:, None] + np.arange(NA_COLS)[None, :]
    col_bias_idx = col_idx - cols[:, None] + (NA_COLS - 1)

    def row_block(r):
        rs = jnp.clip(r - kr // 2, 0, rows - kr)
        qr = lax.dynamic_index_in_dim(qg, r, axis=1, keepdims=False)
        def gather(t):
            tw = lax.dynamic_slice_in_dim(t, rs, kr, axis=1)[:, :, col_idx]
            return tw.transpose(0, 2, 1, 3, 4, 5).reshape(bsz, GRID_W, n_loc, NA_HEADS, NA_HEAD_DIM)
        kw, vw = gather(kg), gather(vg)
        row_bias_idx = rs + jnp.arange(kr) - r + (NA_ROWS_MAX - 1)
        bias = rpb[:, row_bias_idx[:, None, None], col_bias_idx[None, :, :]]
        bias = bias.transpose(0, 2, 1, 3).reshape(NA_HEADS, GRID_W, n_loc).astype(jnp.float32)
        s_loc = jnp.einsum("bqhd,bqkhd->bhqk", qr, kw).astype(jnp.float32) * scale + bias
        s_ctx = jnp.einsum("bqhd,bkhd->bhqk", qr, kc).astype(jnp.float32) * scale
        p = jax.nn.softmax(jnp.concatenate([s_loc, s_ctx], axis=-1), axis=-1).astype(v.dtype)
        return (jnp.einsum("bhqk,bqkhd->bqhd", p[..., :n_loc], vw)
                + jnp.einsum("bhqk,bkhd->bqhd", p[..., n_loc:], vc))

    o = lax.map(row_block, jnp.arange(rows))
    y = o.transpose(1, 0, 2, 3, 4).reshape(bsz, seq, D_MODEL) @ w_o
    yc = None
    if need_ctx:
        s = jnp.einsum("bqhd,bkhd->bhqk", qc, kc).astype(jnp.float32) * scale
        p = jax.nn.softmax(s, axis=-1).astype(vc.dtype)
        oc = jnp.einsum("bhqk,bkhd->bqhd", p, vc)
        yc = oc.reshape(hc.shape[0], hc.shape[1], D_MODEL) @ w_o
    return y, yc


def fourier_mix(z, w_f):
    bsz, length, _ = z.shape
    zg = z.astype(jnp.float32).reshape(bsz, length, FT_GROUPS, FT_GROUP_W)
    f = jnp.fft.fft2(zg, axes=(1, 3), norm="ortho").real
    return f.reshape(bsz, length, D_MODEL).astype(z.dtype) @ w_f


def fourier_mixer(h, hc, w_f, need_ctx):
    return fourier_mix(h, w_f), (fourier_mix(hc, w_f) if need_ctx else None)


def swiglu(z, w_gu, w_down):
    g, u = jnp.split(z @ w_gu, 2, axis=-1)
    return (jax.nn.silu(g) * u) @ w_down


def moe_swiglu(z, router, w_gu, w_down):
    logits = (z @ router).astype(jnp.float32)
    top_v, top_i = lax.top_k(logits, TOP_K)
    wts = jax.nn.softmax(top_v, axis=-1)
    gates = jnp.sum(jax.nn.one_hot(top_i, N_EXPERTS, dtype=jnp.float32) * wts[..., None], axis=-2)
    out = jnp.zeros_like(z)
    for e in range(N_EXPERTS):
        out = out + gates[..., e:e + 1].astype(z.dtype) * swiglu(z, w_gu[e], w_down[e])
    return out


def setup_inputs(seed: int = 0) -> dict:
    key = jax.random.key(seed)
    ks = jax.random.split(key, 32)
    (n_a, n_b, n_c), n_dense, n_moe = _layer_counts(DEPTH)
    d = D_MODEL

    def nrm(k, shape, s):
        return jax.random.normal(k, shape, jnp.float32) * s

    u = jax.random.uniform(ks[11], (n_a, 2, D_RNN), jnp.float32, 0.9, 0.999)
    a0 = u ** (1.0 / LRU_C)
    rg_lambda = jnp.log(a0) - jnp.log1p(-a0)
    return {
        "x": nrm(ks[0], (BATCH, SEQ, d), 1.0),
        "c": nrm(ks[1], (BATCH, d), 1.0),
        "ctx": nrm(ks[2], (BATCH, CTX_LEN, d), 1.0),
        "c_ctx": nrm(ks[3], (d,), 1.0),
        "ada_w": nrm(ks[4], (DEPTH, d, ADA_CHUNKS * d), 0.5 * d ** -0.5),
        "ada_b": nrm(ks[5], (DEPTH, ADA_CHUNKS * d), 0.02),
        "norm_g": 1.0 + nrm(ks[6], (DEPTH, 2, d), 0.1),
        "rg_w_in": nrm(ks[7], (n_a, d, 2 * D_RNN), d ** -0.5),
        "rg_conv_w": nrm(ks[8], (n_a, CONV_WIDTH, D_RNN), CONV_WIDTH ** -0.5),
        "rg_conv_b": nrm(ks[9], (n_a, D_RNN), 0.02),
        "rg_wa": nrm(ks[10], (n_a, 2, RG_BLOCKS, RG_BLOCK_W, RG_BLOCK_W), RG_BLOCK_W ** -0.5),
        "rg_ba": nrm(ks[12], (n_a, 2, D_RNN), 0.02),
        "rg_wi": nrm(ks[13], (n_a, 2, RG_BLOCKS, RG_BLOCK_W, RG_BLOCK_W), RG_BLOCK_W ** -0.5),
        "rg_bi": nrm(ks[14], (n_a, 2, D_RNN), 0.02),
        "rg_lambda": rg_lambda,
        "rg_w_out": nrm(ks[15], (n_a, D_RNN, d), D_RNN ** -0.5),
        "na_w_qkv": nrm(ks[16], (n_b, d, 3 * d), d ** -0.5),
        "na_q_g": 1.0 + nrm(ks[17], (n_b, NA_HEAD_DIM), 0.1),
        "na_k_g": 1.0 + nrm(ks[18], (n_b, NA_HEAD_DIM), 0.1),
        "na_rpb": nrm(ks[19], (n_b, NA_HEADS, 2 * NA_ROWS_MAX - 1, 2 * NA_COLS - 1), 0.1),
        "na_w_o": nrm(ks[20], (n_b, d, d), d ** -0.5),
        "ft_w_out": nrm(ks[21], (n_c, d, d), d ** -0.5),
        "ffn_w_gu": nrm(ks[22], (n_dense, d, 2 * D_FF), d ** -0.5),
        "ffn_w_down": nrm(ks[23], (n_dense, D_FF, d), D_FF ** -0.5),
        "moe_router": nrm(ks[24], (n_moe, d, N_EXPERTS), d ** -0.5),
        "moe_w_gu": nrm(ks[25], (n_moe, N_EXPERTS, d, 2 * D_FF), d ** -0.5),
        "moe_w_down": nrm(ks[26], (n_moe, N_EXPERTS, D_FF, d), D_FF ** -0.5),
    }


def reference(x, c, ctx, c_ctx, ada_w, ada_b, norm_g, rg_w_in, rg_conv_w, rg_conv_b, rg_wa, rg_ba, rg_wi, rg_bi, rg_lambda, rg_w_out, na_w_qkv, na_q_g, na_k_g, na_rpb, na_w_o, ft_w_out, ffn_w_gu, ffn_w_down, moe_router, moe_w_gu, moe_w_down):
    xc = ctx
    silu_c = jax.nn.silu(c)
    silu_cc = jax.nn.silu(c_ctx)
    mix_idx = [0] * N_MIXERS
    dense_idx = 0
    moe_idx = 0
    for layer in range(DEPTH):
        last = layer == DEPTH - 1
        need_ctx = not last
        m = [t[:, None, :] for t in jnp.split(silu_c @ ada_w[layer] + ada_b[layer], ADA_CHUNKS, axis=-1)]
        mc = jnp.split(silu_cc @ ada_w[layer] + ada_b[layer], ADA_CHUNKS, axis=-1)
        h = rmsnorm(x, norm_g[layer, 0]) * (1.0 + m[1]) + m[0]
        hc = rmsnorm(xc, norm_g[layer, 0]) * (1.0 + mc[1]) + mc[0]
        kind = layer % N_MIXERS
        j = mix_idx[kind]
        mix_idx[kind] += 1
        if kind == 0:
            y, yc = rglru_mixer(h, hc, rg_w_in[j], rg_conv_w[j], rg_conv_b[j], rg_wa[j], rg_ba[j], rg_wi[j], rg_bi[j], rg_lambda[j], rg_w_out[j], need_ctx)
        elif kind == 1:
            y, yc = na_mixer(h, hc, na_w_qkv[j], na_q_g[j], na_k_g[j], na_rpb[j], na_w_o[j], need_ctx)
        else:
            y, yc = fourier_mixer(h, hc, ft_w_out[j], need_ctx)
        x = x + m[2] * y
        if need_ctx:
            xc = xc + mc[2] * yc
        h = rmsnorm(x, norm_g[layer, 1]) * (1.0 + m[4]) + m[3]
        if layer % 2 == 0:
            f = swiglu(h, ffn_w_gu[dense_idx], ffn_w_down[dense_idx])
            if need_ctx:
                hc = rmsnorm(xc, norm_g[layer, 1]) * (1.0 + mc[4]) + mc[3]
                xc = xc + mc[5] * swiglu(hc, ffn_w_gu[dense_idx], ffn_w_down[dense_idx])
            dense_idx += 1
        else:
            f = moe_swiglu(h, moe_router[moe_idx], moe_w_gu[moe_idx], moe_w_down[moe_idx])
            if need_ctx:
                hc = rmsnorm(xc, norm_g[layer, 1]) * (1.0 + mc[4]) + mc[3]
                xc = xc + mc[5] * moe_swiglu(hc, moe_router[moe_idx], moe_w_gu[moe_idx], moe_w_down[moe_idx])
            moe_idx += 1
        x = x + m[5] * f
    return x
```

```cpp
#ifndef REP_GU
#define REP_GU 1
#endif
#ifndef REP_NORM
#define REP_NORM 1
#endif
#ifndef REP_OG
#define REP_OG 1
#endif
#ifndef REP_MDN
#define REP_MDN 1
#endif
#ifndef REP_P0
#define REP_P0 1
#endif
#ifndef REP_SYNC
#define REP_SYNC 1
#endif
#ifndef REP_SCAN
#define REP_SCAN 1
#endif
#ifndef REP_ATT
#define REP_ATT 1
#endif
#ifndef REP_SK
#define REP_SK 1
#endif
#include <hip/hip_runtime.h>
#include <hip/hip_cooperative_groups.h>
#include <cstdio>
#include <cstdint>
#include <cstring>
namespace cg = cooperative_groups;

typedef unsigned short bf16_t;
typedef short bf16x8 __attribute__((ext_vector_type(8)));
typedef short s16x4 __attribute__((ext_vector_type(4)));
typedef float f32x4 __attribute__((ext_vector_type(4)));
typedef unsigned u32x4 __attribute__((ext_vector_type(4)));
#define DI __device__ __forceinline__
#define MFMA16(a, b, c) __builtin_amdgcn_mfma_f32_16x16x32_bf16((a), (b), (c), 0, 0, 0)

constexpr int S = 16384, CT = 256, R = S + CT, D = 1024, FF = 3584, NE = 8;
constexpr int NCH = 130;
constexpr int ACT_ROWS = 2 * R + NE * 256;

constexpr size_t al(size_t x) { return (x + 255) & ~(size_t)255; }
constexpr size_t W_RGIN = 0;
constexpr size_t W_GATE = W_RGIN + al((size_t)2 * 2048 * 1024 * 2);
constexpr size_t W_RGOUT = W_GATE + al((size_t)2 * 4096 * 256 * 2);
constexpr size_t W_QKV = W_RGOUT + al((size_t)2 * 1024 * 1024 * 2);
constexpr size_t W_O = W_QKV + al((size_t)3072 * 1024 * 2);
constexpr size_t W_FT = W_O + al((size_t)1024 * 1024 * 2);
constexpr size_t W_FGU = W_FT + al((size_t)1024 * 1024 * 2);
constexpr size_t W_FDN = W_FGU + al((size_t)2 * 7168 * 1024 * 2);
constexpr size_t W_MGU = W_FDN + al((size_t)2 * 1024 * 3584 * 2);
constexpr size_t W_MDN = W_MGU + al((size_t)16 * 7168 * 1024 * 2);
constexpr size_t W_BC = W_MDN + al((size_t)16 * 1024 * 3584 * 2);
constexpr size_t W_D1 = W_BC + al((size_t)512 * 256 * 2);
constexpr size_t W_D3 = W_D1 + al((size_t)256 * 256 * 2);
constexpr size_t W_DC = W_D3 + al((size_t)128 * 256 * 2);
constexpr size_t O_MOD = W_DC + al((size_t)256 * 512 * 2);
constexpr size_t O_XC = O_MOD + al((size_t)4 * 2 * 6144 * 4);
constexpr size_t O_CNT = O_XC + al((size_t)CT * D * 4);
constexpr size_t O_LIST = O_CNT + al(256);
constexpr size_t O_LW = O_LIST + al((size_t)2 * NE * R * 4);
constexpr size_t O_BAR = O_LW + al((size_t)2 * NE * R * 4);
constexpr size_t O_ROUTE = O_BAR + al(16384);
constexpr size_t O_RW = O_ROUTE + al((size_t)R * 4);
constexpr size_t O_H = O_RW + al((size_t)R * 8);
constexpr size_t O_ACT = O_H + al((size_t)R * D * 2);
constexpr size_t O_MIX = O_ACT + al((size_t)ACT_ROWS * FF * 2);
constexpr size_t RB = (size_t)R * D * 2;
constexpr size_t M_XZ = O_MIX, M_GG = M_XZ + al(RB), M_XL = M_GG + al(RB), M_LA = M_XL + al(RB), M_IX = M_LA + al(2 * RB),
                 M_TMP = M_IX + al(2 * RB), M_YIN = M_TMP + al(2 * RB), M_CA = M_YIN + al(RB), M_CB = M_CA + al((size_t)2 * 260 * D * 4),
                 M_END_RG = M_CB + al((size_t)2 * 260 * D * 4);
constexpr size_t M_Y = O_MIX;
constexpr size_t M_Q = O_MIX, M_K = M_Q + al(RB), M_VT = M_K + al(RB), M_O = M_VT + al(RB);
constexpr size_t M_UT = O_MIX, M_UTC = M_UT + al((size_t)S * 2048 * 2), M_AT = M_UTC + al((size_t)CT * 2048 * 2), M_F = M_AT + al((size_t)S * 2048 * 2);

struct Job { const float* src; bf16_t* dst; int K, N, nb, tiles; long long ss, ds; };
constexpr int NJOB = 24;
struct Prm {
  const float *x, *c, *ctx, *cctx, *ada_w, *ada_b, *norm_g, *conv_w, *conv_b, *rg_ba, *rg_bi, *rg_lam, *na_qg, *na_kg, *na_rpb, *router;
  float* out; unsigned char* ws;
  Job jobs[NJOB]; int njob; int never;
};

DI int otid() { int t = threadIdx.x; asm volatile("" : "+v"(t)); return t; }
DI int obid() { int t = blockIdx.x; asm volatile("" : "+s"(t)); return t; }
DI int ogrid() { int t = gridDim.x; asm volatile("" : "+s"(t)); return t; }
DI bf16_t f2bf(float x) { unsigned u = __float_as_uint(x); u += 0x7fffu + ((u >> 16) & 1u); return (bf16_t)(u >> 16); }
DI float bf2f(bf16_t h) { return __uint_as_float(((unsigned)h) << 16); }
DI unsigned pack2(float a, float b) { return (unsigned)f2bf(a) | ((unsigned)f2bf(b) << 16); }
DI uint2 pack4(f32x4 v) { return make_uint2(pack2(v[0], v[1]), pack2(v[2], v[3])); }
DI void unpack4(uint2 v, float* o) { o[0] = __uint_as_float(v.x << 16); o[1] = __uint_as_float(v.x & 0xffff0000u); o[2] = __uint_as_float(v.y << 16); o[3] = __uint_as_float(v.y & 0xffff0000u); }
DI int perm8(int r) { return (r & ~31) + ((r >> 2) & 3) * 8 + ((r >> 4) & 1) * 4 + (r & 3); }
DI uint4 pack8(f32x4 a, f32x4 b) { const uint2 x = pack4(a), y = pack4(b); return make_uint4(x.x, x.y, y.x, y.y); }
DI float sigm(float v) { return 1.f / (1.f + __expf(-v)); }
DI float siluf(float v) { return v / (1.f + __expf(-v)); }
DI float gelut(float v) { float u = 0.7978845608f * (v + 0.044715f * v * v * v); float t = 1.f - 2.f / (__expf(2.f * u) + 1.f); return 0.5f * v * (1.f + t); }
DI float softplus_neg(float lam) { const float x = __expf(-lam); return x < 0.05f ? x * (1.f - x * (0.5f - x * (1.f / 3.f - 0.25f * x))) : __logf(1.f + x); }
DI void sincos_rev(float rev, float* s, float* c) { *s = __builtin_amdgcn_sinf(rev); *c = __builtin_amdgcn_cosf(rev); }
DI float wsum(float v) { for (int o = 32; o; o >>= 1) v += __shfl_xor(v, o); return v; }
DI const float* xrow_in(const Prm& p, int r) { return r < S ? p.x + (size_t)r * D : p.ctx + (size_t)(r - S) * D; }
DI float* xrow(const Prm& p, int r) { return r < S ? p.out + (size_t)r * D : (float*)(p.ws + O_XC) + (size_t)(r - S) * D; }

constexpr int NTHR = 512;
constexpr int LDSS = 72;
constexpr int SMEM_BYTES = 2 * 512 * LDSS * 2;
constexpr int CV_P0 = 1024, CV_L0_IN = 4024, CV_L0_GATES = 5024, CV_L0_OUT = 5324, CV_L0_GU = 8824, CV_L0_DN = 9124, CV_L1_QKV = 14324, CV_L1_O = 19072,
              CV_L1_MGU = 26240, CV_L1_MDN = 42240, CV_L2_GU = 45740, CV_L2_DN = 46040, CV_L3_IN = 49040, CV_L3_GATES = 50040, CV_L3_OUT = 51712, CV_TOTAL = 51712;
__shared__ Job g_jobs_s[NJOB];
#define g_jobs ((const Job*)g_jobs_s)
struct CvTile { const float* src; bf16_t* dst; int N, K, valid, pad; };
DI CvTile cv_tile(const Job* jobs, int t, int c0, int c1) {
  CvTile r; r.valid = t < c1; r.pad = 0;
  int j = 0, tt = r.valid ? t : c0;
  while (tt >= jobs[j].tiles) { tt -= jobs[j].tiles; ++j; }
  const Job jb = jobs[j];
  const int tk = jb.K >> 6, tn = jb.N >> 6, per = tk * tn;
  const int bi = tt / per, rr = tt % per, kt = rr % tk, nt = rr / tk;
  r.src = jb.src + (size_t)bi * jb.ss + (size_t)(kt * 64) * jb.N + nt * 64;
  r.dst = jb.dst + (size_t)bi * jb.ds + (size_t)(nt * 64) * jb.K + kt * 64;
  r.N = jb.N; r.K = jb.K;
  return r;
}
DI void conv_range(const Prm& p, int c0, int c1, bf16_t* smraw, int widx = -1, int wn = 0) {
  if (c0 >= c1) return;
  const int tid = otid(), G = widx < 0 ? ogrid() : wn, b = widx < 0 ? obid() : widx;
  float* smf = (float*)smraw;
  const int half = tid >> 8, vt = tid & 255;
  float* smh = smf + half * (64 * 65);
  const int kr = vt >> 4, nc = (vt & 15) * 4;
  int t0 = c0 + b * 2;
  if (t0 >= c1) { __syncthreads(); return; }
  CvTile cur = cv_tile(g_jobs, t0 + half, c0, c1);
  float4 v[4];
#pragma unroll
  for (int i = 0; i < 4; ++i) v[i] = *(const float4*)(cur.src + (size_t)(kr + 16 * i) * cur.N + nc);
  for (; t0 < c1; t0 += 2 * G) {
    const bool more = t0 + 2 * G < c1;
    CvTile nx = cur; float4 vn[4];
    if (more) {
      nx = cv_tile(g_jobs, t0 + 2 * G + half, c0, c1);
#pragma unroll
      for (int i = 0; i < 4; ++i) vn[i] = *(const float4*)(nx.src + (size_t)(kr + 16 * i) * nx.N + nc);
    }
    __syncthreads();
#pragma unroll
    for (int i = 0; i < 4; ++i) { float* d = smh + (kr + 16 * i) * 65 + nc; d[0] = v[i].x; d[1] = v[i].y; d[2] = v[i].z; d[3] = v[i].w; }
    __syncthreads();
    if (cur.valid) {
      const int n = vt >> 2, kp = (vt & 3) * 16;
      unsigned o[8];
#pragma unroll
      for (int q = 0; q < 8; ++q) o[q] = pack2(smh[(kp + 2 * q) * 65 + n], smh[(kp + 2 * q + 1) * 65 + n]);
      uint4* d4 = (uint4*)(cur.dst + (size_t)n * cur.K + kp);
      d4[0] = make_uint4(o[0], o[1], o[2], o[3]); d4[1] = make_uint4(o[4], o[5], o[6], o[7]);
    }
    if (more) {
      cur = nx;
#pragma unroll
      for (int i = 0; i < 4; ++i) v[i] = vn[i];
    }
  }
  __syncthreads();
}

template <bool NAT, int MI, int WM, int WN, class F>
DI void gemm_stream(int MT, int NT, int K, bf16_t* sm, const void* gbase, F f, const Prm* cvp = nullptr, int cv0 = 0, int cv1 = 0, int lo = 0, int hi = -1, int SUB = 1) {
  constexpr int BM = WM * MI * 16, BN = WN * 64, AR = BM / 64, BR = BN / 64, STG = (BM + BN) * LDSS;
  static_assert(WM * WN == 8, "8 waves");
  const int G = ogrid(), b = obid(), nbx = G >> 3, xcd = b & 7, li = b >> 3;
  if (hi < 0) hi = MT * NT;
  const int T = (hi - lo) * SUB;
  const int full = NT >> 3, wl = NT & 7, gsz = MT * 8;
  const int start = (int)(((long long)T * xcd) >> 3) + li, end = (int)(((long long)T * (xcd + 1)) >> 3);
  const int ntb = start < end ? (end - start + nbx - 1) / nbx : 0;
  if (ntb > 0) {
  auto tile_at = [&](int j, int& mt, int& nt) {
    const int item = start + j * nbx, idx = lo + item / SUB, sb = item % SUB, g = idx / gsz;
    if (g < full) { const int rem = idx - g * gsz; mt = rem >> 3; nt = g * 8 + (rem & 7); }
    else { const int rem = idx - full * gsz; mt = rem / wl; nt = full * 8 + rem % wl; }
    if (SUB == 8) { mt = mt * 4 + (sb >> 1); nt = nt * 2 + (sb & 1); }
  };
  const int tid = otid(), lane = tid & 63, wid = tid >> 6, wm = wid / WN, wn = wid % WN;
  const int lr = tid >> 3, lc = (tid & 7) * 8;
  const char* const gb = (const char*)gbase;
  unsigned ap[AR], bp[BR];
  auto set_offs = [&](int j) {
    int mt, nt; tile_at(j, mt, nt);
    f(mt, nt, [&](auto&& a, auto&& bfn, auto&& ep) {
#pragma unroll
      for (int i = 0; i < AR; ++i) ap[i] = (unsigned)((const char*)a(lr + 64 * i) - gb) + lc * 2;
#pragma unroll
      for (int i = 0; i < BR; ++i) bp[i] = (unsigned)((const char*)bfn(lr + 64 * i) - gb) + lc * 2;
    });
  };
  u32x4 ra[AR], rb[BR];
  f32x4 acc[MI][4];
#pragma unroll
  for (int i = 0; i < MI; ++i)
#pragma unroll
    for (int j = 0; j < 4; ++j) acc[i][j] = (f32x4){0.f, 0.f, 0.f, 0.f};
  const int nk = K / 64, Q = ntb * nk;
  const int fro = (lane & 15) * LDSS + (lane >> 4) * 8;
  set_offs(0);
#pragma unroll
  for (int i = 0; i < AR; ++i) ra[i] = *(const u32x4*)(gb + ap[i]);
#pragma unroll
  for (int i = 0; i < BR; ++i) rb[i] = *(const u32x4*)(gb + bp[i]);
#pragma unroll
  for (int i = 0; i < AR; ++i) *(u32x4*)(sm + (lr + 64 * i) * LDSS + lc) = ra[i];
#pragma unroll
  for (int i = 0; i < BR; ++i) *(u32x4*)(sm + BM * LDSS + (lr + 64 * i) * LDSS + lc) = rb[i];
#pragma unroll
  for (int i = 0; i < AR; ++i) ra[i] = *(const u32x4*)(gb + 128 + ap[i]);
#pragma unroll
  for (int i = 0; i < BR; ++i) rb[i] = *(const u32x4*)(gb + 128 + bp[i]);
  __syncthreads();
  int kt = 0, jt = 0;
  for (int q = 0; q < Q; ++q) {
    bf16_t* sA = sm + (q & 1) * STG; bf16_t* sB = sA + BM * LDSS;
    constexpr int FA = MI < 4 ? MI : 4, HG = MI / FA, NG = 2 * HG;
    bf16x8 fb[2][4], fa[2][FA];
    const bf16_t* pA = sA + (wm * MI * 16) * LDSS + fro; const bf16_t* pB = sB + (wn * 64) * LDSS + fro;
#pragma unroll
    for (int j = 0; j < 4; ++j) fb[0][j] = *(const bf16x8*)(pB + (j * 16) * LDSS);
#pragma unroll
    for (int i = 0; i < FA; ++i) fa[0][i] = *(const bf16x8*)(pA + (i * 16) * LDSS);
    __builtin_amdgcn_sched_barrier(0);
    if (q + 1 < Q) {
      bf16_t* nA = sm + ((q + 1) & 1) * STG; bf16_t* nB = nA + BM * LDSS;
#pragma unroll
      for (int i = 0; i < AR; ++i) *(u32x4*)(nA + (lr + 64 * i) * LDSS + lc) = ra[i];
#pragma unroll
      for (int i = 0; i < BR; ++i) *(u32x4*)(nB + (lr + 64 * i) * LDSS + lc) = rb[i];
    }
    if (q + 2 < Q) {
      int kt2 = kt + 2;
      if (kt2 >= nk) { kt2 -= nk; if (kt2 == 0) set_offs(jt + 1); }
      const char* gk = gb + kt2 * 128;
#pragma unroll
      for (int i = 0; i < AR; ++i) ra[i] = *(const u32x4*)(gk + ap[i]);
#pragma unroll
      for (int i = 0; i < BR; ++i) rb[i] = *(const u32x4*)(gk + bp[i]);
    }
    __builtin_amdgcn_sched_barrier(0);
    {
#pragma unroll
      for (int gi = 0; gi < NG; ++gi) {
        const int ks = gi / HG;
        if (gi + 1 < NG) {
          const int ks1 = (gi + 1) / HG, h1 = (gi + 1) % HG;
          if (ks1 != ks) {
#pragma unroll
            for (int j = 0; j < 4; ++j) fb[ks1 & 1][j] = *(const bf16x8*)(pB + (j * 16) * LDSS + ks1 * 32);
          }
#pragma unroll
          for (int i = 0; i < FA; ++i) fa[(gi + 1) & 1][i] = *(const bf16x8*)(pA + ((h1 * FA + i) * 16) * LDSS + ks1 * 32);
        }
        const int h = gi % HG;
#pragma unroll
        for (int i = 0; i < FA; ++i)
#pragma unroll
          for (int j = 0; j < 4; ++j)
            acc[h * FA + i][j] = NAT ? MFMA16(fa[gi & 1][i], fb[ks & 1][j], acc[h * FA + i][j]) : MFMA16(fb[ks & 1][j], fa[gi & 1][i], acc[h * FA + i][j]);
        __builtin_amdgcn_sched_barrier(0);
      }
    }
    if (kt == nk - 1) {
      int mt, nt; tile_at(jt, mt, nt);
      f(mt, nt, [&](auto&& a, auto&& bfn, auto&& ep) { ep(acc, wm, wn, lane); });
#pragma unroll
      for (int i = 0; i < MI; ++i)
#pragma unroll
        for (int j = 0; j < 4; ++j) acc[i][j] = (f32x4){0.f, 0.f, 0.f, 0.f};
      kt = 0; ++jt;
    } else ++kt;
    __syncthreads();
  }
  }
  if (cvp && cv0 < cv1) {
    int n_idle = 0, my_idx = -1;
#pragma unroll
    for (int x = 0; x < 8; ++x) {
      const int sx = (int)(((long long)T * x) >> 3), ex = (int)(((long long)T * (x + 1)) >> 3), rem = (ex - sx) % nbx;
      if (rem) { if (x == xcd && li >= rem) my_idx = n_idle + (li - rem); n_idle += nbx - rem; }
    }
    if (n_idle == 0) conv_range(*cvp, cv0, cv1, sm);
    else if (my_idx >= 0) conv_range(*cvp, cv0, cv1, sm, my_idx, n_idle);
  }
}

template <bool NAT, class FB, class FS>
DI void gemm_split(bool split, int MT, int NT, int K, bf16_t* sm, const void* gbase, FB fb, FS fs, const Prm* cvp = nullptr, int cv0 = 0, int cv1 = 0) {
  if (!split) { gemm_stream<NAT, 8, 2, 4>(MT, NT, K, sm, gbase, fb, cvp, cv0, cv1); return; }
  const int T = MT * NT, G = ogrid(), tfull = (T / G) * G;
  if (tfull > 0) gemm_stream<NAT, 8, 2, 4>(MT, NT, K, sm, gbase, fb, nullptr, 0, 0, 0, tfull, 1);
  if (tfull < T) gemm_stream<NAT, 1, 4, 2>(MT, NT, K, sm, gbase, fs, cvp, cv0, cv1, tfull, T, 8);
  else if (cvp && cv0 < cv1) conv_range(*cvp, cv0, cv1, sm);
}

DI int ileave(int pc, int half) { const int q = pc >> 6, w = pc & 63; return (w < 32) ? q * 32 + w : half + q * 32 + (w - 32); }
DI int ileave8(int pc, int half) { const int q = pc >> 6, w = pc & 63, c = w & 31, j = c >> 4, g = (c >> 2) & 3, e = c & 3; return (w < 32 ? 0 : half) + q * 32 + 8 * g + 4 * j + e; }

DI void phase0(const Prm& p, bf16_t* smraw) {
  const int tid = otid(), G = ogrid(), b = obid();
  float* smf = (float*)smraw;
  for (int u = b; u < 384; u += G) {
    const int l = u / 96, cg0 = (u % 96) * 64, kq = tid >> 4, cq = tid & 15;
    const float* w = p.ada_w + ((size_t)l * 1024 + kq * 32) * 6144 + cg0 + cq * 4;
    float4 a0 = make_float4(0, 0, 0, 0), a1 = a0;
#pragma unroll 8
    for (int k = 0; k < 32; ++k) {
      const float4 wv = *(const float4*)(w + (size_t)k * 6144);
      const float s0 = siluf(p.c[kq * 32 + k]), s1 = siluf(p.cctx[kq * 32 + k]);
      a0.x += s0 * wv.x; a0.y += s0 * wv.y; a0.z += s0 * wv.z; a0.w += s0 * wv.w;
      a1.x += s1 * wv.x; a1.y += s1 * wv.y; a1.z += s1 * wv.z; a1.w += s1 * wv.w;
    }
    __syncthreads();
    *(float4*)(smf + (kq * 16 + cq) * 8) = a0; *(float4*)(smf + (kq * 16 + cq) * 8 + 4) = a1;
    __syncthreads();
    if (tid < 128) {
      const int wsel = tid >> 6, col = tid & 63; float s = 0.f;
      for (int q = 0; q < 32; ++q) s += smf[(q * 16 + (col >> 2)) * 8 + wsel * 4 + (col & 3)];
      float* mod = (float*)(p.ws + O_MOD);
      mod[(size_t)(l * 2 + wsel) * 6144 + cg0 + col] = s + p.ada_b[(size_t)l * 6144 + cg0 + col];
    }
    __syncthreads();
  }
  if (b == G - 1 && tid < 64) ((int*)(p.ws + O_CNT))[tid] = 0;
  {
    const int gt = b * NTHR + tid, gn = G * NTHR;
    bf16_t* Bc = (bf16_t*)(p.ws + W_BC); bf16_t* D1 = (bf16_t*)(p.ws + W_D1); bf16_t* D3 = (bf16_t*)(p.ws + W_D3); bf16_t* Dc = (bf16_t*)(p.ws + W_DC);
    for (int e = gt; e < 512 * 256; e += gn) { const int rr = e >> 8, c = e & 255, ri = rr >> 8, m = rr & 255; float sn, cs; sincos_rev((float)((m * c) & 255) / 256.f, &sn, &cs); Bc[e] = f2bf((ri ? -sn : cs) * 0.0625f); }
    for (int e = gt; e < 256 * 256; e += gn) { const int rr = e >> 8, c = e & 255, ri = rr >> 7, k1 = rr & 127, ri2 = c >> 7, t1 = c & 127; float sn, cs; sincos_rev((float)((k1 * t1) & 127) / 128.f, &sn, &cs);
      const float v = (ri == ri2) ? cs : (ri == 0 ? sn : -sn); D1[e] = f2bf(v * 0.08838834764831845f); }
    for (int e = gt; e < 128 * 256; e += gn) { const int k2 = e >> 8, c = e & 255, ri = c >> 7, t2 = c & 127; float sn, cs; sincos_rev((float)((k2 * t2) & 127) / 128.f, &sn, &cs); D3[e] = f2bf((ri ? sn : cs) * 0.08838834764831845f); }
    for (int e = gt; e < 256 * 512; e += gn) { const int k = e >> 9, c = e & 511, ri = c >> 8, t = c & 255; float sn, cs; sincos_rev((float)((k * t) & 255) / 256.f, &sn, &cs); Dc[e] = f2bf((ri ? sn : cs) * 0.0625f); }
  }
  conv_range(p, 0, CV_P0, smraw);
}

DI void norm_phase(const Prm& p, int l, int which, int moe_idx, bf16_t* smraw, int comb_l = -1) {
  const int lane = otid() & 63, wv = obid() * 8 + (otid() >> 6), nw = ogrid() * 8;
  const float* g = p.norm_g + (size_t)(l * 2 + which) * D;
  const float* mod = (const float*)(p.ws + O_MOD);
  bf16_t* H = (bf16_t*)(p.ws + O_H);
  float* rts = (float*)smraw;
  if (moe_idx >= 0) {
    const float4* rsrc = (const float4*)(p.router + (size_t)moe_idx * D * NE);
    for (int e = otid(); e < D * NE / 4; e += NTHR) ((float4*)rts)[e] = rsrc[e];
    __syncthreads();
  }
  f32x4 gs0[4], sv0[4];
  {
    const float* sh = mod + (size_t)(l * 2) * 6144 + (which ? 3 : 0) * D; const float* sc = mod + (size_t)(l * 2) * 6144 + (which ? 4 : 1) * D;
#pragma unroll
    for (int i = 0; i < 4; ++i) {
      const int col = i * 256 + lane * 4;
      const float4 g4 = *(const float4*)(g + col), s4 = *(const float4*)(sc + col);
      gs0[i] = (f32x4){g4.x * (1.f + s4.x), g4.y * (1.f + s4.y), g4.z * (1.f + s4.z), g4.w * (1.f + s4.w)}; sv0[i] = *(const f32x4*)(sh + col);
    }
  }
  const bf16_t* Ycmb = (const bf16_t*)(p.ws + M_Y);
  auto load_row = [&](int r, f32x4 (&dst)[4]) {
    const float* xr = (l == 0 && which == 0) ? xrow_in(p, r) : (const float*)xrow(p, r);
#pragma unroll
    for (int i = 0; i < 4; ++i) dst[i] = *(const f32x4*)(xr + i * 256 + lane * 4);
    if (comb_l >= 0) {
      const float* g5 = mod + (size_t)(comb_l * 2 + (r >= S ? 1 : 0)) * 6144 + 5 * D;
#pragma unroll
      for (int i = 0; i < 4; ++i) {
        const int col = i * 256 + lane * 4;
        const uint2 u0 = *(const uint2*)(Ycmb + (size_t)(2 * r) * D + col), u1 = *(const uint2*)(Ycmb + (size_t)(2 * r + 1) * D + col);
        float a0[4], a1[4]; unpack4(u0, a0); unpack4(u1, a1);
        const f32x4 ys = {a0[0] + a1[0], a0[1] + a1[1], a0[2] + a1[2], a0[3] + a1[3]};
        dst[i] += *(const f32x4*)(g5 + col) * ys;
      }
    }
  };
  f32x4 v[4];
  if (wv < R) load_row(wv, v);
  for (int r = wv; r < R; r += nw) {
    f32x4 vn[4];
    const bool more = r + nw < R;
    if (more) load_row(r + nw, vn);
    if (comb_l >= 0) {
      float* xw = xrow(p, r);
#pragma unroll
      for (int i = 0; i < 4; ++i) *(f32x4*)(xw + i * 256 + lane * 4) = v[i];
    }
    float ss = 0.f;
#pragma unroll
    for (int i = 0; i < 4; ++i) ss += v[i][0] * v[i][0] + v[i][1] * v[i][1] + v[i][2] * v[i][2] + v[i][3] * v[i][3];
    ss = wsum(ss);
    const float rstd = rsqrtf(ss * (1.f / 1024.f) + 1e-6f);
    float lg[8];
#pragma unroll
    for (int e = 0; e < 8; ++e) lg[e] = 0.f;
#pragma unroll
    for (int i = 0; i < 4; ++i) {
      const int col = i * 256 + lane * 4;
      f32x4 gs = gs0[i], sv = sv0[i];
      if (r >= S) {
        const float* md = mod + (size_t)(l * 2 + 1) * 6144;
        const float4 g4 = *(const float4*)(g + col), s4 = *(const float4*)(md + (which ? 4 : 1) * D + col);
        gs = (f32x4){g4.x * (1.f + s4.x), g4.y * (1.f + s4.y), g4.z * (1.f + s4.z), g4.w * (1.f + s4.w)}; sv = *(const f32x4*)(md + (which ? 3 : 0) * D + col);
      }
      f32x4 h;
      h = v[i] * rstd * gs + sv;
      *(uint2*)(H + (size_t)r * D + col) = pack4(h);
      if (moe_idx >= 0) {
        const float* rt = rts + (size_t)col * NE;
#pragma unroll
        for (int q = 0; q < 4; ++q) {
          const float4 r0 = *(const float4*)(rt + q * 8), r1 = *(const float4*)(rt + q * 8 + 4);
          lg[0] += h[q] * r0.x; lg[1] += h[q] * r0.y; lg[2] += h[q] * r0.z; lg[3] += h[q] * r0.w;
          lg[4] += h[q] * r1.x; lg[5] += h[q] * r1.y; lg[6] += h[q] * r1.z; lg[7] += h[q] * r1.w;
        }
      }
    }
    if (moe_idx >= 0) {
#pragma unroll
      for (int e = 0; e < 8; ++e) lg[e] = wsum(lg[e]);
      if (lane == 0) {
        int i0 = 0; float v0 = lg[0];
#pragma unroll
        for (int e = 1; e < 8; ++e) if (lg[e] > v0) { v0 = lg[e]; i0 = e; }
        int i1 = -1; float v1 = -3.0e38f;
#pragma unroll
        for (int e = 0; e < 8; ++e) if (e != i0 && lg[e] > v1) { v1 = lg[e]; i1 = e; }
        const float w0 = 1.f / (1.f + __expf(v1 - v0)), w1 = 1.f - w0;
        ((int*)(p.ws + O_ROUTE))[r] = i0 | (i1 << 8); ((float2*)(p.ws + O_RW))[r] = make_float2(w0, w1);
      }
    }
    if (more) {
#pragma unroll
      for (int i = 0; i < 4; ++i) v[i] = vn[i];
    }
  }
}

template <int MI, int BM, int BN, class ACC>
DI void resid_epi(const Prm& p, ACC& acc, int row0, int col0, int l, int gchunk, int lane) {
  const float* mod = (const float*)(p.ws + O_MOD);
#pragma unroll
  for (int i = 0; i < MI; ++i) {
    const int row = row0 + i * 16 + (lane & 15);
    float* xr = xrow(p, row);
    const float* xs = (l == 0 && gchunk == 2) ? xrow_in(p, row) : (const float*)xr;
    const float* gt = mod + (size_t)(l * 2 + (row >= S ? 1 : 0)) * 6144 + gchunk * D;
#pragma unroll
    for (int j = 0; j < 4; ++j) {
      const int col = col0 + j * 16 + 4 * (lane >> 4);
      const float4 g4 = *(const float4*)(gt + col); float4 xv = *(const float4*)(xs + col);
      xv.x += g4.x * acc[i][j][0]; xv.y += g4.y * acc[i][j][1]; xv.z += g4.z * acc[i][j][2]; xv.w += g4.w * acc[i][j][3];
      *(float4*)(xr + col) = xv;
    }
  }
}
DI void resid_gemm(const Prm& p, const bf16_t* A, int K, const bf16_t* Wt, int l, int gchunk, bf16_t* sm, int cv0 = 0, int cv1 = 0) {
  gemm_split<false>(true, R / 256, D / 256, K, sm, p.ws,
    [&](int mt, int nt, auto&& use) {
      use([&](int r) { return A + (size_t)(mt * 256 + r) * K; },
          [&](int r) { return Wt + (size_t)(nt * 256 + r) * K; },
          [&](f32x4 (&acc)[8][4], int wm, int wn, int lane) { resid_epi<8, 256, 256>(p, acc, mt * 256 + wm * 128, nt * 256 + wn * 64, l, gchunk, lane); });
    },
    [&](int mt, int nt, auto&& use) {
      use([&](int r) { return A + (size_t)(mt * 64 + r) * K; },
          [&](int r) { return Wt + (size_t)(nt * 128 + r) * K; },
          [&](f32x4 (&acc)[1][4], int wm, int wn, int lane) { resid_epi<1, 64, 128>(p, acc, mt * 64 + wm * 16, nt * 128 + wn * 64, l, gchunk, lane); });
    }, &p, cv0, cv1);
}

template <int MI, class ACC>
DI void swiglu_epi(bf16_t* ACT, ACC& acc, int row0, int ff0, int lane) {
#pragma unroll
  for (int i = 0; i < MI; ++i) {
    const int row = row0 + i * 16 + (lane & 15), ff = ff0 + 8 * (lane >> 4);
    f32x4 o0, o1;
#pragma unroll
    for (int q = 0; q < 4; ++q) { o0[q] = siluf(acc[i][0][q]) * acc[i][2][q]; o1[q] = siluf(acc[i][1][q]) * acc[i][3][q]; }
    const uint2 w0 = pack4(o0), w1 = pack4(o1);
    *(uint4*)(ACT + (size_t)row * FF + ff) = make_uint4(w0.x, w0.y, w1.x, w1.y);
  }
}
DI void ffn_gu(const Prm& p, const bf16_t* Wt, bf16_t* sm, int cv0 = 0, int cv1 = 0) {
  const bf16_t* H = (const bf16_t*)(p.ws + O_H); bf16_t* ACT = (bf16_t*)(p.ws + O_ACT);
  gemm_split<false>(false, R / 256, 2 * FF / 256, D, sm, p.ws,
    [&](int mt, int nt, auto&& use) {
      use([&](int r) { return H + (size_t)(mt * 256 + r) * D; },
          [&](int r) { return Wt + (size_t)ileave8(nt * 256 + r, FF) * D; },
          [&](f32x4 (&acc)[8][4], int wm, int wn, int lane) { swiglu_epi<8>(ACT, acc, mt * 256 + wm * 128, (nt * 4 + wn) * 32, lane); });
    },
    [&](int mt, int nt, auto&& use) {
      use([&](int r) { return H + (size_t)(mt * 64 + r) * D; },
          [&](int r) { return Wt + (size_t)ileave8(nt * 128 + r, FF) * D; },
          [&](f32x4 (&acc)[1][4], int wm, int wn, int lane) { swiglu_epi<1>(ACT, acc, mt * 64 + wm * 16, (nt * 2 + wn) * 32, lane); });
    }, &p, cv0, cv1);
}

struct MoeMap { int ntiles; int ts1, ts2, ts3, ts4, ts5, ts6, ts7; };
DI void moe_map(const Prm& p, int moe_idx, MoeMap& m) {
  const int* cnt = (const int*)(p.ws + O_CNT) + moe_idx * 8;
  int ts = 0;
  ts += (cnt[0] + 255) >> 8; m.ts1 = ts; ts += (cnt[1] + 255) >> 8; m.ts2 = ts; ts += (cnt[2] + 255) >> 8; m.ts3 = ts; ts += (cnt[3] + 255) >> 8; m.ts4 = ts;
  ts += (cnt[4] + 255) >> 8; m.ts5 = ts; ts += (cnt[5] + 255) >> 8; m.ts6 = ts; ts += (cnt[6] + 255) >> 8; m.ts7 = ts; ts += (cnt[7] + 255) >> 8; m.ntiles = ts;
}
DI void moe_find(const Prm& p, int moe_idx, const MoeMap& m, int mt, int& e, int& lt, int& ce) {
  e = 0; int st = 0;
  if (mt >= m.ts1) { e = 1; st = m.ts1; } if (mt >= m.ts2) { e = 2; st = m.ts2; } if (mt >= m.ts3) { e = 3; st = m.ts3; } if (mt >= m.ts4) { e = 4; st = m.ts4; }
  if (mt >= m.ts5) { e = 5; st = m.ts5; } if (mt >= m.ts6) { e = 6; st = m.ts6; } if (mt >= m.ts7) { e = 7; st = m.ts7; }
  lt = mt - st; ce = ((const int*)(p.ws + O_CNT))[moe_idx * 8 + e];
}

DI void moe_route(const Prm& p, int moe_idx, bf16_t* smraw) {
  const int b = obid(), tid = otid(), e = b & 7, seg = b >> 3, nseg = ogrid() >> 3, SEG = (R + nseg - 1) / nseg;
  int* sc = (int*)smraw;
  const int* route = (const int*)(p.ws + O_ROUTE); const float2* rw = (const float2*)(p.ws + O_RW);
  int* list = (int*)(p.ws + O_LIST) + ((size_t)moe_idx * NE + e) * R; float* lw = (float*)(p.ws + O_LW) + ((size_t)moe_idx * NE + e) * R;
  const int lane = tid & 63, wid = tid >> 6;
  int c = 0;
  const int tend = min(seg * SEG, R);
  for (int t = tid; t < tend; t += 8 * NTHR) {
    int rt[8];
#pragma unroll
    for (int u = 0; u < 8; ++u) rt[u] = (t + u * NTHR < tend) ? route[t + u * NTHR] : -1;
#pragma unroll
    for (int u = 0; u < 8; ++u) c += (rt[u] >= 0) & (((rt[u] & 255) == e) | ((rt[u] >> 8) == e));
  }
  for (int o = 32; o; o >>= 1) c += __shfl_xor(c, o);
  const int t0 = seg * SEG;
  const int ta = t0 + tid, tb = t0 + NTHR + tid;
  const bool ha = tid < SEG && ta < R, hb = NTHR + tid < SEG && tb < R;
  const int ra = ha ? route[ta] : -1, rb = hb ? route[tb] : -1;
  const bool ma = ha && (((ra & 255) == e) | ((ra >> 8) == e)), mb = hb && (((rb & 255) == e) | ((rb >> 8) == e));
  const unsigned long long ba = __ballot(ma), bb = __ballot(mb);
  const unsigned long long below = (1ull << lane) - 1ull;
  __syncthreads();
  if (lane == 0) { sc[wid] = c; sc[8 + wid] = __popcll(ba); sc[16 + wid] = __popcll(bb); }
  __syncthreads();
  int base = 0, tota = 0, prea = 0, preb = 0;
#pragma unroll
  for (int w = 0; w < 8; ++w) { base += sc[w]; tota += sc[8 + w]; if (w < wid) { prea += sc[8 + w]; preb += sc[16 + w]; } }
  int totb = 0;
#pragma unroll
  for (int w = 0; w < 8; ++w) totb += sc[16 + w];
  if (ma) { const int pos = base + prea + __popcll(ba & below); const float2 w = rw[ta]; list[pos] = ta * 2 + (((ra & 255) == e) ? 0 : 1); lw[pos] = ((ra & 255) == e) ? w.x : w.y; }
  if (mb) { const int pos = base + tota + preb + __popcll(bb & below); const float2 w = rw[tb]; list[pos] = tb * 2 + (((rb & 255) == e) ? 0 : 1); lw[pos] = ((rb & 255) == e) ? w.x : w.y; }
  if (seg == nseg - 1 && tid == 0) ((int*)(p.ws + O_CNT))[moe_idx * 8 + e] = base + tota + totb;
  __syncthreads();
}
DI void moe_combine(const Prm& p, int l) {
  const bf16_t* Y = (const bf16_t*)(p.ws + M_Y); const float* mod = (const float*)(p.ws + O_MOD);
  const int gt = obid() * NTHR + otid(), gn = ogrid() * NTHR;
  const int c = (gt & 255) * 4;
  const int rstep = gn >> 8;
  const f32x4 gl = *(const f32x4*)(mod + (size_t)(l * 2) * 6144 + 5 * D + c), gc = *(const f32x4*)(mod + (size_t)(l * 2 + 1) * 6144 + 5 * D + c);
  for (int r0 = gt >> 8; r0 < R; r0 += 4 * rstep) {
    f32x4 xv[4]; uint2 u0[4], u1[4];
#pragma unroll
    for (int u = 0; u < 4; ++u) {
      const int r = r0 + u * rstep;
      if (r < R) { xv[u] = *(const f32x4*)(xrow(p, r) + c); u0[u] = *(const uint2*)(Y + (size_t)(2 * r) * D + c); u1[u] = *(const uint2*)(Y + (size_t)(2 * r + 1) * D + c); }
    }
#pragma unroll
    for (int u = 0; u < 4; ++u) {
      const int r = r0 + u * rstep;
      if (r < R) {
        float y0[4], y1[4]; unpack4(u0[u], y0); unpack4(u1[u], y1);
        const f32x4 ys = {y0[0] + y1[0], y0[1] + y1[1], y0[2] + y1[2], y0[3] + y1[3]};
        *(f32x4*)(xrow(p, r) + c) = xv[u] + (r >= S ? gc : gl) * ys;
      }
    }
  }
}
DI void moe_gu(const Prm& p, int moe_idx, bf16_t* sm, int cv0 = 0, int cv1 = 0) {
  MoeMap m; moe_map(p, moe_idx, m);
  const bf16_t* H = (const bf16_t*)(p.ws + O_H); bf16_t* ACT = (bf16_t*)(p.ws + O_ACT);
  const int* list = (const int*)(p.ws + O_LIST) + (size_t)moe_idx * NE * R;
  gemm_split<false>(cv0 >= cv1, m.ntiles, 2 * FF / 256, D, sm, p.ws,
    [&](int mt, int nt, auto&& use) {
      int e, lt, ce; moe_find(p, moe_idx, m, mt, e, lt, ce);
      const bf16_t* Wt = (const bf16_t*)(p.ws + W_MGU) + (size_t)(moe_idx * 8 + e) * 2 * FF * D;
      const int* le = list + (size_t)e * R;
      use([&](int r) { const int idx = min(lt * 256 + r, ce - 1); return H + (size_t)(le[idx] >> 1) * D; },
          [&](int r) { return Wt + (size_t)ileave8(nt * 256 + r, FF) * D; },
          [&](f32x4 (&acc)[8][4], int wm, int wn, int lane) { swiglu_epi<8>(ACT, acc, mt * 256 + wm * 128, (nt * 4 + wn) * 32, lane); });
    },
    [&](int mt, int nt, auto&& use) {
      int e, lt, ce; moe_find(p, moe_idx, m, mt >> 2, e, lt, ce);
      const bf16_t* Wt = (const bf16_t*)(p.ws + W_MGU) + (size_t)(moe_idx * 8 + e) * 2 * FF * D;
      const int* le = list + (size_t)e * R;
      use([&](int r) { const int idx = min(lt * 256 + (mt & 3) * 64 + r, ce - 1); return H + (size_t)(le[idx] >> 1) * D; },
          [&](int r) { return Wt + (size_t)ileave8(nt * 128 + r, FF) * D; },
          [&](f32x4 (&acc)[1][4], int wm, int wn, int lane) { swiglu_epi<1>(ACT, acc, mt * 64 + wm * 16, (nt * 2 + wn) * 32, lane); });
    }, &p, cv0, cv1);
}
template <int MI, class ACC>
DI void moedown_epi(const Prm& p, int moe_idx, ACC& acc, int e, int idx0, int ce, int col0, int lane) {
  const int* list = (const int*)(p.ws + O_LIST) + (size_t)moe_idx * NE * R;
  const float* lw = (const float*)(p.ws + O_LW) + (size_t)moe_idx * NE * R;
  bf16_t* Y = (bf16_t*)(p.ws + M_Y);
#pragma unroll
  for (int i = 0; i < MI; ++i) {
    const int idx = idx0 + i * 16 + (lane & 15);
    if (idx < ce) {
      const int slot = list[(size_t)e * R + idx]; const float w = lw[(size_t)e * R + idx];
      bf16_t* yr = Y + (size_t)slot * D;
#pragma unroll
      for (int j = 0; j < 4; j += 2) {
        const int col = col0 + (j >> 1) * 32 + 8 * (lane >> 4);
        *(uint4*)(yr + col) = pack8(acc[i][j] * w, acc[i][j + 1] * w);
      }
    }
  }
}
DI void moe_down(const Prm& p, int moe_idx, int l, bf16_t* sm, int cv0 = 0, int cv1 = 0) {
  MoeMap m; moe_map(p, moe_idx, m);
  const bf16_t* ACT = (const bf16_t*)(p.ws + O_ACT);
  gemm_split<false>(cv0 >= cv1, m.ntiles, D / 256, FF, sm, p.ws,
    [&](int mt, int nt, auto&& use) {
      int e, lt, ce; moe_find(p, moe_idx, m, mt, e, lt, ce);
      const bf16_t* Wt = (const bf16_t*)(p.ws + W_MDN) + (size_t)(moe_idx * 8 + e) * D * FF;
      use([&](int r) { return ACT + (size_t)(mt * 256 + r) * FF; },
          [&](int r) { return Wt + (size_t)(nt * 256 + perm8(r)) * FF; },
          [&](f32x4 (&acc)[8][4], int wm, int wn, int lane) { moedown_epi<8>(p, moe_idx, acc, e, lt * 256 + wm * 128, ce, nt * 256 + wn * 64, lane); });
    },
    [&](int mt, int nt, auto&& use) {
      int e, lt, ce; moe_find(p, moe_idx, m, mt >> 2, e, lt, ce);
      const bf16_t* Wt = (const bf16_t*)(p.ws + W_MDN) + (size_t)(moe_idx * 8 + e) * D * FF;
      use([&](int r) { return ACT + (size_t)(mt * 64 + r) * FF; },
          [&](int r) { return Wt + (size_t)(nt * 128 + perm8(r)) * FF; },
          [&](f32x4 (&acc)[1][4], int wm, int wn, int lane) { moedown_epi<1>(p, moe_idx, acc, e, lt * 256 + (mt & 3) * 64 + wm * 16, ce, nt * 128 + wn * 64, lane); });
    }, &p, cv0, cv1);
}

template <int MI, class ACC>
DI void inproj_epi(bf16_t* XZ, bf16_t* GG, ACC& acc, int row0, int col0, int lane) {
#pragma unroll
  for (int i = 0; i < MI; ++i) {
    const int row = row0 + i * 16 + (lane & 15);
#pragma unroll
    for (int jj = 0; jj < 4; jj += 2) {
      const int col = col0 + (jj >> 1) * 32 + 8 * (lane >> 4);
      if (col0 < D) *(uint4*)(XZ + (size_t)row * D + col) = pack8(acc[i][jj], acc[i][jj + 1]);
      else { f32x4 o0, o1; for (int q = 0; q < 4; ++q) { o0[q] = gelut(acc[i][jj][q]); o1[q] = gelut(acc[i][jj + 1][q]); } *(uint4*)(GG + (size_t)row * D + col - D) = pack8(o0, o1); }
    }
  }
}
DI void rg_inproj(const Prm& p, int j, bf16_t* sm, int cv0 = 0, int cv1 = 0) {
  const bf16_t* H = (const bf16_t*)(p.ws + O_H); const bf16_t* Wt = (const bf16_t*)(p.ws + W_RGIN) + (size_t)j * 2048 * D;
  bf16_t* XZ = (bf16_t*)(p.ws + M_XZ); bf16_t* GG = (bf16_t*)(p.ws + M_GG);
  gemm_split<false>(false, R / 256, 8, D, sm, p.ws,
    [&](int mt, int nt, auto&& use) {
      use([&](int r) { return H + (size_t)(mt * 256 + r) * D; },
          [&](int r) { return Wt + (size_t)(nt * 256 + perm8(r)) * D; },
          [&](f32x4 (&acc)[8][4], int wm, int wn, int lane) { inproj_epi<8>(XZ, GG, acc, mt * 256 + wm * 128, nt * 256 + wn * 64, lane); });
    },
    [&](int mt, int nt, auto&& use) {
      use([&](int r) { return H + (size_t)(mt * 64 + r) * D; },
          [&](int r) { return Wt + (size_t)(nt * 128 + perm8(r)) * D; },
          [&](f32x4 (&acc)[1][4], int wm, int wn, int lane) { inproj_epi<1>(XZ, GG, acc, mt * 64 + wm * 16, nt * 128 + wn * 64, lane); });
    }, &p, cv0, cv1);
}
DI void rg_conv(const Prm& p, int j) {
  const bf16_t* XZ = (const bf16_t*)(p.ws + M_XZ); bf16_t* XL = (bf16_t*)(p.ws + M_XL);
  const float* cw = p.conv_w + (size_t)j * 4 * D; const float* cb = p.conv_b + (size_t)j * D;
  const int gt = obid() * NTHR + otid(), gn = ogrid() * NTHR;
  if ((gn & 127) != 0) return;
  const int c0 = (gt & 127) * 8;
  float w[4][8], bias[8];
#pragma unroll
  for (int q = 0; q < 8; ++q) bias[q] = cb[c0 + q];
#pragma unroll
  for (int t = 0; t < 4; ++t)
#pragma unroll
    for (int q = 0; q < 8; ++q) w[t][q] = cw[t * D + c0 + q];
  const u32x4 z4 = {0u, 0u, 0u, 0u};
  auto ld = [&](int e, u32x4 (&v)[4]) {
    const int row = e >> 7, lo = row < S ? 0 : S, hi = row < S ? S : R;
#pragma unroll
    for (int t = 0; t < 4; ++t) { const int rr = row + t - 2; v[t] = (rr >= lo && rr < hi) ? *(const u32x4*)(XZ + (size_t)rr * D + c0) : z4; }
  };
  auto st = [&](int e, u32x4 (&v)[4]) {
    const int row = e >> 7;
    float a[8];
#pragma unroll
    for (int q = 0; q < 8; ++q) a[q] = bias[q];
#pragma unroll
    for (int t = 0; t < 4; ++t)
#pragma unroll
      for (int q = 0; q < 4; ++q) { a[2 * q] += __uint_as_float(v[t][q] << 16) * w[t][2 * q]; a[2 * q + 1] += __uint_as_float(v[t][q] & 0xffff0000u) * w[t][2 * q + 1]; }
    *(uint4*)(XL + (size_t)row * D + c0) = make_uint4(pack2(a[0], a[1]), pack2(a[2], a[3]), pack2(a[4], a[5]), pack2(a[6], a[7]));
  };
  u32x4 v0[4], v1[4];
  int e = gt;
  if (e < R * 128) ld(e, v0);
  for (; e < R * 128; e += 2 * gn) {
    const bool m1 = e + gn < R * 128, m2 = e + 2 * gn < R * 128;
    if (m1) ld(e + gn, v1);
    st(e, v0);
    if (m2) ld(e + 2 * gn, v0);
    if (m1) st(e + gn, v1);
  }
}
template <int MI, class ACC>
DI void gates_epi(const Prm& p, int j, ACC& acc, int row0, int col0, int lane) {
  const bf16_t* XL = (const bf16_t*)(p.ws + M_XL); bf16_t* LA = (bf16_t*)(p.ws + M_LA); bf16_t* IX = (bf16_t*)(p.ws + M_IX);
  const int d = col0 >> 11, gate = (col0 >> 10) & 1, chw = col0 & 1023;
  const float* bias = (gate ? p.rg_bi : p.rg_ba) + (size_t)(j * 2 + d) * D;
  const float* lam = p.rg_lam + (size_t)(j * 2 + d) * D;
#pragma unroll
  for (int i = 0; i < MI; ++i) {
    const int row = row0 + i * 16 + (lane & 15);
#pragma unroll
    for (int jj = 0; jj < 4; jj += 2) {
      const int ch = chw + (jj >> 1) * 32 + 8 * (lane >> 4);
      float bb[8], v[8];
      { const float4 b0 = *(const float4*)(bias + ch), b1 = *(const float4*)(bias + ch + 4); bb[0] = b0.x; bb[1] = b0.y; bb[2] = b0.z; bb[3] = b0.w; bb[4] = b1.x; bb[5] = b1.y; bb[6] = b1.z; bb[7] = b1.w; }
#pragma unroll
      for (int q = 0; q < 4; ++q) { v[q] = acc[i][jj][q]; v[4 + q] = acc[i][jj + 1][q]; }
      f32x4 o0, o1;
      if (gate == 0) {
        float ll[8];
        { const float4 l0 = *(const float4*)(lam + ch), l1 = *(const float4*)(lam + ch + 4); ll[0] = l0.x; ll[1] = l0.y; ll[2] = l0.z; ll[3] = l0.w; ll[4] = l1.x; ll[5] = l1.y; ll[6] = l1.z; ll[7] = l1.w; }
#pragma unroll
        for (int q = 0; q < 4; ++q) { o0[q] = -8.f * sigm(v[q] + bb[q]) * softplus_neg(ll[q]); o1[q] = -8.f * sigm(v[4 + q] + bb[4 + q]) * softplus_neg(ll[4 + q]); }
        *(uint4*)(LA + ((size_t)d * R + row) * D + ch) = pack8(o0, o1);
      } else {
        const uint4 xv = *(const uint4*)(XL + (size_t)row * D + ch);
        float x0[4], x1[4]; unpack4(make_uint2(xv.x, xv.y), x0); unpack4(make_uint2(xv.z, xv.w), x1);
#pragma unroll
        for (int q = 0; q < 4; ++q) { o0[q] = sigm(v[q] + bb[q]) * x0[q]; o1[q] = sigm(v[4 + q] + bb[4 + q]) * x1[q]; }
        *(uint4*)(IX + ((size_t)d * R + row) * D + ch) = pack8(o0, o1);
      }
    }
  }
}
DI void rg_gates(const Prm& p, int j, bf16_t* sm, int cv0 = 0, int cv1 = 0) {
  const bf16_t* XL = (const bf16_t*)(p.ws + M_XL); const bf16_t* Wt = (const bf16_t*)(p.ws + W_GATE) + (size_t)j * 4096 * 256;
  gemm_split<false>(false, R / 256, 16, 256, sm, p.ws,
    [&](int mt, int nt, auto&& use) {
      const int nblk = ((nt * 256) & 1023) >> 8;
      use([&](int r) { return XL + (size_t)(mt * 256 + r) * D + nblk * 256; },
          [&](int r) { return Wt + (size_t)(nt * 256 + perm8(r)) * 256; },
          [&](f32x4 (&acc)[8][4], int wm, int wn, int lane) { gates_epi<8>(p, j, acc, mt * 256 + wm * 128, nt * 256 + wn * 64, lane); });
    },
    [&](int mt, int nt, auto&& use) {
      const int nblk = ((nt * 128) & 1023) >> 8;
      use([&](int r) { return XL + (size_t)(mt * 64 + r) * D + nblk * 256; },
          [&](int r) { return Wt + (size_t)(nt * 128 + perm8(r)) * 256; },
          [&](f32x4 (&acc)[1][4], int wm, int wn, int lane) { gates_epi<1>(p, j, acc, mt * 64 + wm * 16, nt * 128 + wn * 64, lane); });
    }, &p, cv0, cv1);
}
constexpr int SC = 64, NCH2 = R / SC;
DI int chunk_base(int j) { return j < S / SC ? j * SC : S + (j - S / SC) * SC; }
DI void ab_from(uint2 lav, uint2 ixv, float* a, float* b) {
  float la[4], ix[4]; unpack4(lav, la); unpack4(ixv, ix);
#pragma unroll
  for (int q = 0; q < 4; ++q) { a[q] = __expf(la[q]); b[q] = sqrtf(fmaxf(1.f - a[q] * a[q], 0.f)) * ix[q]; }
}
DI void rg_scan1(const Prm& p) {
  const bf16_t* LA = (const bf16_t*)(p.ws + M_LA); const bf16_t* IX = (const bf16_t*)(p.ws + M_IX);
  float* CA = (float*)(p.ws + M_CA); float* CB = (float*)(p.ws + M_CB);
  const int gt = obid() * NTHR + otid(), gn = ogrid() * NTHR;
  for (int e = gt; e < 2 * NCH2 * 256; e += gn) {
    const int cq = e & 255, dj = e >> 8, d = dj / NCH2, j = dj % NCH2, base = chunk_base(j);
    float A[4] = {1.f, 1.f, 1.f, 1.f}, B[4] = {0.f, 0.f, 0.f, 0.f};
    const size_t off0 = ((size_t)d * R) * D + cq * 4;
    uint2 l0[8], i0[8], l1[8], i1[8];
    auto ld = [&](int s0, uint2 (&lv)[8], uint2 (&iv)[8]) {
#pragma unroll
      for (int u = 0; u < 8; ++u) { const int row = d ? base + SC - 1 - (s0 + u) : base + s0 + u; lv[u] = *(const uint2*)(LA + off0 + (size_t)row * D); iv[u] = *(const uint2*)(IX + off0 + (size_t)row * D); }
    };
    auto fold = [&](uint2 (&lv)[8], uint2 (&iv)[8]) {
#pragma unroll
      for (int u = 0; u < 8; ++u) {
        float a[4], b[4]; ab_from(lv[u], iv[u], a, b);
#pragma unroll
        for (int q = 0; q < 4; ++q) { B[q] = a[q] * B[q] + b[q]; A[q] *= a[q]; }
      }
    };
    ld(0, l0, i0);
    for (int s0 = 0; s0 < SC; s0 += 16) { ld(s0 + 8, l1, i1); fold(l0, i0); if (s0 + 16 < SC) ld(s0 + 16, l0, i0); fold(l1, i1); }
    *(float4*)(CA + (size_t)dj * D + cq * 4) = make_float4(A[0], A[1], A[2], A[3]);
    *(float4*)(CB + (size_t)dj * D + cq * 4) = make_float4(B[0], B[1], B[2], B[3]);
  }
}
DI void rg_scan2(const Prm& p) {
  const bf16_t* LA = (const bf16_t*)(p.ws + M_LA); const bf16_t* IX = (const bf16_t*)(p.ws + M_IX); const bf16_t* GG = (const bf16_t*)(p.ws + M_GG);
  const float* CA = (const float*)(p.ws + M_CA); const float* CB = (const float*)(p.ws + M_CB);
  bf16_t* TMP = (bf16_t*)(p.ws + M_TMP); bf16_t* YIN = (bf16_t*)(p.ws + M_YIN);
  const int gt = obid() * NTHR + otid(), gn = ogrid() * NTHR;
  constexpr int NL = S / SC, NC = CT / SC;
  for (int e = gt; e < NCH2 * 256; e += gn) {
    const int cq = e & 255, j = e >> 8, base = chunk_base(j);
    float hf[4] = {0.f, 0.f, 0.f, 0.f}, hb[4] = {0.f, 0.f, 0.f, 0.f};
    const int pf = j >= NL ? j - NL : j + NC;
    for (int p0 = 0; p0 < pf; p0 += 8) {
      float4 av[8], bv[8];
#pragma unroll
      for (int u = 0; u < 8; ++u) { const int pos = min(p0 + u, pf - 1); const int i = pos < NC ? NL + pos : pos - NC; av[u] = *(const float4*)(CA + (size_t)i * D + cq * 4); bv[u] = *(const float4*)(CB + (size_t)i * D + cq * 4); }
#pragma unroll
      for (int u = 0; u < 8; ++u) if (p0 + u < pf) { hf[0] = av[u].x * hf[0] + bv[u].x; hf[1] = av[u].y * hf[1] + bv[u].y; hf[2] = av[u].z * hf[2] + bv[u].z; hf[3] = av[u].w * hf[3] + bv[u].w; }
    }
    const int pb = NCH2 - 1 - j;
    for (int p0 = 0; p0 < pb; p0 += 8) {
      float4 av[8], bv[8];
#pragma unroll
      for (int u = 0; u < 8; ++u) { const int pos = min(p0 + u, pb - 1); const int i = NCH2 - 1 - pos; av[u] = *(const float4*)(CA + (size_t)(NCH2 + i) * D + cq * 4); bv[u] = *(const float4*)(CB + (size_t)(NCH2 + i) * D + cq * 4); }
#pragma unroll
      for (int u = 0; u < 8; ++u) if (p0 + u < pb) { hb[0] = av[u].x * hb[0] + bv[u].x; hb[1] = av[u].y * hb[1] + bv[u].y; hb[2] = av[u].z * hb[2] + bv[u].z; hb[3] = av[u].w * hb[3] + bv[u].w; }
    }
    const size_t c0 = (size_t)cq * 4;
    {
      uint2 l0[8], i0[8], l1[8], i1[8];
      auto ld = [&](int s0, uint2 (&lv)[8], uint2 (&iv)[8]) {
#pragma unroll
        for (int u = 0; u < 8; ++u) { const size_t ix = (size_t)(base + s0 + u) * D + c0; lv[u] = *(const uint2*)(LA + ix); iv[u] = *(const uint2*)(IX + ix); }
      };
      auto fold = [&](int s0, uint2 (&lv)[8], uint2 (&iv)[8]) {
#pragma unroll
        for (int u = 0; u < 8; ++u) {
          float a[4], b[4]; ab_from(lv[u], iv[u], a, b);
#pragma unroll
          for (int q = 0; q < 4; ++q) hf[q] = a[q] * hf[q] + b[q];
          *(uint2*)(TMP + (size_t)(base + s0 + u) * D + c0) = make_uint2(pack2(hf[0], hf[1]), pack2(hf[2], hf[3]));
        }
      };
      ld(0, l0, i0);
      for (int s0 = 0; s0 < SC; s0 += 16) { ld(s0 + 8, l1, i1); fold(s0, l0, i0); if (s0 + 16 < SC) ld(s0 + 16, l0, i0); fold(s0 + 8, l1, i1); }
    }
    {
      uint2 l0[8], i0[8], t0[8], g0[8], l1[8], i1[8], t1[8], g1[8];
      auto ld = [&](int s0, uint2 (&lv)[8], uint2 (&iv)[8], uint2 (&tv)[8], uint2 (&gv)[8]) {
#pragma unroll
        for (int u = 0; u < 8; ++u) { const size_t ix = (size_t)(base + SC - 1 - (s0 + u)) * D + c0; lv[u] = *(const uint2*)(LA + (size_t)R * D + ix); iv[u] = *(const uint2*)(IX + (size_t)R * D + ix); tv[u] = *(const uint2*)(TMP + ix); gv[u] = *(const uint2*)(GG + ix); }
      };
      auto fold = [&](int s0, uint2 (&lv)[8], uint2 (&iv)[8], uint2 (&tv)[8], uint2 (&gv)[8]) {
#pragma unroll
        for (int u = 0; u < 8; ++u) {
          float a[4], b[4], t[4], g[4]; ab_from(lv[u], iv[u], a, b); unpack4(tv[u], t); unpack4(gv[u], g);
#pragma unroll
          for (int q = 0; q < 4; ++q) hb[q] = a[q] * hb[q] + b[q];
          *(uint2*)(YIN + (size_t)(base + SC - 1 - (s0 + u)) * D + c0) = make_uint2(pack2((t[0] + hb[0]) * g[0], (t[1] + hb[1]) * g[1]), pack2((t[2] + hb[2]) * g[2], (t[3] + hb[3]) * g[3]));
        }
      };
      ld(0, l0, i0, t0, g0);
      for (int s0 = 0; s0 < SC; s0 += 16) { ld(s0 + 8, l1, i1, t1, g1); fold(s0, l0, i0, t0, g0); if (s0 + 16 < SC) ld(s0 + 16, l0, i0, t0, g0); fold(s0 + 8, l1, i1, t1, g1); }
    }
  }
}

template <int MI, class ACC>
DI void qk_epi(const Prm& p, ACC& acc, int row0, int col0, int lane) {
  bf16_t* Qb = (bf16_t*)(p.ws + M_Q); bf16_t* Kb = (bf16_t*)(p.ws + M_K);
  const bool isq = col0 < D; const float* gv = isq ? p.na_qg : p.na_kg; bf16_t* O = isq ? Qb : Kb;
  const int colb = col0 & 1023; const float osc = isq ? 0.125f : 1.f;
#pragma unroll
  for (int i = 0; i < MI; ++i) {
    const int row = row0 + i * 16 + (lane & 15);
    float ss = 0.f;
#pragma unroll
    for (int jj = 0; jj < 4; ++jj)
#pragma unroll
      for (int q = 0; q < 4; ++q) ss += acc[i][jj][q] * acc[i][jj][q];
    ss += __shfl_xor(ss, 16); ss += __shfl_xor(ss, 32);
    const float rstd = rsqrtf(ss * (1.f / 64.f) + 1e-6f) * osc;
#pragma unroll
    for (int jj = 0; jj < 4; jj += 2) {
      const int dc = (jj >> 1) * 32 + 8 * (lane >> 4);
      const f32x4 g0 = *(const f32x4*)(gv + dc), g1 = *(const f32x4*)(gv + dc + 4);
      *(uint4*)(O + (size_t)row * D + colb + dc) = pack8(acc[i][jj] * rstd * g0, acc[i][jj + 1] * rstd * g1);
    }
  }
}
template <int MI, class ACC>
DI void v_epi(bf16_t* VT, ACC& acc, int tok0, int hd0, int lane) {
#pragma unroll
  for (int i = 0; i < MI; ++i) {
    const int tok = tok0 + i * 16 + 4 * (lane >> 4);
#pragma unroll
    for (int jj = 0; jj < 4; ++jj) {
      const int hd = hd0 + jj * 16 + (lane & 15);
      *(uint2*)(VT + (size_t)hd * R + tok) = pack4(acc[i][jj]);
    }
  }
}
DI void na_qkv(const Prm& p, bf16_t* sm, int cv0 = 0, int cv1 = 0) {
  const int cvm = cv0 + (cv1 - cv0) / 2;
  const bf16_t* H = (const bf16_t*)(p.ws + O_H); const bf16_t* Wt = (const bf16_t*)(p.ws + W_QKV);
  bf16_t* VT = (bf16_t*)(p.ws + M_VT);
  gemm_split<false>(false, R / 256, 8, D, sm, p.ws,
    [&](int mt, int nt, auto&& use) {
      use([&](int r) { return H + (size_t)(mt * 256 + r) * D; },
          [&](int r) { return Wt + (size_t)(nt * 256 + perm8(r)) * D; },
          [&](f32x4 (&acc)[8][4], int wm, int wn, int lane) { qk_epi<8>(p, acc, mt * 256 + wm * 128, nt * 256 + wn * 64, lane); });
    },
    [&](int mt, int nt, auto&& use) {
      use([&](int r) { return H + (size_t)(mt * 64 + r) * D; },
          [&](int r) { return Wt + (size_t)(nt * 128 + perm8(r)) * D; },
          [&](f32x4 (&acc)[1][4], int wm, int wn, int lane) { qk_epi<1>(p, acc, mt * 64 + wm * 16, nt * 128 + wn * 64, lane); });
    }, &p, cv0, cvm);
  gemm_split<true>(false, R / 256, 4, D, sm, p.ws,
    [&](int mt, int nt, auto&& use) {
      use([&](int r) { return H + (size_t)(mt * 256 + r) * D; },
          [&](int r) { return Wt + (size_t)(2048 + nt * 256 + r) * D; },
          [&](f32x4 (&acc)[8][4], int wm, int wn, int lane) { v_epi<8>(VT, acc, mt * 256 + wm * 128, nt * 256 + wn * 64, lane); });
    },
    [&](int mt, int nt, auto&& use) {
      use([&](int r) { return H + (size_t)(mt * 64 + r) * D; },
          [&](int r) { return Wt + (size_t)(2048 + nt * 128 + r) * D; },
          [&](f32x4 (&acc)[1][4], int wm, int wn, int lane) { v_epi<1>(VT, acc, mt * 64 + wm * 16, nt * 128 + wn * 64, lane); });
    }, &p, cvm, cv1);
}
DI void na_attn(const Prm& p, bf16_t* sm0) {
  const int tid0 = otid(), half = tid0 >> 8, tid = tid0 & 255;
  bf16_t* sm = sm0 + half * 36864;
  bf16_t* Ks = sm; bf16_t* VTs = sm + 256 * 72; float* rp = (float*)(sm + 256 * 72 + 64 * 264);
  const bf16_t* Qb = (const bf16_t*)(p.ws + M_Q); const bf16_t* Kb = (const bf16_t*)(p.ws + M_K); const bf16_t* VT = (const bf16_t*)(p.ws + M_VT);
  bf16_t* Ob = (bf16_t*)(p.ws + M_O);
  const int lane = tid & 63, w = tid >> 6, g = lane >> 4, ql = lane & 15;
  const int G = ogrid(), b = obid();
  const int nbx = G >> 3, li = b >> 3;
  {
    const int xx = b & 7;
    for (int jj = li * 2 + half; jj < 520; jj += nbx * 2) {
      const bool lat = jj < 512;
      int h, r = 0, rs = 0, qtok;
      if (lat) { const int it = xx * 512 + jj; h = it >> 8; r = it & 255; rs = min(max(r - 4, 0), 248); qtok = r * 64 + 16 * w + ql; }
      else { const int t = xx * 8 + (jj - 512); h = t >> 2; qtok = S + (t & 3) * 64 + 16 * w + ql; }
      const int qc = 16 * w + ql, cst = min(max(qc - 8, 0), 48), cs0 = min(max(16 * w - 8, 0), 32);
      bf16x8 qf[2];
#pragma unroll
      for (int ks = 0; ks < 2; ++ks) qf[ks] = *(const bf16x8*)(Qb + (size_t)qtok * D + h * 64 + ks * 32 + g * 8);
      float m_run = -1e30f, l_run = 0.f;
      f32x4 o[4];
#pragma unroll
      for (int db = 0; db < 4; ++db) o[db] = (f32x4){0.f, 0.f, 0.f, 0.f};
      __syncthreads();
      if (lat) for (int e = tid; e < 465; e += 256) rp[e] = p.na_rpb[(size_t)h * 465 + e];
      const char* const kbase = (const char*)Kb + (size_t)h * 128; const char* const vbase = (const char*)VT + (size_t)h * 64 * R * 2;
      for (int c = lat ? 0 : 2; c < 4; ++c) {
        __syncthreads();
        {
          const int nkeys = c < 2 ? 256 : 128, tok0 = c < 2 ? (rs + 4 * c) * 64 : S + (c - 2) * 128, ppr = nkeys >> 3, ni = nkeys >> 5;
          u32x4 kreg[8], vreg[8];
#pragma unroll
          for (int i = 0; i < 8; ++i) if (i < ni) {
            const int ch = tid + 256 * i;
            const unsigned ko = (unsigned)((tok0 + (ch >> 3)) * D + (ch & 7) * 8) * 2u, vo = (unsigned)((ch / ppr) * R + tok0 + (ch % ppr) * 8) * 2u;
            kreg[i] = *(const u32x4*)(kbase + ko);
            vreg[i] = *(const u32x4*)(vbase + vo);
          }
#pragma unroll
          for (int i = 0; i < 8; ++i) if (i < ni) {
            const int ch = tid + 256 * i;
            *(u32x4*)(Ks + (ch >> 3) * 72 + (ch & 7) * 8) = kreg[i];
            *(u32x4*)(VTs + (ch / ppr) * 264 + (ch % ppr) * 8) = vreg[i];
          }
        }
        __syncthreads();
        f32x4 s[8];
#pragma unroll
        for (int kb = 0; kb < 8; ++kb) {
          const int kbase = c < 2 ? (kb >> 1) * 64 + cs0 + 16 * (kb & 1) : kb * 16;
          s[kb] = (f32x4){0.f, 0.f, 0.f, 0.f};
#pragma unroll
          for (int ks = 0; ks < 2; ++ks) { const bf16x8 kf = *(const bf16x8*)(Ks + (kbase + ql) * 72 + ks * 32 + g * 8); s[kb] = MFMA16(kf, qf[ks], s[kb]); }
        }
        if (c < 2) {
#pragma unroll
          for (int kb = 0; kb < 8; ++kb) {
            const int krow = rs + 4 * c + (kb >> 1), rbi = krow - r + 7;
#pragma unroll
            for (int q = 0; q < 4; ++q) {
              const int kc = cs0 + 16 * (kb & 1) + 4 * g + q;
              const bool valid = (kc >= cst) && (kc < cst + 16);
              const int cbi = min(max(kc - qc + 15, 0), 30);
              s[kb][q] = valid ? s[kb][q] + rp[rbi * 31 + cbi] : -1e30f;
            }
          }
        }
        float mx = -1e30f;
#pragma unroll
        for (int kb = 0; kb < 8; ++kb)
#pragma unroll
          for (int q = 0; q < 4; ++q) mx = fmaxf(mx, s[kb][q]);
        mx = fmaxf(mx, __shfl_xor(mx, 16)); mx = fmaxf(mx, __shfl_xor(mx, 32));
        const float m_new = fmaxf(m_run, mx), alpha = __expf(m_run - m_new);
        float ls = 0.f;
#pragma unroll
        for (int kb = 0; kb < 8; ++kb)
#pragma unroll
          for (int q = 0; q < 4; ++q) { s[kb][q] = __expf(s[kb][q] - m_new); ls += s[kb][q]; }
        l_run = l_run * alpha + ls; m_run = m_new;
#pragma unroll
        for (int db = 0; db < 4; ++db) { o[db][0] *= alpha; o[db][1] *= alpha; o[db][2] *= alpha; o[db][3] *= alpha; }
#pragma unroll
        for (int t = 0; t < 4; ++t) {
          const int kb0 = c < 2 ? ((2 * t) >> 1) * 64 + cs0 : (2 * t) * 16, kb1 = c < 2 ? kb0 + 16 : kb0 + 16;
          const uint2 p0 = pack4(s[2 * t]), p1 = pack4(s[2 * t + 1]);
          const uint4 pu = make_uint4(p0.x, p0.y, p1.x, p1.y);
          const bf16x8 pf = __builtin_bit_cast(bf16x8, pu);
#pragma unroll
          for (int db = 0; db < 4; ++db) {
            const s16x4 v0 = *(const s16x4*)(VTs + (db * 16 + ql) * 264 + kb0 + 4 * g), v1 = *(const s16x4*)(VTs + (db * 16 + ql) * 264 + kb1 + 4 * g);
            const bf16x8 vf = __builtin_shufflevector(v0, v1, 0, 1, 2, 3, 4, 5, 6, 7);
            o[db] = MFMA16(vf, pf, o[db]);
          }
        }
      }
      l_run += __shfl_xor(l_run, 16); l_run += __shfl_xor(l_run, 32);
      const float inv = 1.f / l_run;
#pragma unroll
      for (int db = 0; db < 4; ++db) { f32x4 v = o[db]; v[0] *= inv; v[1] *= inv; v[2] *= inv; v[3] *= inv; *(uint2*)(Ob + (size_t)qtok * D + h * 64 + db * 16 + 4 * g) = pack4(v); }
    }
  }
}

DI void ft_chan(const Prm& p, bf16_t* sm) {
  const bf16_t* H = (const bf16_t*)(p.ws + O_H); const bf16_t* Bc = (const bf16_t*)(p.ws + W_BC);
  bf16_t* UT = (bf16_t*)(p.ws + M_UT); bf16_t* UTC = (bf16_t*)(p.ws + M_UTC);
  gemm_stream<true, 4, 2, 4>(130, 8, 256, sm, p.ws, [&](int mt, int nt, auto&& use) {
    const int grp = nt >> 1;
    use(
        [&](int r0) { const int r = perm8(r0); const int tok = mt < 128 ? 128 * r + mt : S + (mt - 128) * 128 + r; return H + (size_t)tok * D + grp * 256; },
        [&](int r) { return Bc + (size_t)((nt & 1) * 256 + r) * 256; },
        [&](f32x4 (&acc)[4][4], int wm, int wn, int lane) {
#pragma unroll
          for (int i = 0; i < 4; i += 2) {
            const int tr = wm * 64 + (i >> 1) * 32 + 8 * (lane >> 4);
#pragma unroll
            for (int jj = 0; jj < 4; ++jj) {
              const int cc = (nt & 1) * 256 + wn * 64 + jj * 16 + (lane & 15), ri = cc >> 8, ch = grp * 256 + (cc & 255);
              const uint4 w = pack8(acc[i][jj], acc[i + 1][jj]);
              if (mt < 128) *(uint4*)(UT + (((size_t)mt * D + ch) * 2 + ri) * 128 + tr) = w;
              else *(uint4*)(UTC + ((size_t)ch * 2 + ri) * 256 + (mt - 128) * 128 + tr) = w;
            }
          }
        });
  });
}
DI void ft_step1(const Prm& p, bf16_t* sm) {
  const bf16_t* UT = (const bf16_t*)(p.ws + M_UT); const bf16_t* UTC = (const bf16_t*)(p.ws + M_UTC);
  const bf16_t* D1 = (const bf16_t*)(p.ws + W_D1); const bf16_t* Dc = (const bf16_t*)(p.ws + W_DC);
  bf16_t* AT = (bf16_t*)(p.ws + M_AT); bf16_t* F = (bf16_t*)(p.ws + M_F);
  gemm_stream<true, 4, 2, 4>(1024, 1, 256, sm, p.ws, [&](int mt, int nt, auto&& use) {
    const int ch = mt;
    use(
        [&](int r) { return UT + ((size_t)perm8(r) * D + ch) * 256; },
        [&](int r) { return D1 + (size_t)ileave(r, 128) * 256; },
        [&](f32x4 (&acc)[4][4], int wm, int wn, int lane) {
#pragma unroll
          for (int i = 0; i < 4; i += 2) {
            const int t2 = wm * 64 + (i >> 1) * 32 + 8 * (lane >> 4);
#pragma unroll
            for (int jj = 0; jj < 2; ++jj) {
              const int k1 = wn * 32 + jj * 16 + (lane & 15);
              f32x4 orr[2], oi[2];
#pragma unroll
              for (int u = 0; u < 2; ++u)
#pragma unroll
                for (int q = 0; q < 4; ++q) {
                  float st, ct; sincos_rev((float)(k1 * (t2 + 4 * u + q)) * (1.f / 16384.f), &st, &ct);
                  const float ar = acc[i + u][jj][q], ai = acc[i + u][jj + 2][q];
                  orr[u][q] = ar * ct + ai * st; oi[u][q] = ai * ct - ar * st;
                }
              *(uint4*)(AT + (((size_t)k1 * D + ch) * 2 + 0) * 128 + t2) = pack8(orr[0], orr[1]);
              *(uint4*)(AT + (((size_t)k1 * D + ch) * 2 + 1) * 128 + t2) = pack8(oi[0], oi[1]);
            }
          }
        });
  });
  gemm_stream<true, 4, 2, 4>(8, 1, 512, sm, p.ws, [&](int mt, int nt, auto&& use) {
    const int ch0 = mt * 128;
    use(
        [&](int r) { return UTC + (size_t)(ch0 + perm8(r)) * 512; },
        [&](int r) { return Dc + (size_t)r * 512; },
        [&](f32x4 (&acc)[4][4], int wm, int wn, int lane) {
#pragma unroll
          for (int i = 0; i < 4; i += 2) {
            const int ch = ch0 + wm * 64 + (i >> 1) * 32 + 8 * (lane >> 4);
#pragma unroll
            for (int jj = 0; jj < 4; ++jj) {
              const int k = wn * 64 + jj * 16 + (lane & 15);
              *(uint4*)(F + (size_t)(S + k) * D + ch) = pack8(acc[i][jj], acc[i + 1][jj]);
            }
          }
        });
  });
}
DI void ft_step3(const Prm& p, bf16_t* sm) {
  const bf16_t* AT = (const bf16_t*)(p.ws + M_AT); const bf16_t* D3 = (const bf16_t*)(p.ws + W_D3); bf16_t* F = (bf16_t*)(p.ws + M_F);
  gemm_stream<true, 4, 4, 2>(512, 1, 256, sm, p.ws, [&](int mt, int nt, auto&& use) {
    const int k1 = mt >> 2, ch0 = (mt & 3) * 256;
    use(
        [&](int r) { return AT + ((size_t)k1 * D + ch0 + perm8(r)) * 256; },
        [&](int r) { return D3 + (size_t)r * 256; },
        [&](f32x4 (&acc)[4][4], int wm, int wn, int lane) {
#pragma unroll
          for (int i = 0; i < 4; i += 2) {
            const int ch = ch0 + wm * 64 + (i >> 1) * 32 + 8 * (lane >> 4);
#pragma unroll
            for (int jj = 0; jj < 4; ++jj) {
              const int k2 = wn * 64 + jj * 16 + (lane & 15);
              *(uint4*)(F + (size_t)(128 * k2 + k1) * D + ch) = pack8(acc[i][jj], acc[i + 1][jj]);
            }
          }
        });
  });
}

#define XB_TMO      128
#define XB_XCNT(j)  (256  + 64 * (j))
#define XB_XSUB(j)  (1280 + 64 * (j))
#define XB_XGEN(j)  (2304 + 64 * (j))
#define XB_TOP      3328
#define XB_TOPGEN   3392
#define XCD_BAR_WORDS 3456
#define XB_SPIN_CAP (1u << 18)
#define LAS __attribute__((address_space(3)))

__device__ __forceinline__ unsigned xb_ld(unsigned* p)              { return __hip_atomic_load(p, __ATOMIC_RELAXED, __HIP_MEMORY_SCOPE_AGENT); }
__device__ __forceinline__ unsigned xb_add(unsigned* p, unsigned v) { return __hip_atomic_fetch_add(p, v, __ATOMIC_RELAXED, __HIP_MEMORY_SCOPE_AGENT); }
__device__ __forceinline__ unsigned xb_xcc_id() { return (unsigned)__builtin_amdgcn_s_getreg((3 << 11) | 20) & 0xFu; }
#define XB_SPIN(cond, bar) do { unsigned _sp = 0; while (cond) { __builtin_amdgcn_s_sleep(1); \
    if ((++_sp & 255u) == 0u) { if (xb_ld(&(bar)[XB_TMO])) break; if (_sp > XB_SPIN_CAP) { atomicAdd(&(bar)[XB_TMO], 1u); break; } } } } while (0)

struct XcdBarrier {
    unsigned* bar; unsigned x;
    volatile LAS unsigned* st;
};

__device__ __forceinline__ XcdBarrier xcd_barrier_post(unsigned* bar, volatile LAS unsigned* st) {
    XcdBarrier b; b.bar = bar; b.x = xb_xcc_id(); b.st = st;
    if (threadIdx.x == 0) (void)xb_add(&bar[XB_XCNT(b.x)], 1u);
    return b;
}
__device__ __forceinline__ void xcd_barrier_complete(unsigned* bar, unsigned x, unsigned& nloc, unsigned& nx) {
    const unsigned G = gridDim.x * gridDim.y * gridDim.z;
    unsigned sum, cnt, mine, sp = 0u;
    for (;;) {
        sum = 0u; cnt = 0u; mine = 0u;
#pragma unroll
        for (unsigned j = 0; j < 16; ++j) { const unsigned c = xb_ld(&bar[XB_XCNT(j)]); sum += c; cnt += (c > 0u) ? 1u : 0u; mine = (j == x) ? c : mine; }
        if (sum == G) break;
        __builtin_amdgcn_s_sleep(1);
        if ((++sp & 255u) == 0u) { if (xb_ld(&bar[XB_TMO])) break; if (sp > XB_SPIN_CAP) { atomicAdd(&bar[XB_TMO], 1u); break; } }
    }
    nloc = mine > 0u ? mine : 1u; nx = cnt > 0u ? cnt : 1u;
}

__device__ __forceinline__ void xcd_barrier(const XcdBarrier& b) {
    asm volatile("s_waitcnt vmcnt(0)" ::: "memory");
    __syncthreads();
    if (threadIdx.x == 0) {
        unsigned* bar = b.bar;
        __builtin_amdgcn_s_waitcnt(0);
        unsigned nloc = b.st[0], nx = b.st[1];
        if (nloc == 0u) { xcd_barrier_complete(bar, b.x, nloc, nx); b.st[0] = nloc; b.st[1] = nx; }
        const unsigned old = xb_add(&bar[XB_XSUB(b.x)], 1u);
        const unsigned gen = old / nloc;
        if (old + 1u == (gen + 1u) * nloc) {
            __builtin_amdgcn_fence(__ATOMIC_RELEASE, "agent");
            asm volatile("s_waitcnt vmcnt(0)" ::: "memory");
            const unsigned og = xb_add(&bar[XB_TOP], 1u);
            const unsigned tg = og / nx;
            if (og + 1u == (tg + 1u) * nx) xb_add(&bar[XB_TOPGEN], 1u);
            else XB_SPIN(xb_ld(&bar[XB_TOPGEN]) == tg, bar);
            __builtin_amdgcn_fence(__ATOMIC_ACQUIRE, "agent");
            xb_add(&bar[XB_XGEN(b.x)], 1u);
            asm volatile("s_waitcnt vmcnt(0)" ::: "memory");
        } else {
            XB_SPIN(xb_ld(&bar[XB_XGEN(b.x)]) == gen, bar);
            __builtin_amdgcn_fence(__ATOMIC_ACQUIRE, "agent");
            asm volatile("s_waitcnt vmcnt(0)" ::: "memory");
        }
    }
    __syncthreads();
}


__global__ void __launch_bounds__(512) fwd_megakernel(Prm p) {
  __shared__ __attribute__((aligned(16))) unsigned char smem_raw[SMEM_BYTES];
  bf16_t* sm = (bf16_t*)smem_raw;
  __shared__ uint4 xb_words;
  if (threadIdx.x == 0) {
    xb_words = make_uint4(0u, 0u, 0u, 0u);
#pragma unroll
    for (int j = 0; j < NJOB; ++j) g_jobs_s[j] = p.jobs[j];
  }
  __syncthreads();
  XcdBarrier xb = xcd_barrier_post((unsigned*)(p.ws + O_BAR), (volatile LAS unsigned*)&xb_words);
  if (p.never) { cg::grid_group grid = cg::this_grid(); grid.sync(); }
#define GSYNC() do { for (int rs_ = 0; rs_ < REP_SYNC; ++rs_) xcd_barrier(xb); } while (0)
#define WITH_CONV(c0, c1, call) do { const bool cf_ = ((obid() >> 3) & 1) == 0; if (cf_) conv_range(p, (c0), (c1), sm); call; if (!cf_) conv_range(p, (c0), (c1), sm); } while (0)
  phase0(p, sm); GSYNC();
  int rg_j = 0, dense_j = 0, moe_j = 0;
  for (int l = 0; l < 4; ++l) {
    norm_phase(p, l, 0, -1, sm, l == 2 ? 1 : -1); GSYNC();
    const int kind = l % 3;
    if (kind == 0) {
      const int c0 = l == 0 ? CV_P0 : CV_L2_DN, c1 = l == 0 ? CV_L0_IN : CV_L3_IN, c2 = l == 0 ? CV_L0_GATES : CV_L3_GATES, c3 = l == 0 ? CV_L0_OUT : CV_L3_OUT;
      for (int q_ = 0; q_ < REP_OG; ++q_) { rg_inproj(p, rg_j, sm, c0, c1); GSYNC(); }
      for (int q_ = 0; q_ < REP_ATT; ++q_) { rg_conv(p, rg_j); GSYNC(); }
      for (int q_ = 0; q_ < REP_OG; ++q_) { rg_gates(p, rg_j, sm, c1, c2); GSYNC(); }
      for (int q_ = 0; q_ < REP_SCAN; ++q_) { rg_scan1(p); GSYNC(); rg_scan2(p); GSYNC(); }
      resid_gemm(p, (const bf16_t*)(p.ws + M_YIN), D, (const bf16_t*)(p.ws + W_RGOUT) + (size_t)rg_j * D * D, l, 2, sm, c2, c3);
      ++rg_j;
    } else if (kind == 1) {
      for (int q_ = 0; q_ < REP_OG; ++q_) { na_qkv(p, sm, CV_L0_DN, CV_L1_QKV); GSYNC(); }
      for (int q_ = 0; q_ < REP_ATT; ++q_) { na_attn(p, sm); GSYNC(); }
      resid_gemm(p, (const bf16_t*)(p.ws + M_O), D, (const bf16_t*)(p.ws + W_O), l, 2, sm, CV_L1_QKV, CV_L1_O);
    } else {
      for (int q_ = 0; q_ < REP_OG; ++q_) { ft_chan(p, sm); GSYNC(); ft_step1(p, sm); GSYNC(); ft_step3(p, sm); GSYNC(); }
      resid_gemm(p, (const bf16_t*)(p.ws + M_F), D, (const bf16_t*)(p.ws + W_FT), l, 2, sm);
    }
    GSYNC();
    const bool moe = (l & 1);
    norm_phase(p, l, 1, moe ? moe_j : -1, sm); GSYNC();
    if (!moe) {
      const int c0 = l == 0 ? CV_L0_OUT : CV_L1_MDN, c1 = l == 0 ? CV_L0_GU : CV_L2_GU, c2 = l == 0 ? CV_L0_DN : CV_L2_DN;
      ffn_gu(p, (const bf16_t*)(p.ws + W_FGU) + (size_t)dense_j * 2 * FF * D, sm, c0, c1); GSYNC();
      resid_gemm(p, (const bf16_t*)(p.ws + O_ACT), FF, (const bf16_t*)(p.ws + W_FDN) + (size_t)dense_j * D * FF, l, 5, sm, c1, c2);
      ++dense_j;
    } else {
      for (int q_ = 0; q_ < REP_ATT; ++q_) { moe_route(p, moe_j, sm); GSYNC(); }
      if (l == 1) moe_gu(p, moe_j, sm, CV_L1_O, CV_L1_MGU); else moe_gu(p, moe_j, sm);
      GSYNC();
      for (int q_ = 0; q_ < REP_MDN; ++q_) { if (l == 1) moe_down(p, moe_j, l, sm, CV_L1_MGU, CV_L1_MDN); else moe_down(p, moe_j, l, sm);
      GSYNC(); }
      if (l == 3) moe_combine(p, l);
      ++moe_j;
    }
    if (l < 3 && l != 1) GSYNC();
  }
}

static void add_job(Prm& p, const float* src, size_t dst_off, int K, int N, int nb, long long ss, long long ds) {
  Job& j = p.jobs[p.njob++];
  j.src = src; j.dst = (bf16_t*)(p.ws + dst_off); j.K = K; j.N = N; j.nb = nb; j.tiles = (K / 64) * (N / 64) * nb; j.ss = ss; j.ds = ds;
}

extern "C" void kernel_launch(void* const* d_in, const int* in_sizes, int n_in, void* d_out, int out_size, void* d_ws, size_t ws_size, hipStream_t stream) {
  static int grid_blocks = 0;
  if (!grid_blocks) {
    int dev = 0, cus = 0, per_cu = 0;
    hipGetDevice(&dev);
    hipDeviceGetAttribute(&cus, hipDeviceAttributeMultiprocessorCount, dev);
    hipOccupancyMaxActiveBlocksPerMultiprocessor(&per_cu, fwd_megakernel, NTHR, 0);
    if (per_cu < 1) per_cu = 1;
    if (per_cu > 1) per_cu = 1;
    grid_blocks = (cus * per_cu) & ~7;
  }
  Prm p; memset(&p, 0, sizeof(p));
  const float* const* in = (const float* const*)d_in;
  p.x = in[0]; p.c = in[1]; p.ctx = in[2]; p.cctx = in[3]; p.ada_w = in[4]; p.ada_b = in[5]; p.norm_g = in[6];
  p.conv_w = in[8]; p.conv_b = in[9]; p.rg_ba = in[11]; p.rg_bi = in[13]; p.rg_lam = in[14];
  p.na_qg = in[17]; p.na_kg = in[18]; p.na_rpb = in[19]; p.router = in[24];
  p.out = (float*)d_out; p.ws = (unsigned char*)d_ws;
  p.njob = 0;
  const long long GU = (long long)1024 * 7168, DN = (long long)3584 * 1024, SQ = (long long)1024 * 1024;
  auto gates = [&](int j) {
    for (int d = 0; d < 2; ++d) {
      const int jd = j * 2 + d;
      add_job(p, in[10] + (size_t)jd * 4 * 65536, W_GATE + ((size_t)(jd * 2 + 0) * 4 * 65536) * 2, 256, 256, 4, 65536, 65536);
      add_job(p, in[12] + (size_t)jd * 4 * 65536, W_GATE + ((size_t)(jd * 2 + 1) * 4 * 65536) * 2, 256, 256, 4, 65536, 65536);
    }
  };
  add_job(p, in[7], W_RGIN, 1024, 2048, 1, 0, 0); gates(0); add_job(p, in[15], W_RGOUT, 1024, 1024, 1, 0, 0);
  add_job(p, in[22], W_FGU, 1024, 7168, 1, 0, 0); add_job(p, in[23], W_FDN, 3584, 1024, 1, 0, 0);
  add_job(p, in[16], W_QKV, 1024, 3072, 1, 0, 0); add_job(p, in[20], W_O, 1024, 1024, 1, 0, 0);
  add_job(p, in[25], W_MGU, 1024, 7168, 8, GU, GU); add_job(p, in[26], W_MDN, 3584, 1024, 8, DN, DN);
  add_job(p, in[21], W_FT, 1024, 1024, 1, 0, 0);
  add_job(p, in[22] + GU, W_FGU + (size_t)GU * 2, 1024, 7168, 1, 0, 0); add_job(p, in[23] + DN, W_FDN + (size_t)DN * 2, 3584, 1024, 1, 0, 0);
  add_job(p, in[7] + 2 * SQ, W_RGIN + (size_t)2 * SQ * 2, 1024, 2048, 1, 0, 0); gates(1); add_job(p, in[15] + SQ, W_RGOUT + (size_t)SQ * 2, 1024, 1024, 1, 0, 0);
  add_job(p, in[25] + 8 * GU, W_MGU + (size_t)8 * GU * 2, 1024, 7168, 8, GU, GU); add_job(p, in[26] + 8 * DN, W_MDN + (size_t)8 * DN * 2, 3584, 1024, 8, DN, DN);
  {
    int tot = 0; for (int j = 0; j < p.njob; ++j) tot += p.jobs[j].tiles;
    if (tot != CV_TOTAL) fprintf(stderr, "conversion tile count %d != %d\n", tot, CV_TOTAL);
  }
  (void)hipMemsetAsync((unsigned char*)d_ws + O_BAR, 0, XCD_BAR_WORDS * 4, stream);
  void* args[] = {&p};
  hipError_t e = hipLaunchCooperativeKernel((void*)fwd_megakernel, dim3(grid_blocks), dim3(NTHR), args, 0, stream);
  if (e != hipSuccess) fprintf(stderr, "cooperative launch failed: %s (grid %d)\n", hipGetErrorString(e), grid_blocks);
}
```

```cpp
#ifndef REP_GU
#define REP_GU 1
#endif
#ifndef REP_NORM
#define REP_NORM 1
#endif
#ifndef REP_OG
#define REP_OG 1
#endif
#ifndef REP_MDN
#define REP_MDN 1
#endif
#ifndef REP_P0
#define REP_P0 1
#endif
#ifndef REP_SYNC
#define REP_SYNC 1
#endif
#ifndef REP_SCAN
#define REP_SCAN 1
#endif
#ifndef REP_ATT
#define REP_ATT 1
#endif
#ifndef REP_SK
#define REP_SK 1
#endif
#include <hip/hip_runtime.h>
#include <hip/hip_cooperative_groups.h>
#include <cstdio>
#include <cstdint>
#include <cstring>
namespace cg = cooperative_groups;

typedef unsigned short bf16_t;
typedef short bf16x8 __attribute__((ext_vector_type(8)));
typedef short s16x4 __attribute__((ext_vector_type(4)));
typedef float f32x4 __attribute__((ext_vector_type(4)));
typedef unsigned u32x4 __attribute__((ext_vector_type(4)));
#define DI __device__ __forceinline__
#define MFMA16(a, b, c) __builtin_amdgcn_mfma_f32_16x16x32_bf16((a), (b), (c), 0, 0, 0)

constexpr int S = 16384, CT = 256, R = S + CT, D = 1024, FF = 3584, NE = 8;
constexpr int NCH = 130;
constexpr int ACT_ROWS = 2 * R + NE * 256;

constexpr size_t al(size_t x) { return (x + 255) & ~(size_t)255; }
constexpr size_t W_RGIN = 0;
constexpr size_t W_GATE = W_RGIN + al((size_t)2 * 2048 * 1024 * 2);
constexpr size_t W_RGOUT = W_GATE + al((size_t)2 * 4096 * 256 * 2);
constexpr size_t W_QKV = W_RGOUT + al((size_t)2 * 1024 * 1024 * 2);
constexpr size_t W_O = W_QKV + al((size_t)3072 * 1024 * 2);
constexpr size_t W_FT = W_O + al((size_t)1024 * 1024 * 2);
constexpr size_t W_FGU = W_FT + al((size_t)1024 * 1024 * 2);
constexpr size_t W_FDN = W_FGU + al((size_t)2 * 7168 * 1024 * 2);
constexpr size_t W_MGU = W_FDN + al((size_t)2 * 1024 * 3584 * 2);
constexpr size_t W_MDN = W_MGU + al((size_t)16 * 7168 * 1024 * 2);
constexpr size_t W_BC = W_MDN + al((size_t)16 * 1024 * 3584 * 2);
constexpr size_t W_D1 = W_BC + al((size_t)512 * 256 * 2);
constexpr size_t W_D3 = W_D1 + al((size_t)256 * 256 * 2);
constexpr size_t W_DC = W_D3 + al((size_t)128 * 256 * 2);
constexpr size_t O_MOD = W_DC + al((size_t)256 * 512 * 2);
constexpr size_t O_XC = O_MOD + al((size_t)4 * 2 * 6144 * 4);
constexpr size_t O_CNT = O_XC + al((size_t)CT * D * 4);
constexpr size_t O_LIST = O_CNT + al(256);
constexpr size_t O_LW = O_LIST + al((size_t)2 * NE * R * 4);
constexpr size_t O_BAR = O_LW + al((size_t)2 * NE * R * 4);
constexpr size_t O_ROUTE = O_BAR + al(16384);
constexpr size_t O_RW = O_ROUTE + al((size_t)R * 4);
constexpr size_t O_H = O_RW + al((size_t)R * 8);
constexpr size_t O_ACT = O_H + al((size_t)R * D * 2);
constexpr size_t O_MIX = O_ACT + al((size_t)ACT_ROWS * FF * 2);
constexpr size_t RB = (size_t)R * D * 2;
constexpr size_t M_XZ = O_MIX, M_GG = M_XZ + al(RB), M_XL = M_GG + al(RB), M_LA = M_XL + al(RB), M_IX = M_LA + al(2 * RB),
                 M_TMP = M_IX + al(2 * RB), M_YIN = M_TMP + al(2 * RB), M_CA = M_YIN + al(RB), M_CB = M_CA + al((size_t)2 * 260 * D * 4),
                 M_END_RG = M_CB + al((size_t)2 * 260 * D * 4);
constexpr size_t M_Y = O_MIX;
constexpr size_t M_Q = O_MIX, M_K = M_Q + al(RB), M_VT = M_K + al(RB), M_O = M_VT + al(RB);
constexpr size_t M_UT = O_MIX, M_UTC = M_UT + al((size_t)S * 2048 * 2), M_AT = M_UTC + al((size_t)CT * 2048 * 2), M_F = M_AT + al((size_t)S * 2048 * 2);

struct Job { const float* src; bf16_t* dst; int K, N, nb, tiles; long long ss, ds; };
constexpr int NJOB = 24;
struct Prm {
  const float *x, *c, *ctx, *cctx, *ada_w, *ada_b, *norm_g, *conv_w, *conv_b, *rg_ba, *rg_bi, *rg_lam, *na_qg, *na_kg, *na_rpb, *router;
  float* out; unsigned char* ws;
  Job jobs[NJOB]; int njob; int never;
};

DI int otid() { int t = threadIdx.x; asm volatile("" : "+v"(t)); return t; }
DI int obid() { int t = blockIdx.x; asm volatile("" : "+s"(t)); return t; }
DI int ogrid() { int t = gridDim.x; asm volatile("" : "+s"(t)); return t; }
DI bf16_t f2bf(float x) { unsigned u = __float_as_uint(x); u += 0x7fffu + ((u >> 16) & 1u); return (bf16_t)(u >> 16); }
DI float bf2f(bf16_t h) { return __uint_as_float(((unsigned)h) << 16); }
DI unsigned pack2(float a, float b) { return (unsigned)f2bf(a) | ((unsigned)f2bf(b) << 16); }
DI uint2 pack4(f32x4 v) { return make_uint2(pack2(v[0], v[1]), pack2(v[2], v[3])); }
DI void unpack4(uint2 v, float* o) { o[0] = __uint_as_float(v.x << 16); o[1] = __uint_as_float(v.x & 0xffff0000u); o[2] = __uint_as_float(v.y << 16); o[3] = __uint_as_float(v.y & 0xffff0000u); }
DI int perm8(int r) { return (r & ~31) + ((r >> 2) & 3) * 8 + ((r >> 4) & 1) * 4 + (r & 3); }
DI uint4 pack8(f32x4 a, f32x4 b) { const uint2 x = pack4(a), y = pack4(b); return make_uint4(x.x, x.y, y.x, y.y); }
DI float sigm(float v) { return 1.f / (1.f + __expf(-v)); }
DI float siluf(float v) { return v / (1.f + __expf(-v)); }
DI float gelut(float v) { float u = 0.7978845608f * (v + 0.044715f * v * v * v); float t = 1.f - 2.f / (__expf(2.f * u) + 1.f); return 0.5f * v * (1.f + t); }
DI float softplus_neg(float lam) { const float x = __expf(-lam); return x < 0.05f ? x * (1.f - x * (0.5f - x * (1.f / 3.f - 0.25f * x))) : __logf(1.f + x); }
DI void sincos_rev(float rev, float* s, float* c) { *s = __builtin_amdgcn_sinf(rev); *c = __builtin_amdgcn_cosf(rev); }
DI float wsum(float v) { for (int o = 32; o; o >>= 1) v += __shfl_xor(v, o); return v; }
DI const float* xrow_in(const Prm& p, int r) { return r < S ? p.x + (size_t)r * D : p.ctx + (size_t)(r - S) * D; }
DI float* xrow(const Prm& p, int r) { return r < S ? p.out + (size_t)r * D : (float*)(p.ws + O_XC) + (size_t)(r - S) * D; }

constexpr int NTHR = 512;
constexpr int LDSS = 72;
constexpr int SMEM_BYTES = 2 * 512 * LDSS * 2;
constexpr int CV_P0 = 1024, CV_L0_IN = 4024, CV_L0_GATES = 5024, CV_L0_OUT = 5324, CV_L0_GU = 8824, CV_L0_DN = 14824, CV_L1_QKV = 20024, CV_L1_O = 21024,
              CV_L1_MGU = 26240, CV_L1_MDN = 42240, CV_L2_GU = 45740, CV_L2_DN = 49740, CV_L3_IN = 51240, CV_L3_GATES = 51712, CV_L3_OUT = 51712, CV_TOTAL = 51712;
__shared__ Job g_jobs_s[NJOB];
#define g_jobs ((const Job*)g_jobs_s)
struct CvTile { const float* src; bf16_t* dst; int N, K, valid, pad; };
DI CvTile cv_tile(const Job* jobs, int t, int c0, int c1) {
  CvTile r; r.valid = t < c1; r.pad = 0;
  int j = 0, tt = r.valid ? t : c0;
  while (tt >= jobs[j].tiles) { tt -= jobs[j].tiles; ++j; }
  const Job jb = jobs[j];
  const int tk = jb.K >> 6, tn = jb.N >> 6, per = tk * tn;
  const int bi = tt / per, rr = tt % per, kt = rr % tk, nt = rr / tk;
  r.src = jb.src + (size_t)bi * jb.ss + (size_t)(kt * 64) * jb.N + nt * 64;
  r.dst = jb.dst + (size_t)bi * jb.ds + (size_t)(nt * 64) * jb.K + kt * 64;
  r.N = jb.N; r.K = jb.K;
  return r;
}
DI void conv_range(const Prm& p, int c0, int c1, bf16_t* smraw, int widx = -1, int wn = 0) {
  if (c0 >= c1) return;
  const int tid = otid(), G = widx < 0 ? ogrid() : wn, b = widx < 0 ? obid() : widx;
  float* smf = (float*)smraw;
  const int half = tid >> 8, vt = tid & 255;
  float* smh = smf + half * (64 * 65);
  const int kr = vt >> 4, nc = (vt & 15) * 4;
  int t0 = c0 + b * 2;
  if (t0 >= c1) { __syncthreads(); return; }
  CvTile cur = cv_tile(g_jobs, t0 + half, c0, c1);
  float4 v[4];
#pragma unroll
  for (int i = 0; i < 4; ++i) v[i] = *(const float4*)(cur.src + (size_t)(kr + 16 * i) * cur.N + nc);
  for (; t0 < c1; t0 += 2 * G) {
    const bool more = t0 + 2 * G < c1;
    CvTile nx = cur; float4 vn[4];
    if (more) {
      nx = cv_tile(g_jobs, t0 + 2 * G + half, c0, c1);
#pragma unroll
      for (int i = 0; i < 4; ++i) vn[i] = *(const float4*)(nx.src + (size_t)(kr + 16 * i) * nx.N + nc);
    }
    __syncthreads();
#pragma unroll
    for (int i = 0; i < 4; ++i) { float* d = smh + (kr + 16 * i) * 65 + nc; d[0] = v[i].x; d[1] = v[i].y; d[2] = v[i].z; d[3] = v[i].w; }
    __syncthreads();
    if (cur.valid) {
      const int n = vt >> 2, kp = (vt & 3) * 16;
      unsigned o[8];
#pragma unroll
      for (int q = 0; q < 8; ++q) o[q] = pack2(smh[(kp + 2 * q) * 65 + n], smh[(kp + 2 * q + 1) * 65 + n]);
      uint4* d4 = (uint4*)(cur.dst + (size_t)n * cur.K + kp);
      d4[0] = make_uint4(o[0], o[1], o[2], o[3]); d4[1] = make_uint4(o[4], o[5], o[6], o[7]);
    }
    if (more) {
      cur = nx;
#pragma unroll
      for (int i = 0; i < 4; ++i) v[i] = vn[i];
    }
  }
  __syncthreads();
}

template <bool NAT, int MI, int WM, int WN, class F>
DI void gemm_stream(int MT, int NT, int K, bf16_t* sm, const void* gbase, F f, const Prm* cvp = nullptr, int cv0 = 0, int cv1 = 0, int lo = 0, int hi = -1, int SUB = 1) {
  constexpr int BM = WM * MI * 16, BN = WN * 64, AR = BM / 64, BR = BN / 64, STG = (BM + BN) * LDSS;
  static_assert(WM * WN == 8, "8 waves");
  const int G = ogrid(), b = obid(), nbx = G >> 3, xcd = b & 7, li = b >> 3;
  if (hi < 0) hi = MT * NT;
  const int T = (hi - lo) * SUB;
  const int full = NT >> 3, wl = NT & 7, gsz = MT * 8;
  const int start = (int)(((long long)T * xcd) >> 3) + li, end = (int)(((long long)T * (xcd + 1)) >> 3);
  const int ntb = start < end ? (end - start + nbx - 1) / nbx : 0;
  if (ntb > 0) {
  auto tile_at = [&](int j, int& mt, int& nt) {
    const int item = start + j * nbx, idx = lo + item / SUB, sb = item % SUB, g = idx / gsz;
    if (g < full) { const int rem = idx - g * gsz; mt = rem >> 3; nt = g * 8 + (rem & 7); }
    else { const int rem = idx - full * gsz; mt = rem / wl; nt = full * 8 + rem % wl; }
    if (SUB == 8) { mt = mt * 4 + (sb >> 1); nt = nt * 2 + (sb & 1); }
  };
  const int tid = otid(), lane = tid & 63, wid = tid >> 6, wm = wid / WN, wn = wid % WN;
  const int lr = tid >> 3, lc = (tid & 7) * 8;
  const char* const gb = (const char*)gbase;
  unsigned ap[AR], bp[BR];
  auto set_offs = [&](int j) {
    int mt, nt; tile_at(j, mt, nt);
    f(mt, nt, [&](auto&& a, auto&& bfn, auto&& ep) {
#pragma unroll
      for (int i = 0; i < AR; ++i) ap[i] = (unsigned)((const char*)a(lr + 64 * i) - gb) + lc * 2;
#pragma unroll
      for (int i = 0; i < BR; ++i) bp[i] = (unsigned)((const char*)bfn(lr + 64 * i) - gb) + lc * 2;
    });
  };
  u32x4 ra[AR], rb[BR];
  f32x4 acc[MI][4];
#pragma unroll
  for (int i = 0; i < MI; ++i)
#pragma unroll
    for (int j = 0; j < 4; ++j) acc[i][j] = (f32x4){0.f, 0.f, 0.f, 0.f};
  const int nk = K / 64, Q = ntb * nk;
  const int fro = (lane & 15) * LDSS + (lane >> 4) * 8;
  set_offs(0);
#pragma unroll
  for (int i = 0; i < AR; ++i) ra[i] = *(const u32x4*)(gb + ap[i]);
#pragma unroll
  for (int i = 0; i < BR; ++i) rb[i] = *(const u32x4*)(gb + bp[i]);
#pragma unroll
  for (int i = 0; i < AR; ++i) *(u32x4*)(sm + (lr + 64 * i) * LDSS + lc) = ra[i];
#pragma unroll
  for (int i = 0; i < BR; ++i) *(u32x4*)(sm + BM * LDSS + (lr + 64 * i) * LDSS + lc) = rb[i];
#pragma unroll
  for (int i = 0; i < AR; ++i) ra[i] = *(const u32x4*)(gb + 128 + ap[i]);
#pragma unroll
  for (int i = 0; i < BR; ++i) rb[i] = *(const u32x4*)(gb + 128 + bp[i]);
  __syncthreads();
  int kt = 0, jt = 0;
  for (int q = 0; q < Q; ++q) {
    bf16_t* sA = sm + (q & 1) * STG; bf16_t* sB = sA + BM * LDSS;
    constexpr int FA = MI < 4 ? MI : 4, HG = MI / FA, NG = 2 * HG;
    bf16x8 fb[2][4], fa[2][FA];
    const bf16_t* pA = sA + (wm * MI * 16) * LDSS + fro; const bf16_t* pB = sB + (wn * 64) * LDSS + fro;
#pragma unroll
    for (int j = 0; j < 4; ++j) fb[0][j] = *(const bf16x8*)(pB + (j * 16) * LDSS);
#pragma unroll
    for (int i = 0; i < FA; ++i) fa[0][i] = *(const bf16x8*)(pA + (i * 16) * LDSS);
    __builtin_amdgcn_sched_barrier(0);
    if (q + 1 < Q) {
      bf16_t* nA = sm + ((q + 1) & 1) * STG; bf16_t* nB = nA + BM * LDSS;
#pragma unroll
      for (int i = 0; i < AR; ++i) *(u32x4*)(nA + (lr + 64 * i) * LDSS + lc) = ra[i];
#pragma unroll
      for (int i = 0; i < BR; ++i) *(u32x4*)(nB + (lr + 64 * i) * LDSS + lc) = rb[i];
    }
    if (q + 2 < Q) {
      int kt2 = kt + 2;
      if (kt2 >= nk) { kt2 -= nk; if (kt2 == 0) set_offs(jt + 1); }
      const char* gk = gb + kt2 * 128;
#pragma unroll
      for (int i = 0; i < AR; ++i) ra[i] = *(const u32x4*)(gk + ap[i]);
#pragma unroll
      for (int i = 0; i < BR; ++i) rb[i] = *(const u32x4*)(gk + bp[i]);
    }
    __builtin_amdgcn_sched_barrier(0);
    {
#pragma unroll
      for (int gi = 0; gi < NG; ++gi) {
        const int ks = gi / HG;
        if (gi + 1 < NG) {
          const int ks1 = (gi + 1) / HG, h1 = (gi + 1) % HG;
          if (ks1 != ks) {
#pragma unroll
            for (int j = 0; j < 4; ++j) fb[ks1 & 1][j] = *(const bf16x8*)(pB + (j * 16) * LDSS + ks1 * 32);
          }
#pragma unroll
          for (int i = 0; i < FA; ++i) fa[(gi + 1) & 1][i] = *(const bf16x8*)(pA + ((h1 * FA + i) * 16) * LDSS + ks1 * 32);
        }
        const int h = gi % HG;
#pragma unroll
        for (int i = 0; i < FA; ++i)
#pragma unroll
          for (int j = 0; j < 4; ++j)
            acc[h * FA + i][j] = NAT ? MFMA16(fa[gi & 1][i], fb[ks & 1][j], acc[h * FA + i][j]) : MFMA16(fb[ks & 1][j], fa[gi & 1][i], acc[h * FA + i][j]);
        __builtin_amdgcn_sched_barrier(0);
      }
    }
    if (kt == nk - 1) {
      int mt, nt; tile_at(jt, mt, nt);
      f(mt, nt, [&](auto&& a, auto&& bfn, auto&& ep) { ep(acc, wm, wn, lane); });
#pragma unroll
      for (int i = 0; i < MI; ++i)
#pragma unroll
        for (int j = 0; j < 4; ++j) acc[i][j] = (f32x4){0.f, 0.f, 0.f, 0.f};
      kt = 0; ++jt;
    } else ++kt;
    __syncthreads();
  }
  }
  if (cvp && cv0 < cv1) {
    int n_idle = 0, my_idx = -1;
#pragma unroll
    for (int x = 0; x < 8; ++x) {
      const int sx = (int)(((long long)T * x) >> 3), ex = (int)(((long long)T * (x + 1)) >> 3), rem = (ex - sx) % nbx;
      if (rem) { if (x == xcd && li >= rem) my_idx = n_idle + (li - rem); n_idle += nbx - rem; }
    }
    if (n_idle == 0) conv_range(*cvp, cv0, cv1, sm);
    else if (my_idx >= 0) conv_range(*cvp, cv0, cv1, sm, my_idx, n_idle);
  }
}

template <bool NAT, class FB, class FS>
DI void gemm_split(bool split, int MT, int NT, int K, bf16_t* sm, const void* gbase, FB fb, FS fs, const Prm* cvp = nullptr, int cv0 = 0, int cv1 = 0) {
  if (!split) { gemm_stream<NAT, 8, 2, 4>(MT, NT, K, sm, gbase, fb, cvp, cv0, cv1); return; }
  const int T = MT * NT, G = ogrid(), tfull = (T / G) * G;
  if (tfull > 0) gemm_stream<NAT, 8, 2, 4>(MT, NT, K, sm, gbase, fb, nullptr, 0, 0, 0, tfull, 1);
  if (tfull < T) gemm_stream<NAT, 1, 4, 2>(MT, NT, K, sm, gbase, fs, cvp, cv0, cv1, tfull, T, 8);
  else if (cvp && cv0 < cv1) conv_range(*cvp, cv0, cv1, sm);
}

DI int ileave(int pc, int half) { const int q = pc >> 6, w = pc & 63; return (w < 32) ? q * 32 + w : half + q * 32 + (w - 32); }
DI int ileave8(int pc, int half) { const int q = pc >> 6, w = pc & 63, c = w & 31, j = c >> 4, g = (c >> 2) & 3, e = c & 3; return (w < 32 ? 0 : half) + q * 32 + 8 * g + 4 * j + e; }

DI void phase0(const Prm& p, bf16_t* smraw) {
  const int tid = otid(), G = ogrid(), b = obid();
  float* smf = (float*)smraw;
  for (int u = b; u < 384; u += G) {
    const int l = u / 96, cg0 = (u % 96) * 64, kq = tid >> 4, cq = tid & 15;
    const float* w = p.ada_w + ((size_t)l * 1024 + kq * 32) * 6144 + cg0 + cq * 4;
    float4 a0 = make_float4(0, 0, 0, 0), a1 = a0;
#pragma unroll 8
    for (int k = 0; k < 32; ++k) {
      const float4 wv = *(const float4*)(w + (size_t)k * 6144);
      const float s0 = siluf(p.c[kq * 32 + k]), s1 = siluf(p.cctx[kq * 32 + k]);
      a0.x += s0 * wv.x; a0.y += s0 * wv.y; a0.z += s0 * wv.z; a0.w += s0 * wv.w;
      a1.x += s1 * wv.x; a1.y += s1 * wv.y; a1.z += s1 * wv.z; a1.w += s1 * wv.w;
    }
    __syncthreads();
    *(float4*)(smf + (kq * 16 + cq) * 8) = a0; *(float4*)(smf + (kq * 16 + cq) * 8 + 4) = a1;
    __syncthreads();
    if (tid < 128) {
      const int wsel = tid >> 6, col = tid & 63; float s = 0.f;
      for (int q = 0; q < 32; ++q) s += smf[(q * 16 + (col >> 2)) * 8 + wsel * 4 + (col & 3)];
      float* mod = (float*)(p.ws + O_MOD);
      mod[(size_t)(l * 2 + wsel) * 6144 + cg0 + col] = s + p.ada_b[(size_t)l * 6144 + cg0 + col];
    }
    __syncthreads();
  }
  if (b == G - 1 && tid < 64) ((int*)(p.ws + O_CNT))[tid] = 0;
  {
    const int gt = b * NTHR + tid, gn = G * NTHR;
    bf16_t* Bc = (bf16_t*)(p.ws + W_BC); bf16_t* D1 = (bf16_t*)(p.ws + W_D1); bf16_t* D3 = (bf16_t*)(p.ws + W_D3); bf16_t* Dc = (bf16_t*)(p.ws + W_DC);
    for (int e = gt; e < 512 * 256; e += gn) { const int rr = e >> 8, c = e & 255, ri = rr >> 8, m = rr & 255; float sn, cs; sincos_rev((float)((m * c) & 255) / 256.f, &sn, &cs); Bc[e] = f2bf((ri ? -sn : cs) * 0.0625f); }
    for (int e = gt; e < 256 * 256; e += gn) { const int rr = e >> 8, c = e & 255, ri = rr >> 7, k1 = rr & 127, ri2 = c >> 7, t1 = c & 127; float sn, cs; sincos_rev((float)((k1 * t1) & 127) / 128.f, &sn, &cs);
      const float v = (ri == ri2) ? cs : (ri == 0 ? sn : -sn); D1[e] = f2bf(v * 0.08838834764831845f); }
    for (int e = gt; e < 128 * 256; e += gn) { const int k2 = e >> 8, c = e & 255, ri = c >> 7, t2 = c & 127; float sn, cs; sincos_rev((float)((k2 * t2) & 127) / 128.f, &sn, &cs); D3[e] = f2bf((ri ? sn : cs) * 0.08838834764831845f); }
    for (int e = gt; e < 256 * 512; e += gn) { const int k = e >> 9, c = e & 511, ri = c >> 8, t = c & 255; float sn, cs; sincos_rev((float)((k * t) & 255) / 256.f, &sn, &cs); Dc[e] = f2bf((ri ? sn : cs) * 0.0625f); }
  }
  conv_range(p, 0, CV_P0, smraw);
}

DI void norm_phase(const Prm& p, int l, int which, int moe_idx, bf16_t* smraw, int comb_l = -1) {
  const int lane = otid() & 63, wv = obid() * 8 + (otid() >> 6), nw = ogrid() * 8;
  const float* g = p.norm_g + (size_t)(l * 2 + which) * D;
  const float* mod = (const float*)(p.ws + O_MOD);
  bf16_t* H = (bf16_t*)(p.ws + O_H);
  float* rts = (float*)smraw;
  if (moe_idx >= 0) {
    const float4* rsrc = (const float4*)(p.router + (size_t)moe_idx * D * NE);
    for (int e = otid(); e < D * NE / 4; e += NTHR) ((float4*)rts)[e] = rsrc[e];
    __syncthreads();
  }
  f32x4 gs0[4], sv0[4];
  {
    const float* sh = mod + (size_t)(l * 2) * 6144 + (which ? 3 : 0) * D; const float* sc = mod + (size_t)(l * 2) * 6144 + (which ? 4 : 1) * D;
#pragma unroll
    for (int i = 0; i < 4; ++i) {
      const int col = i * 256 + lane * 4;
      const float4 g4 = *(const float4*)(g + col), s4 = *(const float4*)(sc + col);
      gs0[i] = (f32x4){g4.x * (1.f + s4.x), g4.y * (1.f + s4.y), g4.z * (1.f + s4.z), g4.w * (1.f + s4.w)}; sv0[i] = *(const f32x4*)(sh + col);
    }
  }
  const bf16_t* Ycmb = (const bf16_t*)(p.ws + M_Y);
  auto load_row = [&](int r, f32x4 (&dst)[4]) {
    const float* xr = (l == 0 && which == 0) ? xrow_in(p, r) : (const float*)xrow(p, r);
#pragma unroll
    for (int i = 0; i < 4; ++i) dst[i] = *(const f32x4*)(xr + i * 256 + lane * 4);
    if (comb_l >= 0) {
      const float* g5 = mod + (size_t)(comb_l * 2 + (r >= S ? 1 : 0)) * 6144 + 5 * D;
#pragma unroll
      for (int i = 0; i < 4; ++i) {
        const int col = i * 256 + lane * 4;
        const uint2 u0 = *(const uint2*)(Ycmb + (size_t)(2 * r) * D + col), u1 = *(const uint2*)(Ycmb + (size_t)(2 * r + 1) * D + col);
        float a0[4], a1[4]; unpack4(u0, a0); unpack4(u1, a1);
        const f32x4 ys = {a0[0] + a1[0], a0[1] + a1[1], a0[2] + a1[2], a0[3] + a1[3]};
        dst[i] += *(const f32x4*)(g5 + col) * ys;
      }
    }
  };
  f32x4 v[4];
  if (wv < R) load_row(wv, v);
  for (int r = wv; r < R; r += nw) {
    f32x4 vn[4];
    const bool more = r + nw < R;
    if (more) load_row(r + nw, vn);
    if (comb_l >= 0) {
      float* xw = xrow(p, r);
#pragma unroll
      for (int i = 0; i < 4; ++i) *(f32x4*)(xw + i * 256 + lane * 4) = v[i];
    }
    float ss = 0.f;
#pragma unroll
    for (int i = 0; i < 4; ++i) ss += v[i][0] * v[i][0] + v[i][1] * v[i][1] + v[i][2] * v[i][2] + v[i][3] * v[i][3];
    ss = wsum(ss);
    const float rstd = rsqrtf(ss * (1.f / 1024.f) + 1e-6f);
    float lg[8];
#pragma unroll
    for (int e = 0; e < 8; ++e) lg[e] = 0.f;
#pragma unroll
    for (int i = 0; i < 4; ++i) {
      const int col = i * 256 + lane * 4;
      f32x4 gs = gs0[i], sv = sv0[i];
      if (r >= S) {
        const float* md = mod + (size_t)(l * 2 + 1) * 6144;
        const float4 g4 = *(const float4*)(g + col), s4 = *(const float4*)(md + (which ? 4 : 1) * D + col);
        gs = (f32x4){g4.x * (1.f + s4.x), g4.y * (1.f + s4.y), g4.z * (1.f + s4.z), g4.w * (1.f + s4.w)}; sv = *(const f32x4*)(md + (which ? 3 : 0) * D + col);
      }
      f32x4 h;
      h = v[i] * rstd * gs + sv;
      *(uint2*)(H + (size_t)r * D + col) = pack4(h);
      if (moe_idx >= 0) {
        const float* rt = rts + (size_t)col * NE;
#pragma unroll
        for (int q = 0; q < 4; ++q) {
          const float4 r0 = *(const float4*)(rt + q * 8), r1 = *(const float4*)(rt + q * 8 + 4);
          lg[0] += h[q] * r0.x; lg[1] += h[q] * r0.y; lg[2] += h[q] * r0.z; lg[3] += h[q] * r0.w;
          lg[4] += h[q] * r1.x; lg[5] += h[q] * r1.y; lg[6] += h[q] * r1.z; lg[7] += h[q] * r1.w;
        }
      }
    }
    if (moe_idx >= 0) {
#pragma unroll
      for (int e = 0; e < 8; ++e) lg[e] = wsum(lg[e]);
      if (lane == 0) {
        int i0 = 0; float v0 = lg[0];
#pragma unroll
        for (int e = 1; e < 8; ++e) if (lg[e] > v0) { v0 = lg[e]; i0 = e; }
        int i1 = -1; float v1 = -3.0e38f;
#pragma unroll
        for (int e = 0; e < 8; ++e) if (e != i0 && lg[e] > v1) { v1 = lg[e]; i1 = e; }
        const float w0 = 1.f / (1.f + __expf(v1 - v0)), w1 = 1.f - w0;
        ((int*)(p.ws + O_ROUTE))[r] = i0 | (i1 << 8); ((float2*)(p.ws + O_RW))[r] = make_float2(w0, w1);
      }
    }
    if (more) {
#pragma unroll
      for (int i = 0; i < 4; ++i) v[i] = vn[i];
    }
  }
}

template <int MI, int BM, int BN, class ACC>
DI void resid_epi(const Prm& p, ACC& acc, int row0, int col0, int l, int gchunk, int lane) {
  const float* mod = (const float*)(p.ws + O_MOD);
#pragma unroll
  for (int i = 0; i < MI; ++i) {
    const int row = row0 + i * 16 + (lane & 15);
    float* xr = xrow(p, row);
    const float* xs = (l == 0 && gchunk == 2) ? xrow_in(p, row) : (const float*)xr;
    const float* gt = mod + (size_t)(l * 2 + (row >= S ? 1 : 0)) * 6144 + gchunk * D;
#pragma unroll
    for (int j = 0; j < 4; ++j) {
      const int col = col0 + j * 16 + 4 * (lane >> 4);
      const float4 g4 = *(const float4*)(gt + col); float4 xv = *(const float4*)(xs + col);
      xv.x += g4.x * acc[i][j][0]; xv.y += g4.y * acc[i][j][1]; xv.z += g4.z * acc[i][j][2]; xv.w += g4.w * acc[i][j][3];
      *(float4*)(xr + col) = xv;
    }
  }
}
DI void resid_gemm(const Prm& p, const bf16_t* A, int K, const bf16_t* Wt, int l, int gchunk, bf16_t* sm, int cv0 = 0, int cv1 = 0) {
  gemm_split<false>(true, R / 256, D / 256, K, sm, p.ws,
    [&](int mt, int nt, auto&& use) {
      use([&](int r) { return A + (size_t)(mt * 256 + r) * K; },
          [&](int r) { return Wt + (size_t)(nt * 256 + r) * K; },
          [&](f32x4 (&acc)[8][4], int wm, int wn, int lane) { resid_epi<8, 256, 256>(p, acc, mt * 256 + wm * 128, nt * 256 + wn * 64, l, gchunk, lane); });
    },
    [&](int mt, int nt, auto&& use) {
      use([&](int r) { return A + (size_t)(mt * 64 + r) * K; },
          [&](int r) { return Wt + (size_t)(nt * 128 + r) * K; },
          [&](f32x4 (&acc)[1][4], int wm, int wn, int lane) { resid_epi<1, 64, 128>(p, acc, mt * 64 + wm * 16, nt * 128 + wn * 64, l, gchunk, lane); });
    }, &p, cv0, cv1);
}

template <int MI, class ACC>
DI void swiglu_epi(bf16_t* ACT, ACC& acc, int row0, int ff0, int lane) {
#pragma unroll
  for (int i = 0; i < MI; ++i) {
    const int row = row0 + i * 16 + (lane & 15), ff = ff0 + 8 * (lane >> 4);
    f32x4 o0, o1;
#pragma unroll
    for (int q = 0; q < 4; ++q) { o0[q] = siluf(acc[i][0][q]) * acc[i][2][q]; o1[q] = siluf(acc[i][1][q]) * acc[i][3][q]; }
    const uint2 w0 = pack4(o0), w1 = pack4(o1);
    *(uint4*)(ACT + (size_t)row * FF + ff) = make_uint4(w0.x, w0.y, w1.x, w1.y);
  }
}
DI void ffn_gu(const Prm& p, const bf16_t* Wt, bf16_t* sm, int cv0 = 0, int cv1 = 0) {
  const bf16_t* H = (const bf16_t*)(p.ws + O_H); bf16_t* ACT = (bf16_t*)(p.ws + O_ACT);
  gemm_split<false>(false, R / 256, 2 * FF / 256, D, sm, p.ws,
    [&](int mt, int nt, auto&& use) {
      use([&](int r) { return H + (size_t)(mt * 256 + r) * D; },
          [&](int r) { return Wt + (size_t)ileave8(nt * 256 + r, FF) * D; },
          [&](f32x4 (&acc)[8][4], int wm, int wn, int lane) { swiglu_epi<8>(ACT, acc, mt * 256 + wm * 128, (nt * 4 + wn) * 32, lane); });
    },
    [&](int mt, int nt, auto&& use) {
      use([&](int r) { return H + (size_t)(mt * 64 + r) * D; },
          [&](int r) { return Wt + (size_t)ileave8(nt * 128 + r, FF) * D; },
          [&](f32x4 (&acc)[1][4], int wm, int wn, int lane) { swiglu_epi<1>(ACT, acc, mt * 64 + wm * 16, (nt * 2 + wn) * 32, lane); });
    }, &p, cv0, cv1);
}

struct MoeMap { int ntiles; int ts1, ts2, ts3, ts4, ts5, ts6, ts7; };
DI void moe_map(const Prm& p, int moe_idx, MoeMap& m) {
  const int* cnt = (const int*)(p.ws + O_CNT) + moe_idx * 8;
  int ts = 0;
  ts += (cnt[0] + 255) >> 8; m.ts1 = ts; ts += (cnt[1] + 255) >> 8; m.ts2 = ts; ts += (cnt[2] + 255) >> 8; m.ts3 = ts; ts += (cnt[3] + 255) >> 8; m.ts4 = ts;
  ts += (cnt[4] + 255) >> 8; m.ts5 = ts; ts += (cnt[5] + 255) >> 8; m.ts6 = ts; ts += (cnt[6] + 255) >> 8; m.ts7 = ts; ts += (cnt[7] + 255) >> 8; m.ntiles = ts;
}
DI void moe_find(const Prm& p, int moe_idx, const MoeMap& m, int mt, int& e, int& lt, int& ce) {
  e = 0; int st = 0;
  if (mt >= m.ts1) { e = 1; st = m.ts1; } if (mt >= m.ts2) { e = 2; st = m.ts2; } if (mt >= m.ts3) { e = 3; st = m.ts3; } if (mt >= m.ts4) { e = 4; st = m.ts4; }
  if (mt >= m.ts5) { e = 5; st = m.ts5; } if (mt >= m.ts6) { e = 6; st = m.ts6; } if (mt >= m.ts7) { e = 7; st = m.ts7; }
  lt = mt - st; ce = ((const int*)(p.ws + O_CNT))[moe_idx * 8 + e];
}

DI void moe_route(const Prm& p, int moe_idx, bf16_t* smraw) {
  const int b = obid(), tid = otid(), e = b & 7, seg = b >> 3, nseg = ogrid() >> 3, SEG = (R + nseg - 1) / nseg;
  int* sc = (int*)smraw;
  const int* route = (const int*)(p.ws + O_ROUTE); const float2* rw = (const float2*)(p.ws + O_RW);
  int* list = (int*)(p.ws + O_LIST) + ((size_t)moe_idx * NE + e) * R; float* lw = (float*)(p.ws + O_LW) + ((size_t)moe_idx * NE + e) * R;
  const int lane = tid & 63, wid = tid >> 6;
  int c = 0;
  const int tend = min(seg * SEG, R);
  for (int t = tid; t < tend; t += 8 * NTHR) {
    int rt[8];
#pragma unroll
    for (int u = 0; u < 8; ++u) rt[u] = (t + u * NTHR < tend) ? route[t + u * NTHR] : -1;
#pragma unroll
    for (int u = 0; u < 8; ++u) c += (rt[u] >= 0) & (((rt[u] & 255) == e) | ((rt[u] >> 8) == e));
  }
  for (int o = 32; o; o >>= 1) c += __shfl_xor(c, o);
  const int t0 = seg * SEG;
  const int ta = t0 + tid, tb = t0 + NTHR + tid;
  const bool ha = tid < SEG && ta < R, hb = NTHR + tid < SEG && tb < R;
  const int ra = ha ? route[ta] : -1, rb = hb ? route[tb] : -1;
  const bool ma = ha && (((ra & 255) == e) | ((ra >> 8) == e)), mb = hb && (((rb & 255) == e) | ((rb >> 8) == e));
  const unsigned long long ba = __ballot(ma), bb = __ballot(mb);
  const unsigned long long below = (1ull << lane) - 1ull;
  __syncthreads();
  if (lane == 0) { sc[wid] = c; sc[8 + wid] = __popcll(ba); sc[16 + wid] = __popcll(bb); }
  __syncthreads();
  int base = 0, tota = 0, prea = 0, preb = 0;
#pragma unroll
  for (int w = 0; w < 8; ++w) { base += sc[w]; tota += sc[8 + w]; if (w < wid) { prea += sc[8 + w]; preb += sc[16 + w]; } }
  int totb = 0;
#pragma unroll
  for (int w = 0; w < 8; ++w) totb += sc[16 + w];
  if (ma) { const int pos = base + prea + __popcll(ba & below); const float2 w = rw[ta]; list[pos] = ta * 2 + (((ra & 255) == e) ? 0 : 1); lw[pos] = ((ra & 255) == e) ? w.x : w.y; }
  if (mb) { const int pos = base + tota + preb + __popcll(bb & below); const float2 w = rw[tb]; list[pos] = tb * 2 + (((rb & 255) == e) ? 0 : 1); lw[pos] = ((rb & 255) == e) ? w.x : w.y; }
  if (seg == nseg - 1 && tid == 0) ((int*)(p.ws + O_CNT))[moe_idx * 8 + e] = base + tota + totb;
  __syncthreads();
}
DI void moe_combine(const Prm& p, int l) {
  const bf16_t* Y = (const bf16_t*)(p.ws + M_Y); const float* mod = (const float*)(p.ws + O_MOD);
  const int gt = obid() * NTHR + otid(), gn = ogrid() * NTHR;
  for (int e = gt; e < R * 256; e += gn) {
    const int r = e >> 8, c = (e & 255) * 4;
    float* xr = xrow(p, r) + c;
    const float4 g4 = *(const float4*)(mod + (size_t)(l * 2 + (r >= S ? 1 : 0)) * 6144 + 5 * D + c);
    const uint2 u0 = *(const uint2*)(Y + (size_t)(2 * r) * D + c), u1 = *(const uint2*)(Y + (size_t)(2 * r + 1) * D + c);
    float y0[4], y1[4]; unpack4(u0, y0); unpack4(u1, y1);
    float4 xv = *(float4*)xr;
    xv.x += g4.x * (y0[0] + y1[0]); xv.y += g4.y * (y0[1] + y1[1]); xv.z += g4.z * (y0[2] + y1[2]); xv.w += g4.w * (y0[3] + y1[3]);
    *(float4*)xr = xv;
  }
}
DI void moe_gu(const Prm& p, int moe_idx, bf16_t* sm, int cv0 = 0, int cv1 = 0) {
  MoeMap m; moe_map(p, moe_idx, m);
  const bf16_t* H = (const bf16_t*)(p.ws + O_H); bf16_t* ACT = (bf16_t*)(p.ws + O_ACT);
  const int* list = (const int*)(p.ws + O_LIST) + (size_t)moe_idx * NE * R;
  gemm_split<false>(cv0 >= cv1, m.ntiles, 2 * FF / 256, D, sm, p.ws,
    [&](int mt, int nt, auto&& use) {
      int e, lt, ce; moe_find(p, moe_idx, m, mt, e, lt, ce);
      const bf16_t* Wt = (const bf16_t*)(p.ws + W_MGU) + (size_t)(moe_idx * 8 + e) * 2 * FF * D;
      const int* le = list + (size_t)e * R;
      use([&](int r) { const int idx = min(lt * 256 + r, ce - 1); return H + (size_t)(le[idx] >> 1) * D; },
          [&](int r) { return Wt + (size_t)ileave8(nt * 256 + r, FF) * D; },
          [&](f32x4 (&acc)[8][4], int wm, int wn, int lane) { swiglu_epi<8>(ACT, acc, mt * 256 + wm * 128, (nt * 4 + wn) * 32, lane); });
    },
    [&](int mt, int nt, auto&& use) {
      int e, lt, ce; moe_find(p, moe_idx, m, mt >> 2, e, lt, ce);
      const bf16_t* Wt = (const bf16_t*)(p.ws + W_MGU) + (size_t)(moe_idx * 8 + e) * 2 * FF * D;
      const int* le = list + (size_t)e * R;
      use([&](int r) { const int idx = min(lt * 256 + (mt & 3) * 64 + r, ce - 1); return H + (size_t)(le[idx] >> 1) * D; },
          [&](int r) { return Wt + (size_t)ileave8(nt * 128 + r, FF) * D; },
          [&](f32x4 (&acc)[1][4], int wm, int wn, int lane) { swiglu_epi<1>(ACT, acc, mt * 64 + wm * 16, (nt * 2 + wn) * 32, lane); });
    }, &p, cv0, cv1);
}
template <int MI, class ACC>
DI void moedown_epi(const Prm& p, int moe_idx, ACC& acc, int e, int idx0, int ce, int col0, int lane) {
  const int* list = (const int*)(p.ws + O_LIST) + (size_t)moe_idx * NE * R;
  const float* lw = (const float*)(p.ws + O_LW) + (size_t)moe_idx * NE * R;
  bf16_t* Y = (bf16_t*)(p.ws + M_Y);
#pragma unroll
  for (int i = 0; i < MI; ++i) {
    const int idx = idx0 + i * 16 + (lane & 15);
    if (idx < ce) {
      const int slot = list[(size_t)e * R + idx]; const float w = lw[(size_t)e * R + idx];
      bf16_t* yr = Y + (size_t)slot * D;
#pragma unroll
      for (int j = 0; j < 4; j += 2) {
        const int col = col0 + (j >> 1) * 32 + 8 * (lane >> 4);
        *(uint4*)(yr + col) = pack8(acc[i][j] * w, acc[i][j + 1] * w);
      }
    }
  }
}
DI void moe_down(const Prm& p, int moe_idx, int l, bf16_t* sm, int cv0 = 0, int cv1 = 0) {
  MoeMap m; moe_map(p, moe_idx, m);
  const bf16_t* ACT = (const bf16_t*)(p.ws + O_ACT);
  gemm_split<false>(cv0 >= cv1, m.ntiles, D / 256, FF, sm, p.ws,
    [&](int mt, int nt, auto&& use) {
      int e, lt, ce; moe_find(p, moe_idx, m, mt, e, lt, ce);
      const bf16_t* Wt = (const bf16_t*)(p.ws + W_MDN) + (size_t)(moe_idx * 8 + e) * D * FF;
      use([&](int r) { return ACT + (size_t)(mt * 256 + r) * FF; },
          [&](int r) { return Wt + (size_t)(nt * 256 + perm8(r)) * FF; },
          [&](f32x4 (&acc)[8][4], int wm, int wn, int lane) { moedown_epi<8>(p, moe_idx, acc, e, lt * 256 + wm * 128, ce, nt * 256 + wn * 64, lane); });
    },
    [&](int mt, int nt, auto&& use) {
      int e, lt, ce; moe_find(p, moe_idx, m, mt >> 2, e, lt, ce);
      const bf16_t* Wt = (const bf16_t*)(p.ws + W_MDN) + (size_t)(moe_idx * 8 + e) * D * FF;
      use([&](int r) { return ACT + (size_t)(mt * 64 + r) * FF; },
          [&](int r) { return Wt + (size_t)(nt * 128 + perm8(r)) * FF; },
          [&](f32x4 (&acc)[1][4], int wm, int wn, int lane) { moedown_epi<1>(p, moe_idx, acc, e, lt * 256 + (mt & 3) * 64 + wm * 16, ce, nt * 128 + wn * 64, lane); });
    }, &p, cv0, cv1);
}

template <int MI, class ACC>
DI void inproj_epi(bf16_t* XZ, bf16_t* GG, ACC& acc, int row0, int col0, int lane) {
#pragma unroll
  for (int i = 0; i < MI; ++i) {
    const int row = row0 + i * 16 + (lane & 15);
#pragma unroll
    for (int jj = 0; jj < 4; jj += 2) {
      const int col = col0 + (jj >> 1) * 32 + 8 * (lane >> 4);
      if (col0 < D) *(uint4*)(XZ + (size_t)row * D + col) = pack8(acc[i][jj], acc[i][jj + 1]);
      else { f32x4 o0, o1; for (int q = 0; q < 4; ++q) { o0[q] = gelut(acc[i][jj][q]); o1[q] = gelut(acc[i][jj + 1][q]); } *(uint4*)(GG + (size_t)row * D + col - D) = pack8(o0, o1); }
    }
  }
}
DI void rg_inproj(const Prm& p, int j, bf16_t* sm, int cv0 = 0, int cv1 = 0) {
  const bf16_t* H = (const bf16_t*)(p.ws + O_H); const bf16_t* Wt = (const bf16_t*)(p.ws + W_RGIN) + (size_t)j * 2048 * D;
  bf16_t* XZ = (bf16_t*)(p.ws + M_XZ); bf16_t* GG = (bf16_t*)(p.ws + M_GG);
  gemm_split<false>(false, R / 256, 8, D, sm, p.ws,
    [&](int mt, int nt, auto&& use) {
      use([&](int r) { return H + (size_t)(mt * 256 + r) * D; },
          [&](int r) { return Wt + (size_t)(nt * 256 + perm8(r)) * D; },
          [&](f32x4 (&acc)[8][4], int wm, int wn, int lane) { inproj_epi<8>(XZ, GG, acc, mt * 256 + wm * 128, nt * 256 + wn * 64, lane); });
    },
    [&](int mt, int nt, auto&& use) {
      use([&](int r) { return H + (size_t)(mt * 64 + r) * D; },
          [&](int r) { return Wt + (size_t)(nt * 128 + perm8(r)) * D; },
          [&](f32x4 (&acc)[1][4], int wm, int wn, int lane) { inproj_epi<1>(XZ, GG, acc, mt * 64 + wm * 16, nt * 128 + wn * 64, lane); });
    }, &p, cv0, cv1);
}
DI void rg_conv(const Prm& p, int j) {
  const bf16_t* XZ = (const bf16_t*)(p.ws + M_XZ); bf16_t* XL = (bf16_t*)(p.ws + M_XL);
  const float* cw = p.conv_w + (size_t)j * 4 * D; const float* cb = p.conv_b + (size_t)j * D;
  const int gt = obid() * NTHR + otid(), gn = ogrid() * NTHR;
  if ((gn & 127) != 0) return;
  const int c0 = (gt & 127) * 8;
  float w[4][8], bias[8];
#pragma unroll
  for (int q = 0; q < 8; ++q) bias[q] = cb[c0 + q];
#pragma unroll
  for (int t = 0; t < 4; ++t)
#pragma unroll
    for (int q = 0; q < 8; ++q) w[t][q] = cw[t * D + c0 + q];
  const u32x4 z4 = {0u, 0u, 0u, 0u};
  auto ld = [&](int e, u32x4 (&v)[4]) {
    const int row = e >> 7, lo = row < S ? 0 : S, hi = row < S ? S : R;
#pragma unroll
    for (int t = 0; t < 4; ++t) { const int rr = row + t - 2; v[t] = (rr >= lo && rr < hi) ? *(const u32x4*)(XZ + (size_t)rr * D + c0) : z4; }
  };
  auto st = [&](int e, u32x4 (&v)[4]) {
    const int row = e >> 7;
    float a[8];
#pragma unroll
    for (int q = 0; q < 8; ++q) a[q] = bias[q];
#pragma unroll
    for (int t = 0; t < 4; ++t)
#pragma unroll
      for (int q = 0; q < 4; ++q) { a[2 * q] += __uint_as_float(v[t][q] << 16) * w[t][2 * q]; a[2 * q + 1] += __uint_as_float(v[t][q] & 0xffff0000u) * w[t][2 * q + 1]; }
    *(uint4*)(XL + (size_t)row * D + c0) = make_uint4(pack2(a[0], a[1]), pack2(a[2], a[3]), pack2(a[4], a[5]), pack2(a[6], a[7]));
  };
  u32x4 v0[4], v1[4];
  int e = gt;
  if (e < R * 128) ld(e, v0);
  for (; e < R * 128; e += 2 * gn) {
    const bool m1 = e + gn < R * 128, m2 = e + 2 * gn < R * 128;
    if (m1) ld(e + gn, v1);
    st(e, v0);
    if (m2) ld(e + 2 * gn, v0);
    if (m1) st(e + gn, v1);
  }
}
template <int MI, class ACC>
DI void gates_epi(const Prm& p, int j, ACC& acc, int row0, int col0, int lane) {
  const bf16_t* XL = (const bf16_t*)(p.ws + M_XL); bf16_t* LA = (bf16_t*)(p.ws + M_LA); bf16_t* IX = (bf16_t*)(p.ws + M_IX);
  const int d = col0 >> 11, gate = (col0 >> 10) & 1, chw = col0 & 1023;
  const float* bias = (gate ? p.rg_bi : p.rg_ba) + (size_t)(j * 2 + d) * D;
  const float* lam = p.rg_lam + (size_t)(j * 2 + d) * D;
#pragma unroll
  for (int i = 0; i < MI; ++i) {
    const int row = row0 + i * 16 + (lane & 15);
#pragma unroll
    for (int jj = 0; jj < 4; jj += 2) {
      const int ch = chw + (jj >> 1) * 32 + 8 * (lane >> 4);
      float bb[8], v[8];
      { const float4 b0 = *(const float4*)(bias + ch), b1 = *(const float4*)(bias + ch + 4); bb[0] = b0.x; bb[1] = b0.y; bb[2] = b0.z; bb[3] = b0.w; bb[4] = b1.x; bb[5] = b1.y; bb[6] = b1.z; bb[7] = b1.w; }
#pragma unroll
      for (int q = 0; q < 4; ++q) { v[q] = acc[i][jj][q]; v[4 + q] = acc[i][jj + 1][q]; }
      f32x4 o0, o1;
      if (gate == 0) {
        float ll[8];
        { const float4 l0 = *(const float4*)(lam + ch), l1 = *(const float4*)(lam + ch + 4); ll[0] = l0.x; ll[1] = l0.y; ll[2] = l0.z; ll[3] = l0.w; ll[4] = l1.x; ll[5] = l1.y; ll[6] = l1.z; ll[7] = l1.w; }
#pragma unroll
        for (int q = 0; q < 4; ++q) { o0[q] = -8.f * sigm(v[q] + bb[q]) * softplus_neg(ll[q]); o1[q] = -8.f * sigm(v[4 + q] + bb[4 + q]) * softplus_neg(ll[4 + q]); }
        *(uint4*)(LA + ((size_t)d * R + row) * D + ch) = pack8(o0, o1);
      } else {
        const uint4 xv = *(const uint4*)(XL + (size_t)row * D + ch);
        float x0[4], x1[4]; unpack4(make_uint2(xv.x, xv.y), x0); unpack4(make_uint2(xv.z, xv.w), x1);
#pragma unroll
        for (int q = 0; q < 4; ++q) { o0[q] = sigm(v[q] + bb[q]) * x0[q]; o1[q] = sigm(v[4 + q] + bb[4 + q]) * x1[q]; }
        *(uint4*)(IX + ((size_t)d * R + row) * D + ch) = pack8(o0, o1);
      }
    }
  }
}
DI void rg_gates(const Prm& p, int j, bf16_t* sm, int cv0 = 0, int cv1 = 0) {
  const bf16_t* XL = (const bf16_t*)(p.ws + M_XL); const bf16_t* Wt = (const bf16_t*)(p.ws + W_GATE) + (size_t)j * 4096 * 256;
  gemm_split<false>(false, R / 256, 16, 256, sm, p.ws,
    [&](int mt, int nt, auto&& use) {
      const int nblk = ((nt * 256) & 1023) >> 8;
      use([&](int r) { return XL + (size_t)(mt * 256 + r) * D + nblk * 256; },
          [&](int r) { return Wt + (size_t)(nt * 256 + perm8(r)) * 256; },
          [&](f32x4 (&acc)[8][4], int wm, int wn, int lane) { gates_epi<8>(p, j, acc, mt * 256 + wm * 128, nt * 256 + wn * 64, lane); });
    },
    [&](int mt, int nt, auto&& use) {
      const int nblk = ((nt * 128) & 1023) >> 8;
      use([&](int r) { return XL + (size_t)(mt * 64 + r) * D + nblk * 256; },
          [&](int r) { return Wt + (size_t)(nt * 128 + perm8(r)) * 256; },
          [&](f32x4 (&acc)[1][4], int wm, int wn, int lane) { gates_epi<1>(p, j, acc, mt * 64 + wm * 16, nt * 128 + wn * 64, lane); });
    }, &p, cv0, cv1);
}
constexpr int SC = 64, NCH2 = R / SC;
DI int chunk_base(int j) { return j < S / SC ? j * SC : S + (j - S / SC) * SC; }
DI void ab_from(uint2 lav, uint2 ixv, float* a, float* b) {
  float la[4], ix[4]; unpack4(lav, la); unpack4(ixv, ix);
#pragma unroll
  for (int q = 0; q < 4; ++q) { a[q] = __expf(la[q]); b[q] = sqrtf(fmaxf(1.f - a[q] * a[q], 0.f)) * ix[q]; }
}
DI void rg_scan1(const Prm& p) {
  const bf16_t* LA = (const bf16_t*)(p.ws + M_LA); const bf16_t* IX = (const bf16_t*)(p.ws + M_IX);
  float* CA = (float*)(p.ws + M_CA); float* CB = (float*)(p.ws + M_CB);
  const int gt = obid() * NTHR + otid(), gn = ogrid() * NTHR;
  for (int e = gt; e < 2 * NCH2 * 256; e += gn) {
    const int cq = e & 255, dj = e >> 8, d = dj / NCH2, j = dj % NCH2, base = chunk_base(j);
    float A[4] = {1.f, 1.f, 1.f, 1.f}, B[4] = {0.f, 0.f, 0.f, 0.f};
    const size_t off0 = ((size_t)d * R) * D + cq * 4;
    uint2 l0[8], i0[8], l1[8], i1[8];
    auto ld = [&](int s0, uint2 (&lv)[8], uint2 (&iv)[8]) {
#pragma unroll
      for (int u = 0; u < 8; ++u) { const int row = d ? base + SC - 1 - (s0 + u) : base + s0 + u; lv[u] = *(const uint2*)(LA + off0 + (size_t)row * D); iv[u] = *(const uint2*)(IX + off0 + (size_t)row * D); }
    };
    auto fold = [&](uint2 (&lv)[8], uint2 (&iv)[8]) {
#pragma unroll
      for (int u = 0; u < 8; ++u) {
        float a[4], b[4]; ab_from(lv[u], iv[u], a, b);
#pragma unroll
        for (int q = 0; q < 4; ++q) { B[q] = a[q] * B[q] + b[q]; A[q] *= a[q]; }
      }
    };
    ld(0, l0, i0);
    for (int s0 = 0; s0 < SC; s0 += 16) { ld(s0 + 8, l1, i1); fold(l0, i0); if (s0 + 16 < SC) ld(s0 + 16, l0, i0); fold(l1, i1); }
    *(float4*)(CA + (size_t)dj * D + cq * 4) = make_float4(A[0], A[1], A[2], A[3]);
    *(float4*)(CB + (size_t)dj * D + cq * 4) = make_float4(B[0], B[1], B[2], B[3]);
  }
}
DI void rg_scan2(const Prm& p) {
  const bf16_t* LA = (const bf16_t*)(p.ws + M_LA); const bf16_t* IX = (const bf16_t*)(p.ws + M_IX); const bf16_t* GG = (const bf16_t*)(p.ws + M_GG);
  const float* CA = (const float*)(p.ws + M_CA); const float* CB = (const float*)(p.ws + M_CB);
  bf16_t* TMP = (bf16_t*)(p.ws + M_TMP); bf16_t* YIN = (bf16_t*)(p.ws + M_YIN);
  const int gt = obid() * NTHR + otid(), gn = ogrid() * NTHR;
  constexpr int NL = S / SC, NC = CT / SC;
  for (int e = gt; e < NCH2 * 256; e += gn) {
    const int cq = e & 255, j = e >> 8, base = chunk_base(j);
    float hf[4] = {0.f, 0.f, 0.f, 0.f}, hb[4] = {0.f, 0.f, 0.f, 0.f};
    const int pf = j >= NL ? j - NL : j + NC;
    for (int p0 = 0; p0 < pf; p0 += 8) {
      float4 av[8], bv[8];
#pragma unroll
      for (int u = 0; u < 8; ++u) { const int pos = min(p0 + u, pf - 1); const int i = pos < NC ? NL + pos : pos - NC; av[u] = *(const float4*)(CA + (size_t)i * D + cq * 4); bv[u] = *(const float4*)(CB + (size_t)i * D + cq * 4); }
#pragma unroll
      for (int u = 0; u < 8; ++u) if (p0 + u < pf) { hf[0] = av[u].x * hf[0] + bv[u].x; hf[1] = av[u].y * hf[1] + bv[u].y; hf[2] = av[u].z * hf[2] + bv[u].z; hf[3] = av[u].w * hf[3] + bv[u].w; }
    }
    const int pb = NCH2 - 1 - j;
    for (int p0 = 0; p0 < pb; p0 += 8) {
      float4 av[8], bv[8];
#pragma unroll
      for (int u = 0; u < 8; ++u) { const int pos = min(p0 + u, pb - 1); const int i = NCH2 - 1 - pos; av[u] = *(const float4*)(CA + (size_t)(NCH2 + i) * D + cq * 4); bv[u] = *(const float4*)(CB + (size_t)(NCH2 + i) * D + cq * 4); }
#pragma unroll
      for (int u = 0; u < 8; ++u) if (p0 + u < pb) { hb[0] = av[u].x * hb[0] + bv[u].x; hb[1] = av[u].y * hb[1] + bv[u].y; hb[2] = av[u].z * hb[2] + bv[u].z; hb[3] = av[u].w * hb[3] + bv[u].w; }
    }
    const size_t c0 = (size_t)cq * 4;
    {
      uint2 l0[8], i0[8], l1[8], i1[8];
      auto ld = [&](int s0, uint2 (&lv)[8], uint2 (&iv)[8]) {
#pragma unroll
        for (int u = 0; u < 8; ++u) { const size_t ix = (size_t)(base + s0 + u) * D + c0; lv[u] = *(const uint2*)(LA + ix); iv[u] = *(const uint2*)(IX + ix); }
      };
      auto fold = [&](int s0, uint2 (&lv)[8], uint2 (&iv)[8]) {
#pragma unroll
        for (int u = 0; u < 8; ++u) {
          float a[4], b[4]; ab_from(lv[u], iv[u], a, b);
#pragma unroll
          for (int q = 0; q < 4; ++q) hf[q] = a[q] * hf[q] + b[q];
          *(uint2*)(TMP + (size_t)(base + s0 + u) * D + c0) = make_uint2(pack2(hf[0], hf[1]), pack2(hf[2], hf[3]));
        }
      };
      ld(0, l0, i0);
      for (int s0 = 0; s0 < SC; s0 += 16) { ld(s0 + 8, l1, i1); fold(s0, l0, i0); if (s0 + 16 < SC) ld(s0 + 16, l0, i0); fold(s0 + 8, l1, i1); }
    }
    {
      uint2 l0[8], i0[8], t0[8], g0[8], l1[8], i1[8], t1[8], g1[8];
      auto ld = [&](int s0, uint2 (&lv)[8], uint2 (&iv)[8], uint2 (&tv)[8], uint2 (&gv)[8]) {
#pragma unroll
        for (int u = 0; u < 8; ++u) { const size_t ix = (size_t)(base + SC - 1 - (s0 + u)) * D + c0; lv[u] = *(const uint2*)(LA + (size_t)R * D + ix); iv[u] = *(const uint2*)(IX + (size_t)R * D + ix); tv[u] = *(const uint2*)(TMP + ix); gv[u] = *(const uint2*)(GG + ix); }
      };
      auto fold = [&](int s0, uint2 (&lv)[8], uint2 (&iv)[8], uint2 (&tv)[8], uint2 (&gv)[8]) {
#pragma unroll
        for (int u = 0; u < 8; ++u) {
          float a[4], b[4], t[4], g[4]; ab_from(lv[u], iv[u], a, b); unpack4(tv[u], t); unpack4(gv[u], g);
#pragma unroll
          for (int q = 0; q < 4; ++q) hb[q] = a[q] * hb[q] + b[q];
          *(uint2*)(YIN + (size_t)(base + SC - 1 - (s0 + u)) * D + c0) = make_uint2(pack2((t[0] + hb[0]) * g[0], (t[1] + hb[1]) * g[1]), pack2((t[2] + hb[2]) * g[2], (t[3] + hb[3]) * g[3]));
        }
      };
      ld(0, l0, i0, t0, g0);
      for (int s0 = 0; s0 < SC; s0 += 16) { ld(s0 + 8, l1, i1, t1, g1); fold(s0, l0, i0, t0, g0); if (s0 + 16 < SC) ld(s0 + 16, l0, i0, t0, g0); fold(s0 + 8, l1, i1, t1, g1); }
    }
  }
}

template <int MI, class ACC>
DI void qk_epi(const Prm& p, ACC& acc, int row0, int col0, int lane) {
  bf16_t* Qb = (bf16_t*)(p.ws + M_Q); bf16_t* Kb = (bf16_t*)(p.ws + M_K);
  const bool isq = col0 < D; const float* gv = isq ? p.na_qg : p.na_kg; bf16_t* O = isq ? Qb : Kb;
  const int colb = col0 & 1023; const float osc = isq ? 0.125f : 1.f;
#pragma unroll
  for (int i = 0; i < MI; ++i) {
    const int row = row0 + i * 16 + (lane & 15);
    float ss = 0.f;
#pragma unroll
    for (int jj = 0; jj < 4; ++jj)
#pragma unroll
      for (int q = 0; q < 4; ++q) ss += acc[i][jj][q] * acc[i][jj][q];
    ss += __shfl_xor(ss, 16); ss += __shfl_xor(ss, 32);
    const float rstd = rsqrtf(ss * (1.f / 64.f) + 1e-6f) * osc;
#pragma unroll
    for (int jj = 0; jj < 4; jj += 2) {
      const int dc = (jj >> 1) * 32 + 8 * (lane >> 4);
      const f32x4 g0 = *(const f32x4*)(gv + dc), g1 = *(const f32x4*)(gv + dc + 4);
      *(uint4*)(O + (size_t)row * D + colb + dc) = pack8(acc[i][jj] * rstd * g0, acc[i][jj + 1] * rstd * g1);
    }
  }
}
template <int MI, class ACC>
DI void v_epi(bf16_t* VT, ACC& acc, int tok0, int hd0, int lane) {
#pragma unroll
  for (int i = 0; i < MI; ++i) {
    const int tok = tok0 + i * 16 + 4 * (lane >> 4);
#pragma unroll
    for (int jj = 0; jj < 4; ++jj) {
      const int hd = hd0 + jj * 16 + (lane & 15);
      *(uint2*)(VT + (size_t)hd * R + tok) = pack4(acc[i][jj]);
    }
  }
}
DI void na_qkv(const Prm& p, bf16_t* sm, int cv0 = 0, int cv1 = 0) {
  const int cvm = cv0 + (cv1 - cv0) / 2;
  const bf16_t* H = (const bf16_t*)(p.ws + O_H); const bf16_t* Wt = (const bf16_t*)(p.ws + W_QKV);
  bf16_t* VT = (bf16_t*)(p.ws + M_VT);
  gemm_split<false>(false, R / 256, 8, D, sm, p.ws,
    [&](int mt, int nt, auto&& use) {
      use([&](int r) { return H + (size_t)(mt * 256 + r) * D; },
          [&](int r) { return Wt + (size_t)(nt * 256 + perm8(r)) * D; },
          [&](f32x4 (&acc)[8][4], int wm, int wn, int lane) { qk_epi<8>(p, acc, mt * 256 + wm * 128, nt * 256 + wn * 64, lane); });
    },
    [&](int mt, int nt, auto&& use) {
      use([&](int r) { return H + (size_t)(mt * 64 + r) * D; },
          [&](int r) { return Wt + (size_t)(nt * 128 + perm8(r)) * D; },
          [&](f32x4 (&acc)[1][4], int wm, int wn, int lane) { qk_epi<1>(p, acc, mt * 64 + wm * 16, nt * 128 + wn * 64, lane); });
    }, &p, cv0, cvm);
  gemm_split<true>(false, R / 256, 4, D, sm, p.ws,
    [&](int mt, int nt, auto&& use) {
      use([&](int r) { return H + (size_t)(mt * 256 + r) * D; },
          [&](int r) { return Wt + (size_t)(2048 + nt * 256 + r) * D; },
          [&](f32x4 (&acc)[8][4], int wm, int wn, int lane) { v_epi<8>(VT, acc, mt * 256 + wm * 128, nt * 256 + wn * 64, lane); });
    },
    [&](int mt, int nt, auto&& use) {
      use([&](int r) { return H + (size_t)(mt * 64 + r) * D; },
          [&](int r) { return Wt + (size_t)(2048 + nt * 128 + r) * D; },
          [&](f32x4 (&acc)[1][4], int wm, int wn, int lane) { v_epi<1>(VT, acc, mt * 64 + wm * 16, nt * 128 + wn * 64, lane); });
    }, &p, cvm, cv1);
}
DI void na_attn(const Prm& p, bf16_t* sm0) {
  const int tid0 = otid(), half = tid0 >> 8, tid = tid0 & 255;
  bf16_t* sm = sm0 + half * 36864;
  bf16_t* Ks = sm; bf16_t* VTs = sm + 256 * 72; float* rp = (float*)(sm + 256 * 72 + 64 * 264);
  const bf16_t* Qb = (const bf16_t*)(p.ws + M_Q); const bf16_t* Kb = (const bf16_t*)(p.ws + M_K); const bf16_t* VT = (const bf16_t*)(p.ws + M_VT);
  bf16_t* Ob = (bf16_t*)(p.ws + M_O);
  const int lane = tid & 63, w = tid >> 6, g = lane >> 4, ql = lane & 15;
  const int G = ogrid(), b = obid();
  const int nbx = G >> 3, li = b >> 3;
  {
    const int xx = b & 7;
    for (int jj = li * 2 + half; jj < 520; jj += nbx * 2) {
      const bool lat = jj < 512;
      int h, r = 0, rs = 0, qtok;
      if (lat) { const int it = xx * 512 + jj; h = it >> 8; r = it & 255; rs = min(max(r - 4, 0), 248); qtok = r * 64 + 16 * w + ql; }
      else { const int t = xx * 8 + (jj - 512); h = t >> 2; qtok = S + (t & 3) * 64 + 16 * w + ql; }
      const int qc = 16 * w + ql, cst = min(max(qc - 8, 0), 48), cs0 = min(max(16 * w - 8, 0), 32);
      bf16x8 qf[2];
#pragma unroll
      for (int ks = 0; ks < 2; ++ks) qf[ks] = *(const bf16x8*)(Qb + (size_t)qtok * D + h * 64 + ks * 32 + g * 8);
      float m_run = -1e30f, l_run = 0.f;
      f32x4 o[4];
#pragma unroll
      for (int db = 0; db < 4; ++db) o[db] = (f32x4){0.f, 0.f, 0.f, 0.f};
      __syncthreads();
      if (lat) for (int e = tid; e < 465; e += 256) rp[e] = p.na_rpb[(size_t)h * 465 + e];
      const char* const kbase = (const char*)Kb + (size_t)h * 128; const char* const vbase = (const char*)VT + (size_t)h * 64 * R * 2;
      for (int c = lat ? 0 : 2; c < 4; ++c) {
        __syncthreads();
        {
          const int nkeys = c < 2 ? 256 : 128, tok0 = c < 2 ? (rs + 4 * c) * 64 : S + (c - 2) * 128, ppr = nkeys >> 3, ni = nkeys >> 5;
          u32x4 kreg[8], vreg[8];
#pragma unroll
          for (int i = 0; i < 8; ++i) if (i < ni) {
            const int ch = tid + 256 * i;
            const unsigned ko = (unsigned)((tok0 + (ch >> 3)) * D + (ch & 7) * 8) * 2u, vo = (unsigned)((ch / ppr) * R + tok0 + (ch % ppr) * 8) * 2u;
            kreg[i] = *(const u32x4*)(kbase + ko);
            vreg[i] = *(const u32x4*)(vbase + vo);
          }
#pragma unroll
          for (int i = 0; i < 8; ++i) if (i < ni) {
            const int ch = tid + 256 * i;
            *(u32x4*)(Ks + (ch >> 3) * 72 + (ch & 7) * 8) = kreg[i];
            *(u32x4*)(VTs + (ch / ppr) * 264 + (ch % ppr) * 8) = vreg[i];
          }
        }
        __syncthreads();
        f32x4 s[8];
#pragma unroll
        for (int kb = 0; kb < 8; ++kb) {
          const int kbase = c < 2 ? (kb >> 1) * 64 + cs0 + 16 * (kb & 1) : kb * 16;
          s[kb] = (f32x4){0.f, 0.f, 0.f, 0.f};
#pragma unroll
          for (int ks = 0; ks < 2; ++ks) { const bf16x8 kf = *(const bf16x8*)(Ks + (kbase + ql) * 72 + ks * 32 + g * 8); s[kb] = MFMA16(kf, qf[ks], s[kb]); }
        }
        if (c < 2) {
#pragma unroll
          for (int kb = 0; kb < 8; ++kb) {
            const int krow = rs + 4 * c + (kb >> 1), rbi = krow - r + 7;
#pragma unroll
            for (int q = 0; q < 4; ++q) {
              const int kc = cs0 + 16 * (kb & 1) + 4 * g + q;
              const bool valid = (kc >= cst) && (kc < cst + 16);
              const int cbi = min(max(kc - qc + 15, 0), 30);
              s[kb][q] = valid ? s[kb][q] + rp[rbi * 31 + cbi] : -1e30f;
            }
          }
        }
        float mx = -1e30f;
#pragma unroll
        for (int kb = 0; kb < 8; ++kb)
#pragma unroll
          for (int q = 0; q < 4; ++q) mx = fmaxf(mx, s[kb][q]);
        mx = fmaxf(mx, __shfl_xor(mx, 16)); mx = fmaxf(mx, __shfl_xor(mx, 32));
        const float m_new = fmaxf(m_run, mx), alpha = __expf(m_run - m_new);
        float ls = 0.f;
#pragma unroll
        for (int kb = 0; kb < 8; ++kb)
#pragma unroll
          for (int q = 0; q < 4; ++q) { s[kb][q] = __expf(s[kb][q] - m_new); ls += s[kb][q]; }
        l_run = l_run * alpha + ls; m_run = m_new;
#pragma unroll
        for (int db = 0; db < 4; ++db) { o[db][0] *= alpha; o[db][1] *= alpha; o[db][2] *= alpha; o[db][3] *= alpha; }
#pragma unroll
        for (int t = 0; t < 4; ++t) {
          const int kb0 = c < 2 ? ((2 * t) >> 1) * 64 + cs0 : (2 * t) * 16, kb1 = c < 2 ? kb0 + 16 : kb0 + 16;
          const uint2 p0 = pack4(s[2 * t]), p1 = pack4(s[2 * t + 1]);
          const uint4 pu = make_uint4(p0.x, p0.y, p1.x, p1.y);
          const bf16x8 pf = __builtin_bit_cast(bf16x8, pu);
#pragma unroll
          for (int db = 0; db < 4; ++db) {
            const s16x4 v0 = *(const s16x4*)(VTs + (db * 16 + ql) * 264 + kb0 + 4 * g), v1 = *(const s16x4*)(VTs + (db * 16 + ql) * 264 + kb1 + 4 * g);
            const bf16x8 vf = __builtin_shufflevector(v0, v1, 0, 1, 2, 3, 4, 5, 6, 7);
            o[db] = MFMA16(vf, pf, o[db]);
          }
        }
      }
      l_run += __shfl_xor(l_run, 16); l_run += __shfl_xor(l_run, 32);
      const float inv = 1.f / l_run;
#pragma unroll
      for (int db = 0; db < 4; ++db) { f32x4 v = o[db]; v[0] *= inv; v[1] *= inv; v[2] *= inv; v[3] *= inv; *(uint2*)(Ob + (size_t)qtok * D + h * 64 + db * 16 + 4 * g) = pack4(v); }
    }
  }
}

DI void ft_chan(const Prm& p, bf16_t* sm) {
  const bf16_t* H = (const bf16_t*)(p.ws + O_H); const bf16_t* Bc = (const bf16_t*)(p.ws + W_BC);
  bf16_t* UT = (bf16_t*)(p.ws + M_UT); bf16_t* UTC = (bf16_t*)(p.ws + M_UTC);
  gemm_stream<true, 4, 2, 4>(130, 8, 256, sm, p.ws, [&](int mt, int nt, auto&& use) {
    const int grp = nt >> 1;
    use(
        [&](int r0) { const int r = perm8(r0); const int tok = mt < 128 ? 128 * r + mt : S + (mt - 128) * 128 + r; return H + (size_t)tok * D + grp * 256; },
        [&](int r) { return Bc + (size_t)((nt & 1) * 256 + r) * 256; },
        [&](f32x4 (&acc)[4][4], int wm, int wn, int lane) {
#pragma unroll
          for (int i = 0; i < 4; i += 2) {
            const int tr = wm * 64 + (i >> 1) * 32 + 8 * (lane >> 4);
#pragma unroll
            for (int jj = 0; jj < 4; ++jj) {
              const int cc = (nt & 1) * 256 + wn * 64 + jj * 16 + (lane & 15), ri = cc >> 8, ch = grp * 256 + (cc & 255);
              const uint4 w = pack8(acc[i][jj], acc[i + 1][jj]);
              if (mt < 128) *(uint4*)(UT + (((size_t)mt * D + ch) * 2 + ri) * 128 + tr) = w;
              else *(uint4*)(UTC + ((size_t)ch * 2 + ri) * 256 + (mt - 128) * 128 + tr) = w;
            }
          }
        });
  });
}
DI void ft_step1(const Prm& p, bf16_t* sm) {
  const bf16_t* UT = (const bf16_t*)(p.ws + M_UT); const bf16_t* UTC = (const bf16_t*)(p.ws + M_UTC);
  const bf16_t* D1 = (const bf16_t*)(p.ws + W_D1); const bf16_t* Dc = (const bf16_t*)(p.ws + W_DC);
  bf16_t* AT = (bf16_t*)(p.ws + M_AT); bf16_t* F = (bf16_t*)(p.ws + M_F);
  gemm_stream<true, 4, 2, 4>(1024, 1, 256, sm, p.ws, [&](int mt, int nt, auto&& use) {
    const int ch = mt;
    use(
        [&](int r) { return UT + ((size_t)perm8(r) * D + ch) * 256; },
        [&](int r) { return D1 + (size_t)ileave(r, 128) * 256; },
        [&](f32x4 (&acc)[4][4], int wm, int wn, int lane) {
#pragma unroll
          for (int i = 0; i < 4; i += 2) {
            const int t2 = wm * 64 + (i >> 1) * 32 + 8 * (lane >> 4);
#pragma unroll
            for (int jj = 0; jj < 2; ++jj) {
              const int k1 = wn * 32 + jj * 16 + (lane & 15);
              f32x4 orr[2], oi[2];
#pragma unroll
              for (int u = 0; u < 2; ++u)
#pragma unroll
                for (int q = 0; q < 4; ++q) {
                  float st, ct; sincos_rev((float)(k1 * (t2 + 4 * u + q)) * (1.f / 16384.f), &st, &ct);
                  const float ar = acc[i + u][jj][q], ai = acc[i + u][jj + 2][q];
                  orr[u][q] = ar * ct + ai * st; oi[u][q] = ai * ct - ar * st;
                }
              *(uint4*)(AT + (((size_t)k1 * D + ch) * 2 + 0) * 128 + t2) = pack8(orr[0], orr[1]);
              *(uint4*)(AT + (((size_t)k1 * D + ch) * 2 + 1) * 128 + t2) = pack8(oi[0], oi[1]);
            }
          }
        });
  });
  gemm_stream<true, 4, 2, 4>(8, 1, 512, sm, p.ws, [&](int mt, int nt, auto&& use) {
    const int ch0 = mt * 128;
    use(
        [&](int r) { return UTC + (size_t)(ch0 + perm8(r)) * 512; },
        [&](int r) { return Dc + (size_t)r * 512; },
        [&](f32x4 (&acc)[4][4], int wm, int wn, int lane) {
#pragma unroll
          for (int i = 0; i < 4; i += 2) {
            const int ch = ch0 + wm * 64 + (i >> 1) * 32 + 8 * (lane >> 4);
#pragma unroll
            for (int jj = 0; jj < 4; ++jj) {
              const int k = wn * 64 + jj * 16 + (lane & 15);
              *(uint4*)(F + (size_t)(S + k) * D + ch) = pack8(acc[i][jj], acc[i + 1][jj]);
            }
          }
        });
  });
}
DI void ft_step3(const Prm& p, bf16_t* sm) {
  const bf16_t* AT = (const bf16_t*)(p.ws + M_AT); const bf16_t* D3 = (const bf16_t*)(p.ws + W_D3); bf16_t* F = (bf16_t*)(p.ws + M_F);
  gemm_stream<true, 4, 4, 2>(512, 1, 256, sm, p.ws, [&](int mt, int nt, auto&& use) {
    const int k1 = mt >> 2, ch0 = (mt & 3) * 256;
    use(
        [&](int r) { return AT + ((size_t)k1 * D + ch0 + perm8(r)) * 256; },
        [&](int r) { return D3 + (size_t)r * 256; },
        [&](f32x4 (&acc)[4][4], int wm, int wn, int lane) {
#pragma unroll
          for (int i = 0; i < 4; i += 2) {
            const int ch = ch0 + wm * 64 + (i >> 1) * 32 + 8 * (lane >> 4);
#pragma unroll
            for (int jj = 0; jj < 4; ++jj) {
              const int k2 = wn * 64 + jj * 16 + (lane & 15);
              *(uint4*)(F + (size_t)(128 * k2 + k1) * D + ch) = pack8(acc[i][jj], acc[i + 1][jj]);
            }
          }
        });
  });
}

#define XB_TMO      128
#define XB_XCNT(j)  (256  + 64 * (j))
#define XB_XSUB(j)  (1280 + 64 * (j))
#define XB_XGEN(j)  (2304 + 64 * (j))
#define XB_TOP      3328
#define XB_TOPGEN   3392
#define XCD_BAR_WORDS 3456
#define XB_SPIN_CAP (1u << 18)
#define LAS __attribute__((address_space(3)))

__device__ __forceinline__ unsigned xb_ld(unsigned* p)              { return __hip_atomic_load(p, __ATOMIC_RELAXED, __HIP_MEMORY_SCOPE_AGENT); }
__device__ __forceinline__ unsigned xb_add(unsigned* p, unsigned v) { return __hip_atomic_fetch_add(p, v, __ATOMIC_RELAXED, __HIP_MEMORY_SCOPE_AGENT); }
__device__ __forceinline__ unsigned xb_xcc_id() { return (unsigned)__builtin_amdgcn_s_getreg((3 << 11) | 20) & 0xFu; }
#define XB_SPIN(cond, bar) do { unsigned _sp = 0; while (cond) { __builtin_amdgcn_s_sleep(1); \
    if ((++_sp & 255u) == 0u) { if (xb_ld(&(bar)[XB_TMO])) break; if (_sp > XB_SPIN_CAP) { atomicAdd(&(bar)[XB_TMO], 1u); break; } } } } while (0)

struct XcdBarrier {
    unsigned* bar; unsigned x;
    volatile LAS unsigned* st;
};

__device__ __forceinline__ XcdBarrier xcd_barrier_post(unsigned* bar, volatile LAS unsigned* st) {
    XcdBarrier b; b.bar = bar; b.x = xb_xcc_id(); b.st = st;
    if (threadIdx.x == 0) (void)xb_add(&bar[XB_XCNT(b.x)], 1u);
    return b;
}
__device__ __forceinline__ void xcd_barrier_complete(unsigned* bar, unsigned x, unsigned& nloc, unsigned& nx) {
    const unsigned G = gridDim.x * gridDim.y * gridDim.z;
    unsigned sum, cnt, mine, sp = 0u;
    for (;;) {
        sum = 0u; cnt = 0u; mine = 0u;
#pragma unroll
        for (unsigned j = 0; j < 16; ++j) { const unsigned c = xb_ld(&bar[XB_XCNT(j)]); sum += c; cnt += (c > 0u) ? 1u : 0u; mine = (j == x) ? c : mine; }
        if (sum == G) break;
        __builtin_amdgcn_s_sleep(1);
        if ((++sp & 255u) == 0u) { if (xb_ld(&bar[XB_TMO])) break; if (sp > XB_SPIN_CAP) { atomicAdd(&bar[XB_TMO], 1u); break; } }
    }
    nloc = mine > 0u ? mine : 1u; nx = cnt > 0u ? cnt : 1u;
}

__device__ __forceinline__ void xcd_barrier(const XcdBarrier& b) {
    asm volatile("s_waitcnt vmcnt(0)" ::: "memory");
    __syncthreads();
    if (threadIdx.x == 0) {
        unsigned* bar = b.bar;
        __builtin_amdgcn_s_waitcnt(0);
        unsigned nloc = b.st[0], nx = b.st[1];
        if (nloc == 0u) { xcd_barrier_complete(bar, b.x, nloc, nx); b.st[0] = nloc; b.st[1] = nx; }
        const unsigned old = xb_add(&bar[XB_XSUB(b.x)], 1u);
        const unsigned gen = old / nloc;
        if (old + 1u == (gen + 1u) * nloc) {
            __builtin_amdgcn_fence(__ATOMIC_RELEASE, "agent");
            asm volatile("s_waitcnt vmcnt(0)" ::: "memory");
            const unsigned og = xb_add(&bar[XB_TOP], 1u);
            const unsigned tg = og / nx;
            if (og + 1u == (tg + 1u) * nx) xb_add(&bar[XB_TOPGEN], 1u);
            else XB_SPIN(xb_ld(&bar[XB_TOPGEN]) == tg, bar);
            __builtin_amdgcn_fence(__ATOMIC_ACQUIRE, "agent");
            xb_add(&bar[XB_XGEN(b.x)], 1u);
            asm volatile("s_waitcnt vmcnt(0)" ::: "memory");
        } else {
            XB_SPIN(xb_ld(&bar[XB_XGEN(b.x)]) == gen, bar);
            __builtin_amdgcn_fence(__ATOMIC_ACQUIRE, "agent");
            asm volatile("s_waitcnt vmcnt(0)" ::: "memory");
        }
    }
    __syncthreads();
}


__global__ void __launch_bounds__(512) fwd_megakernel(Prm p) {
  __shared__ __attribute__((aligned(16))) unsigned char smem_raw[SMEM_BYTES];
  bf16_t* sm = (bf16_t*)smem_raw;
  __shared__ uint4 xb_words;
  if (threadIdx.x == 0) {
    xb_words = make_uint4(0u, 0u, 0u, 0u);
#pragma unroll
    for (int j = 0; j < NJOB; ++j) g_jobs_s[j] = p.jobs[j];
  }
  __syncthreads();
  XcdBarrier xb = xcd_barrier_post((unsigned*)(p.ws + O_BAR), (volatile LAS unsigned*)&xb_words);
  if (p.never) { cg::grid_group grid = cg::this_grid(); grid.sync(); }
#define GSYNC() do { for (int rs_ = 0; rs_ < REP_SYNC; ++rs_) xcd_barrier(xb); } while (0)
#define WITH_CONV(c0, c1, call) do { const bool cf_ = ((obid() >> 3) & 1) == 0; if (cf_) conv_range(p, (c0), (c1), sm); call; if (!cf_) conv_range(p, (c0), (c1), sm); } while (0)
  phase0(p, sm); GSYNC();
  int rg_j = 0, dense_j = 0, moe_j = 0;
  for (int l = 0; l < 4; ++l) {
    norm_phase(p, l, 0, -1, sm, l == 2 ? 1 : -1); GSYNC();
    const int kind = l % 3;
    if (kind == 0) {
      const int c0 = l == 0 ? CV_P0 : CV_L2_DN, c1 = l == 0 ? CV_L0_IN : CV_L3_IN, c2 = l == 0 ? CV_L0_GATES : CV_L3_GATES, c3 = l == 0 ? CV_L0_OUT : CV_L3_OUT;
      for (int q_ = 0; q_ < REP_OG; ++q_) { rg_inproj(p, rg_j, sm, c0, c1); GSYNC(); }
      for (int q_ = 0; q_ < REP_ATT; ++q_) { rg_conv(p, rg_j); GSYNC(); }
      for (int q_ = 0; q_ < REP_OG; ++q_) { rg_gates(p, rg_j, sm, c1, c2); GSYNC(); }
      for (int q_ = 0; q_ < REP_SCAN; ++q_) { rg_scan1(p); GSYNC(); rg_scan2(p); GSYNC(); }
      resid_gemm(p, (const bf16_t*)(p.ws + M_YIN), D, (const bf16_t*)(p.ws + W_RGOUT) + (size_t)rg_j * D * D, l, 2, sm, c2, c3);
      ++rg_j;
    } else if (kind == 1) {
      for (int q_ = 0; q_ < REP_OG; ++q_) { na_qkv(p, sm, CV_L0_DN, CV_L1_QKV); GSYNC(); }
      for (int q_ = 0; q_ < REP_ATT; ++q_) { na_attn(p, sm); GSYNC(); }
      resid_gemm(p, (const bf16_t*)(p.ws + M_O), D, (const bf16_t*)(p.ws + W_O), l, 2, sm, CV_L1_QKV, CV_L1_O);
    } else {
      for (int q_ = 0; q_ < REP_OG; ++q_) { ft_chan(p, sm); GSYNC(); ft_step1(p, sm); GSYNC(); ft_step3(p, sm); GSYNC(); }
      resid_gemm(p, (const bf16_t*)(p.ws + M_F), D, (const bf16_t*)(p.ws + W_FT), l, 2, sm);
    }
    GSYNC();
    const bool moe = (l & 1);
    norm_phase(p, l, 1, moe ? moe_j : -1, sm); GSYNC();
    if (!moe) {
      const int c0 = l == 0 ? CV_L0_OUT : CV_L1_MDN, c1 = l == 0 ? CV_L0_GU : CV_L2_GU, c2 = l == 0 ? CV_L0_DN : CV_L2_DN;
      ffn_gu(p, (const bf16_t*)(p.ws + W_FGU) + (size_t)dense_j * 2 * FF * D, sm, c0, c1); GSYNC();
      resid_gemm(p, (const bf16_t*)(p.ws + O_ACT), FF, (const bf16_t*)(p.ws + W_FDN) + (size_t)dense_j * D * FF, l, 5, sm, c1, c2);
      ++dense_j;
    } else {
      for (int q_ = 0; q_ < REP_ATT; ++q_) { moe_route(p, moe_j, sm); GSYNC(); }
      if (l == 1) moe_gu(p, moe_j, sm, CV_L1_O, CV_L1_MGU); else moe_gu(p, moe_j, sm);
      GSYNC();
      for (int q_ = 0; q_ < REP_MDN; ++q_) { if (l == 1) moe_down(p, moe_j, l, sm, CV_L1_MGU, CV_L1_MDN); else moe_down(p, moe_j, l, sm);
      GSYNC(); }
      if (l == 3) moe_combine(p, l);
      ++moe_j;
    }
    if (l < 3 && l != 1) GSYNC();
  }
}

static void add_job(Prm& p, const float* src, size_t dst_off, int K, int N, int nb, long long ss, long long ds) {
  Job& j = p.jobs[p.njob++];
  j.src = src; j.dst = (bf16_t*)(p.ws + dst_off); j.K = K; j.N = N; j.nb = nb; j.tiles = (K / 64) * (N / 64) * nb; j.ss = ss; j.ds = ds;
}

extern "C" void kernel_launch(void* const* d_in, const int* in_sizes, int n_in, void* d_out, int out_size, void* d_ws, size_t ws_size, hipStream_t stream) {
  static int grid_blocks = 0;
  if (!grid_blocks) {
    int dev = 0, cus = 0, per_cu = 0;
    hipGetDevice(&dev);
    hipDeviceGetAttribute(&cus, hipDeviceAttributeMultiprocessorCount, dev);
    hipOccupancyMaxActiveBlocksPerMultiprocessor(&per_cu, fwd_megakernel, NTHR, 0);
    if (per_cu < 1) per_cu = 1;
    if (per_cu > 1) per_cu = 1;
    grid_blocks = (cus * per_cu) & ~7;
  }
  Prm p; memset(&p, 0, sizeof(p));
  const float* const* in = (const float* const*)d_in;
  p.x = in[0]; p.c = in[1]; p.ctx = in[2]; p.cctx = in[3]; p.ada_w = in[4]; p.ada_b = in[5]; p.norm_g = in[6];
  p.conv_w = in[8]; p.conv_b = in[9]; p.rg_ba = in[11]; p.rg_bi = in[13]; p.rg_lam = in[14];
  p.na_qg = in[17]; p.na_kg = in[18]; p.na_rpb = in[19]; p.router = in[24];
  p.out = (float*)d_out; p.ws = (unsigned char*)d_ws;
  p.njob = 0;
  const long long GU = (long long)1024 * 7168, DN = (long long)3584 * 1024, SQ = (long long)1024 * 1024;
  auto gates = [&](int j) {
    for (int d = 0; d < 2; ++d) {
      const int jd = j * 2 + d;
      add_job(p, in[10] + (size_t)jd * 4 * 65536, W_GATE + ((size_t)(jd * 2 + 0) * 4 * 65536) * 2, 256, 256, 4, 65536, 65536);
      add_job(p, in[12] + (size_t)jd * 4 * 65536, W_GATE + ((size_t)(jd * 2 + 1) * 4 * 65536) * 2, 256, 256, 4, 65536, 65536);
    }
  };
  add_job(p, in[7], W_RGIN, 1024, 2048, 1, 0, 0); gates(0); add_job(p, in[15], W_RGOUT, 1024, 1024, 1, 0, 0);
  add_job(p, in[22], W_FGU, 1024, 7168, 1, 0, 0); add_job(p, in[23], W_FDN, 3584, 1024, 1, 0, 0);
  add_job(p, in[16], W_QKV, 1024, 3072, 1, 0, 0); add_job(p, in[20], W_O, 1024, 1024, 1, 0, 0);
  add_job(p, in[25], W_MGU, 1024, 7168, 8, GU, GU); add_job(p, in[26], W_MDN, 3584, 1024, 8, DN, DN);
  add_job(p, in[21], W_FT, 1024, 1024, 1, 0, 0);
  add_job(p, in[22] + GU, W_FGU + (size_t)GU * 2, 1024, 7168, 1, 0, 0); add_job(p, in[23] + DN, W_FDN + (size_t)DN * 2, 3584, 1024, 1, 0, 0);
  add_job(p, in[7] + 2 * SQ, W_RGIN + (size_t)2 * SQ * 2, 1024, 2048, 1, 0, 0); gates(1); add_job(p, in[15] + SQ, W_RGOUT + (size_t)SQ * 2, 1024, 1024, 1, 0, 0);
  add_job(p, in[25] + 8 * GU, W_MGU + (size_t)8 * GU * 2, 1024, 7168, 8, GU, GU); add_job(p, in[26] + 8 * DN, W_MDN + (size_t)8 * DN * 2, 3584, 1024, 8, DN, DN);
  {
    int tot = 0; for (int j = 0; j < p.njob; ++j) tot += p.jobs[j].tiles;
    if (tot != CV_TOTAL) fprintf(stderr, "conversion tile count %d != %d\n", tot, CV_TOTAL);
  }
  (void)hipMemsetAsync((unsigned char*)d_ws + O_BAR, 0, XCD_BAR_WORDS * 4, stream);
  void* args[] = {&p};
  hipError_t e = hipLaunchCooperativeKernel((void*)fwd_megakernel, dim3(grid_blocks), dim3(NTHR), args, 0, stream);
  if (e != hipSuccess) fprintf(stderr, "cooperative launch failed: %s (grid %d)\n", hipGetErrorString(e), grid_blocks);
}
```

```cpp
#ifndef REP_GU
#define REP_GU 1
#endif
#ifndef REP_NORM
#define REP_NORM 1
#endif
#ifndef REP_OG
#define REP_OG 1
#endif
#ifndef REP_MDN
#define REP_MDN 1
#endif
#ifndef REP_P0
#define REP_P0 1
#endif
#ifndef REP_SYNC
#define REP_SYNC 1
#endif
#ifndef REP_SCAN
#define REP_SCAN 1
#endif
#ifndef REP_ATT
#define REP_ATT 1
#endif
#ifndef REP_SK
#define REP_SK 1
#endif
#include <hip/hip_runtime.h>
#include <hip/hip_cooperative_groups.h>
#include <cstdio>
#include <cstdint>
#include <cstring>
namespace cg = cooperative_groups;

typedef unsigned short bf16_t;
typedef short bf16x8 __attribute__((ext_vector_type(8)));
typedef short s16x4 __attribute__((ext_vector_type(4)));
typedef float f32x4 __attribute__((ext_vector_type(4)));
typedef unsigned u32x4 __attribute__((ext_vector_type(4)));
#define DI __device__ __forceinline__
#define MFMA16(a, b, c) __builtin_amdgcn_mfma_f32_16x16x32_bf16((a), (b), (c), 0, 0, 0)

constexpr int S = 16384, CT = 256, R = S + CT, D = 1024, FF = 3584, NE = 8;
constexpr int NCH = 130;
constexpr int ACT_ROWS = 2 * R + NE * 256;

constexpr size_t al(size_t x) { return (x + 255) & ~(size_t)255; }
constexpr size_t W_RGIN = 0;
constexpr size_t W_GATE = W_RGIN + al((size_t)2 * 2048 * 1024 * 2);
constexpr size_t W_RGOUT = W_GATE + al((size_t)2 * 4096 * 256 * 2);
constexpr size_t W_QKV = W_RGOUT + al((size_t)2 * 1024 * 1024 * 2);
constexpr size_t W_O = W_QKV + al((size_t)3072 * 1024 * 2);
constexpr size_t W_FT = W_O + al((size_t)1024 * 1024 * 2);
constexpr size_t W_FGU = W_FT + al((size_t)1024 * 1024 * 2);
constexpr size_t W_FDN = W_FGU + al((size_t)2 * 7168 * 1024 * 2);
constexpr size_t W_MGU = W_FDN + al((size_t)2 * 1024 * 3584 * 2);
constexpr size_t W_MDN = W_MGU + al((size_t)16 * 7168 * 1024 * 2);
constexpr size_t W_BC = W_MDN + al((size_t)16 * 1024 * 3584 * 2);
constexpr size_t W_D1 = W_BC + al((size_t)512 * 256 * 2);
constexpr size_t W_D3 = W_D1 + al((size_t)256 * 256 * 2);
constexpr size_t W_DC = W_D3 + al((size_t)128 * 256 * 2);
constexpr size_t O_MOD = W_DC + al((size_t)256 * 512 * 2);
constexpr size_t O_XC = O_MOD + al((size_t)4 * 2 * 6144 * 4);
constexpr size_t O_CNT = O_XC + al((size_t)CT * D * 4);
constexpr size_t O_LIST = O_CNT + al(256);
constexpr size_t O_LW = O_LIST + al((size_t)2 * NE * R * 4);
constexpr size_t O_BAR = O_LW + al((size_t)2 * NE * R * 4);
constexpr size_t O_ROUTE = O_BAR + al(16384);
constexpr size_t O_RW = O_ROUTE + al((size_t)R * 4);
constexpr size_t O_H = O_RW + al((size_t)R * 8);
constexpr size_t O_ACT = O_H + al((size_t)R * D * 2);
constexpr size_t O_MIX = O_ACT + al((size_t)ACT_ROWS * FF * 2);
constexpr size_t RB = (size_t)R * D * 2;
constexpr size_t M_XZ = O_MIX, M_GG = M_XZ + al(RB), M_XL = M_GG + al(RB), M_LA = M_XL + al(RB), M_IX = M_LA + al(2 * RB),
                 M_TMP = M_IX + al(2 * RB), M_YIN = M_TMP + al(2 * RB), M_CA = M_YIN + al(RB), M_CB = M_CA + al((size_t)2 * 260 * D * 4),
                 M_END_RG = M_CB + al((size_t)2 * 260 * D * 4);
constexpr size_t M_Y = O_MIX;
constexpr size_t M_Q = O_MIX, M_K = M_Q + al(RB), M_VT = M_K + al(RB), M_O = M_VT + al(RB);
constexpr size_t M_UT = O_MIX, M_UTC = M_UT + al((size_t)S * 2048 * 2), M_AT = M_UTC + al((size_t)CT * 2048 * 2), M_F = M_AT + al((size_t)S * 2048 * 2);

struct Job { const float* src; bf16_t* dst; int K, N, nb, tiles; long long ss, ds; };
constexpr int NJOB = 24;
struct Prm {
  const float *x, *c, *ctx, *cctx, *ada_w, *ada_b, *norm_g, *conv_w, *conv_b, *rg_ba, *rg_bi, *rg_lam, *na_qg, *na_kg, *na_rpb, *router;
  float* out; unsigned char* ws;
  Job jobs[NJOB]; int njob; int never;
};

DI int otid() { int t = threadIdx.x; asm volatile("" : "+v"(t)); return t; }
DI int obid() { int t = blockIdx.x; asm volatile("" : "+s"(t)); return t; }
DI int ogrid() { int t = gridDim.x; asm volatile("" : "+s"(t)); return t; }
DI bf16_t f2bf(float x) { unsigned u = __float_as_uint(x); u += 0x7fffu + ((u >> 16) & 1u); return (bf16_t)(u >> 16); }
DI float bf2f(bf16_t h) { return __uint_as_float(((unsigned)h) << 16); }
DI unsigned pack2(float a, float b) { unsigned r; asm("v_cvt_pk_bf16_f32 %0, %1, %2" : "=v"(r) : "v"(a), "v"(b)); return r; }
DI uint2 pack4(f32x4 v) { return make_uint2(pack2(v[0], v[1]), pack2(v[2], v[3])); }
DI void unpack4(uint2 v, float* o) { o[0] = __uint_as_float(v.x << 16); o[1] = __uint_as_float(v.x & 0xffff0000u); o[2] = __uint_as_float(v.y << 16); o[3] = __uint_as_float(v.y & 0xffff0000u); }
DI int perm8(int r) { return (r & ~31) + ((r >> 2) & 3) * 8 + ((r >> 4) & 1) * 4 + (r & 3); }
DI uint4 pack8(f32x4 a, f32x4 b) { const uint2 x = pack4(a), y = pack4(b); return make_uint4(x.x, x.y, y.x, y.y); }
DI float sigm(float v) { return __builtin_amdgcn_rcpf(1.f + __expf(-v)); }
DI float siluf(float v) { return v * __builtin_amdgcn_rcpf(1.f + __expf(-v)); }
DI float gelut(float v) { float u = 0.7978845608f * (v + 0.044715f * v * v * v); float t = 1.f - 2.f * __builtin_amdgcn_rcpf(__expf(2.f * u) + 1.f); return 0.5f * v * (1.f + t); }
DI float softplus_neg(float lam) { const float x = __expf(-lam); return x < 0.05f ? x * (1.f - x * (0.5f - x * (1.f / 3.f - 0.25f * x))) : __logf(1.f + x); }
DI void sincos_rev(float rev, float* s, float* c) { *s = __builtin_amdgcn_sinf(rev); *c = __builtin_amdgcn_cosf(rev); }
DI float wsum(float v) { for (int o = 32; o; o >>= 1) v += __shfl_xor(v, o); return v; }
DI const float* xrow_in(const Prm& p, int r) { return r < S ? p.x + (size_t)r * D : p.ctx + (size_t)(r - S) * D; }
DI float* xrow(const Prm& p, int r) { return r < S ? p.out + (size_t)r * D : (float*)(p.ws + O_XC) + (size_t)(r - S) * D; }

constexpr int NTHR = 512;
constexpr int LDSS = 72;
constexpr int SMEM_BYTES = 2 * 512 * LDSS * 2;
constexpr int CV_P0 = 1024, CV_L0_IN = 4024, CV_L0_GATES = 5024, CV_L0_OUT = 5324, CV_L0_GU = 8824, CV_L0_DN = 14824, CV_L1_QKV = 20024, CV_L1_O = 21024,
              CV_L1_MGU = 26240, CV_L1_MDN = 42240, CV_L2_GU = 45740, CV_L2_DN = 49740, CV_L3_IN = 51240, CV_L3_GATES = 51712, CV_L3_OUT = 51712, CV_TOTAL = 51712;
__shared__ Job g_jobs_s[NJOB];
#define g_jobs ((const Job*)g_jobs_s)
struct CvTile { const float* src; bf16_t* dst; int N, K, valid, pad; };
DI CvTile cv_tile(const Job* jobs, int t, int c0, int c1) {
  CvTile r; r.valid = t < c1; r.pad = 0;
  int j = 0, tt = r.valid ? t : c0;
  while (tt >= jobs[j].tiles) { tt -= jobs[j].tiles; ++j; }
  const Job jb = jobs[j];
  const int tk = jb.K >> 6, tn = jb.N >> 6, per = tk * tn;
  const int bi = tt / per, rr = tt % per, kt = rr % tk, nt = rr / tk;
  r.src = jb.src + (size_t)bi * jb.ss + (size_t)(kt * 64) * jb.N + nt * 64;
  r.dst = jb.dst + (size_t)bi * jb.ds + (size_t)(nt * 64) * jb.K + kt * 64;
  r.N = jb.N; r.K = jb.K;
  return r;
}
DI void conv_range(const Prm& p, int c0, int c1, bf16_t* smraw, int widx = -1, int wn = 0) {
  if (c0 >= c1) return;
  const int tid = otid(), G = widx < 0 ? ogrid() : wn, b = widx < 0 ? obid() : widx;
  float* smf = (float*)smraw;
  const int half = tid >> 8, vt = tid & 255;
  float* smh = smf + half * (64 * 65);
  const int kr = vt >> 4, nc = (vt & 15) * 4;
  int t0 = c0 + b * 2;
  if (t0 >= c1) { __syncthreads(); return; }
  CvTile cur = cv_tile(g_jobs, t0 + half, c0, c1);
  float4 v[4];
#pragma unroll
  for (int i = 0; i < 4; ++i) v[i] = *(const float4*)(cur.src + (size_t)(kr + 16 * i) * cur.N + nc);
  for (; t0 < c1; t0 += 2 * G) {
    const bool more = t0 + 2 * G < c1;
    CvTile nx = cur; float4 vn[4];
    if (more) {
      nx = cv_tile(g_jobs, t0 + 2 * G + half, c0, c1);
#pragma unroll
      for (int i = 0; i < 4; ++i) vn[i] = *(const float4*)(nx.src + (size_t)(kr + 16 * i) * nx.N + nc);
    }
    __syncthreads();
#pragma unroll
    for (int i = 0; i < 4; ++i) { float* d = smh + (kr + 16 * i) * 65 + nc; d[0] = v[i].x; d[1] = v[i].y; d[2] = v[i].z; d[3] = v[i].w; }
    __syncthreads();
    if (cur.valid) {
      const int n = vt >> 2, kp = (vt & 3) * 16;
      unsigned o[8];
#pragma unroll
      for (int q = 0; q < 8; ++q) o[q] = pack2(smh[(kp + 2 * q) * 65 + n], smh[(kp + 2 * q + 1) * 65 + n]);
      uint4* d4 = (uint4*)(cur.dst + (size_t)n * cur.K + kp);
      d4[0] = make_uint4(o[0], o[1], o[2], o[3]); d4[1] = make_uint4(o[4], o[5], o[6], o[7]);
    }
    if (more) {
      cur = nx;
#pragma unroll
      for (int i = 0; i < 4; ++i) v[i] = vn[i];
    }
  }
  __syncthreads();
}

template <bool NAT, int MI, int WM, int WN, class F>
DI void gemm_stream(int MT, int NT, int K, bf16_t* sm, const void* gbase, F f, const Prm* cvp = nullptr, int cv0 = 0, int cv1 = 0, int lo = 0, int hi = -1, int SUB = 1) {
  constexpr int BM = WM * MI * 16, BN = WN * 64, AR = BM / 64, BR = BN / 64, STG = (BM + BN) * LDSS;
  static_assert(WM * WN == 8, "8 waves");
  const int G = ogrid(), b = obid(), nbx = G >> 3, xcd = b & 7, li = b >> 3;
  if (hi < 0) hi = MT * NT;
  const int T = (hi - lo) * SUB;
  const int full = NT >> 3, wl = NT & 7, gsz = MT * 8;
  const int start = (int)(((long long)T * xcd) >> 3) + li, end = (int)(((long long)T * (xcd + 1)) >> 3);
  const int ntb = start < end ? (end - start + nbx - 1) / nbx : 0;
  if (ntb > 0) {
  auto tile_at = [&](int j, int& mt, int& nt) {
    const int item = start + j * nbx, idx = lo + item / SUB, sb = item % SUB, g = idx / gsz;
    if (g < full) { const int rem = idx - g * gsz; mt = rem >> 3; nt = g * 8 + (rem & 7); }
    else { const int rem = idx - full * gsz; mt = rem / wl; nt = full * 8 + rem % wl; }
    if (SUB == 8) { mt = mt * 4 + (sb >> 1); nt = nt * 2 + (sb & 1); }
  };
  const int tid = otid(), lane = tid & 63, wid = tid >> 6, wm = wid / WN, wn = wid % WN;
  const int lr = tid >> 3, lc = (tid & 7) * 8;
  const char* const gb = (const char*)gbase;
  unsigned ap[AR], bp[BR];
  auto set_offs = [&](int j) {
    int mt, nt; tile_at(j, mt, nt);
    f(mt, nt, [&](auto&& a, auto&& bfn, auto&& ep) {
#pragma unroll
      for (int i = 0; i < AR; ++i) ap[i] = (unsigned)((const char*)a(lr + 64 * i) - gb) + lc * 2;
#pragma unroll
      for (int i = 0; i < BR; ++i) bp[i] = (unsigned)((const char*)bfn(lr + 64 * i) - gb) + lc * 2;
    });
  };
  u32x4 ra[AR], rb[BR];
  f32x4 acc[MI][4];
#pragma unroll
  for (int i = 0; i < MI; ++i)
#pragma unroll
    for (int j = 0; j < 4; ++j) acc[i][j] = (f32x4){0.f, 0.f, 0.f, 0.f};
  const int nk = K / 64, Q = ntb * nk;
  const int fro = (lane & 15) * LDSS + (lane >> 4) * 8;
  set_offs(0);
#pragma unroll
  for (int i = 0; i < AR; ++i) ra[i] = *(const u32x4*)(gb + ap[i]);
#pragma unroll
  for (int i = 0; i < BR; ++i) rb[i] = *(const u32x4*)(gb + bp[i]);
#pragma unroll
  for (int i = 0; i < AR; ++i) *(u32x4*)(sm + (lr + 64 * i) * LDSS + lc) = ra[i];
#pragma unroll
  for (int i = 0; i < BR; ++i) *(u32x4*)(sm + BM * LDSS + (lr + 64 * i) * LDSS + lc) = rb[i];
#pragma unroll
  for (int i = 0; i < AR; ++i) ra[i] = *(const u32x4*)(gb + 128 + ap[i]);
#pragma unroll
  for (int i = 0; i < BR; ++i) rb[i] = *(const u32x4*)(gb + 128 + bp[i]);
  __syncthreads();
  int kt = 0, jt = 0;
  for (int q = 0; q < Q; ++q) {
    bf16_t* sA = sm + (q & 1) * STG; bf16_t* sB = sA + BM * LDSS;
    constexpr int FA = MI < 4 ? MI : 4, HG = MI / FA, NG = 2 * HG;
    bf16x8 fb[2][4], fa[2][FA];
    const bf16_t* pA = sA + (wm * MI * 16) * LDSS + fro; const bf16_t* pB = sB + (wn * 64) * LDSS + fro;
#pragma unroll
    for (int j = 0; j < 4; ++j) fb[0][j] = *(const bf16x8*)(pB + (j * 16) * LDSS);
#pragma unroll
    for (int i = 0; i < FA; ++i) fa[0][i] = *(const bf16x8*)(pA + (i * 16) * LDSS);
    __builtin_amdgcn_sched_barrier(0);
    if (q + 1 < Q) {
      bf16_t* nA = sm + ((q + 1) & 1) * STG; bf16_t* nB = nA + BM * LDSS;
#pragma unroll
      for (int i = 0; i < AR; ++i) *(u32x4*)(nA + (lr + 64 * i) * LDSS + lc) = ra[i];
#pragma unroll
      for (int i = 0; i < BR; ++i) *(u32x4*)(nB + (lr + 64 * i) * LDSS + lc) = rb[i];
    }
    if (q + 2 < Q) {
      int kt2 = kt + 2;
      if (kt2 >= nk) { kt2 -= nk; if (kt2 == 0) set_offs(jt + 1); }
      const char* gk = gb + kt2 * 128;
#pragma unroll
      for (int i = 0; i < AR; ++i) ra[i] = *(const u32x4*)(gk + ap[i]);
#pragma unroll
      for (int i = 0; i < BR; ++i) rb[i] = *(const u32x4*)(gk + bp[i]);
    }
    __builtin_amdgcn_sched_barrier(0);
    {
#pragma unroll
      for (int gi = 0; gi < NG; ++gi) {
        const int ks = gi / HG;
        if (gi + 1 < NG) {
          const int ks1 = (gi + 1) / HG, h1 = (gi + 1) % HG;
          if (ks1 != ks) {
#pragma unroll
            for (int j = 0; j < 4; ++j) fb[ks1 & 1][j] = *(const bf16x8*)(pB + (j * 16) * LDSS + ks1 * 32);
          }
#pragma unroll
          for (int i = 0; i < FA; ++i) fa[(gi + 1) & 1][i] = *(const bf16x8*)(pA + ((h1 * FA + i) * 16) * LDSS + ks1 * 32);
        }
        const int h = gi % HG;
#pragma unroll
        for (int i = 0; i < FA; ++i)
#pragma unroll
          for (int j = 0; j < 4; ++j)
            acc[h * FA + i][j] = NAT ? MFMA16(fa[gi & 1][i], fb[ks & 1][j], acc[h * FA + i][j]) : MFMA16(fb[ks & 1][j], fa[gi & 1][i], acc[h * FA + i][j]);
        __builtin_amdgcn_sched_barrier(0);
      }
    }
    if (kt == nk - 1) {
      int mt, nt; tile_at(jt, mt, nt);
      f(mt, nt, [&](auto&& a, auto&& bfn, auto&& ep) { ep(acc, wm, wn, lane); });
#pragma unroll
      for (int i = 0; i < MI; ++i)
#pragma unroll
        for (int j = 0; j < 4; ++j) acc[i][j] = (f32x4){0.f, 0.f, 0.f, 0.f};
      kt = 0; ++jt;
    } else ++kt;
    __syncthreads();
  }
  }
  if (cvp && cv0 < cv1) {
    int n_idle = 0, my_idx = -1;
#pragma unroll
    for (int x = 0; x < 8; ++x) {
      const int sx = (int)(((long long)T * x) >> 3), ex = (int)(((long long)T * (x + 1)) >> 3), rem = (ex - sx) % nbx;
      if (rem) { if (x == xcd && li >= rem) my_idx = n_idle + (li - rem); n_idle += nbx - rem; }
    }
    if (n_idle == 0) conv_range(*cvp, cv0, cv1, sm);
    else if (my_idx >= 0) conv_range(*cvp, cv0, cv1, sm, my_idx, n_idle);
  }
}

template <bool NAT, class FB, class FS>
DI void gemm_split(bool split, int MT, int NT, int K, bf16_t* sm, const void* gbase, FB fb, FS fs, const Prm* cvp = nullptr, int cv0 = 0, int cv1 = 0) {
  if (!split) { gemm_stream<NAT, 8, 2, 4>(MT, NT, K, sm, gbase, fb, cvp, cv0, cv1); return; }
  const int T = MT * NT, G = ogrid(), tfull = (T / G) * G;
  if (tfull > 0) gemm_stream<NAT, 8, 2, 4>(MT, NT, K, sm, gbase, fb, nullptr, 0, 0, 0, tfull, 1);
  if (tfull < T) gemm_stream<NAT, 1, 4, 2>(MT, NT, K, sm, gbase, fs, cvp, cv0, cv1, tfull, T, 8);
  else if (cvp && cv0 < cv1) conv_range(*cvp, cv0, cv1, sm);
}

DI int ileave(int pc, int half) { const int q = pc >> 6, w = pc & 63; return (w < 32) ? q * 32 + w : half + q * 32 + (w - 32); }
DI int ileave8(int pc, int half) { const int q = pc >> 6, w = pc & 63, c = w & 31, j = c >> 4, g = (c >> 2) & 3, e = c & 3; return (w < 32 ? 0 : half) + q * 32 + 8 * g + 4 * j + e; }

DI void phase0(const Prm& p, bf16_t* smraw) {
  const int tid = otid(), G = ogrid(), b = obid();
  float* smf = (float*)smraw;
  for (int u = b; u < 384; u += G) {
    const int l = u / 96, cg0 = (u % 96) * 64, kq = tid >> 4, cq = tid & 15;
    const float* w = p.ada_w + ((size_t)l * 1024 + kq * 32) * 6144 + cg0 + cq * 4;
    float4 a0 = make_float4(0, 0, 0, 0), a1 = a0;
#pragma unroll 8
    for (int k = 0; k < 32; ++k) {
      const float4 wv = *(const float4*)(w + (size_t)k * 6144);
      const float s0 = siluf(p.c[kq * 32 + k]), s1 = siluf(p.cctx[kq * 32 + k]);
      a0.x += s0 * wv.x; a0.y += s0 * wv.y; a0.z += s0 * wv.z; a0.w += s0 * wv.w;
      a1.x += s1 * wv.x; a1.y += s1 * wv.y; a1.z += s1 * wv.z; a1.w += s1 * wv.w;
    }
    __syncthreads();
    *(float4*)(smf + (kq * 16 + cq) * 8) = a0; *(float4*)(smf + (kq * 16 + cq) * 8 + 4) = a1;
    __syncthreads();
    if (tid < 128) {
      const int wsel = tid >> 6, col = tid & 63; float s = 0.f;
      for (int q = 0; q < 32; ++q) s += smf[(q * 16 + (col >> 2)) * 8 + wsel * 4 + (col & 3)];
      float* mod = (float*)(p.ws + O_MOD);
      mod[(size_t)(l * 2 + wsel) * 6144 + cg0 + col] = s + p.ada_b[(size_t)l * 6144 + cg0 + col];
    }
    __syncthreads();
  }
  if (b == G - 1 && tid < 64) ((int*)(p.ws + O_CNT))[tid] = 0;
  {
    const int gt = b * NTHR + tid, gn = G * NTHR;
    bf16_t* Bc = (bf16_t*)(p.ws + W_BC); bf16_t* D1 = (bf16_t*)(p.ws + W_D1); bf16_t* D3 = (bf16_t*)(p.ws + W_D3); bf16_t* Dc = (bf16_t*)(p.ws + W_DC);
    for (int e = gt; e < 512 * 256; e += gn) { const int rr = e >> 8, c = e & 255, ri = rr >> 8, m = rr & 255; float sn, cs; sincos_rev((float)((m * c) & 255) / 256.f, &sn, &cs); Bc[e] = f2bf((ri ? -sn : cs) * 0.0625f); }
    for (int e = gt; e < 256 * 256; e += gn) { const int rr = e >> 8, c = e & 255, ri = rr >> 7, k1 = rr & 127, ri2 = c >> 7, t1 = c & 127; float sn, cs; sincos_rev((float)((k1 * t1) & 127) / 128.f, &sn, &cs);
      const float v = (ri == ri2) ? cs : (ri == 0 ? sn : -sn); D1[e] = f2bf(v * 0.08838834764831845f); }
    for (int e = gt; e < 128 * 256; e += gn) { const int k2 = e >> 8, c = e & 255, ri = c >> 7, t2 = c & 127; float sn, cs; sincos_rev((float)((k2 * t2) & 127) / 128.f, &sn, &cs); D3[e] = f2bf((ri ? sn : cs) * 0.08838834764831845f); }
    for (int e = gt; e < 256 * 512; e += gn) { const int k = e >> 9, c = e & 511, ri = c >> 8, t = c & 255; float sn, cs; sincos_rev((float)((k * t) & 255) / 256.f, &sn, &cs); Dc[e] = f2bf((ri ? sn : cs) * 0.0625f); }
  }
  conv_range(p, 0, CV_P0, smraw);
}

DI void norm_phase(const Prm& p, int l, int which, int moe_idx, bf16_t* smraw, int comb_l = -1) {
  const int lane = otid() & 63, wv = obid() * 8 + (otid() >> 6), nw = ogrid() * 8;
  const float* g = p.norm_g + (size_t)(l * 2 + which) * D;
  const float* mod = (const float*)(p.ws + O_MOD);
  bf16_t* H = (bf16_t*)(p.ws + O_H);
  float* rts = (float*)smraw;
  if (moe_idx >= 0) {
    const float4* rsrc = (const float4*)(p.router + (size_t)moe_idx * D * NE);
    for (int e = otid(); e < D * NE / 4; e += NTHR) ((float4*)rts)[e] = rsrc[e];
    __syncthreads();
  }
  f32x4 gs0[4], sv0[4];
  {
    const float* sh = mod + (size_t)(l * 2) * 6144 + (which ? 3 : 0) * D; const float* sc = mod + (size_t)(l * 2) * 6144 + (which ? 4 : 1) * D;
#pragma unroll
    for (int i = 0; i < 4; ++i) {
      const int col = i * 256 + lane * 4;
      const float4 g4 = *(const float4*)(g + col), s4 = *(const float4*)(sc + col);
      gs0[i] = (f32x4){g4.x * (1.f + s4.x), g4.y * (1.f + s4.y), g4.z * (1.f + s4.z), g4.w * (1.f + s4.w)}; sv0[i] = *(const f32x4*)(sh + col);
    }
  }
  const bf16_t* Ycmb = (const bf16_t*)(p.ws + M_Y);
  auto load_row = [&](int r, f32x4 (&dst)[4]) {
    const float* xr = (l == 0 && which == 0) ? xrow_in(p, r) : (const float*)xrow(p, r);
#pragma unroll
    for (int i = 0; i < 4; ++i) dst[i] = *(const f32x4*)(xr + i * 256 + lane * 4);
    if (comb_l >= 0) {
      const float* g5 = mod + (size_t)(comb_l * 2 + (r >= S ? 1 : 0)) * 6144 + 5 * D;
#pragma unroll
      for (int i = 0; i < 4; ++i) {
        const int col = i * 256 + lane * 4;
        const uint2 u0 = *(const uint2*)(Ycmb + (size_t)(2 * r) * D + col), u1 = *(const uint2*)(Ycmb + (size_t)(2 * r + 1) * D + col);
        float a0[4], a1[4]; unpack4(u0, a0); unpack4(u1, a1);
        const f32x4 ys = {a0[0] + a1[0], a0[1] + a1[1], a0[2] + a1[2], a0[3] + a1[3]};
        dst[i] += *(const f32x4*)(g5 + col) * ys;
      }
    }
  };
  f32x4 v[4];
  if (wv < R) load_row(wv, v);
  for (int r = wv; r < R; r += nw) {
    f32x4 vn[4];
    const bool more = r + nw < R;
    if (more) load_row(r + nw, vn);
    if (comb_l >= 0) {
      float* xw = xrow(p, r);
#pragma unroll
      for (int i = 0; i < 4; ++i) *(f32x4*)(xw + i * 256 + lane * 4) = v[i];
    }
    float ss = 0.f;
#pragma unroll
    for (int i = 0; i < 4; ++i) ss += v[i][0] * v[i][0] + v[i][1] * v[i][1] + v[i][2] * v[i][2] + v[i][3] * v[i][3];
    ss = wsum(ss);
    const float rstd = rsqrtf(ss * (1.f / 1024.f) + 1e-6f);
    float lg[8];
#pragma unroll
    for (int e = 0; e < 8; ++e) lg[e] = 0.f;
#pragma unroll
    for (int i = 0; i < 4; ++i) {
      const int col = i * 256 + lane * 4;
      f32x4 gs = gs0[i], sv = sv0[i];
      if (r >= S) {
        const float* md = mod + (size_t)(l * 2 + 1) * 6144;
        const float4 g4 = *(const float4*)(g + col), s4 = *(const float4*)(md + (which ? 4 : 1) * D + col);
        gs = (f32x4){g4.x * (1.f + s4.x), g4.y * (1.f + s4.y), g4.z * (1.f + s4.z), g4.w * (1.f + s4.w)}; sv = *(const f32x4*)(md + (which ? 3 : 0) * D + col);
      }
      f32x4 h;
      h = v[i] * rstd * gs + sv;
      *(uint2*)(H + (size_t)r * D + col) = pack4(h);
      if (moe_idx >= 0) {
        const float* rt = rts + (size_t)col * NE;
#pragma unroll
        for (int q = 0; q < 4; ++q) {
          const float4 r0 = *(const float4*)(rt + q * 8), r1 = *(const float4*)(rt + q * 8 + 4);
          lg[0] += h[q] * r0.x; lg[1] += h[q] * r0.y; lg[2] += h[q] * r0.z; lg[3] += h[q] * r0.w;
          lg[4] += h[q] * r1.x; lg[5] += h[q] * r1.y; lg[6] += h[q] * r1.z; lg[7] += h[q] * r1.w;
        }
      }
    }
    if (moe_idx >= 0) {
#pragma unroll
      for (int e = 0; e < 8; ++e) lg[e] = wsum(lg[e]);
      if (lane == 0) {
        int i0 = 0; float v0 = lg[0];
#pragma unroll
        for (int e = 1; e < 8; ++e) if (lg[e] > v0) { v0 = lg[e]; i0 = e; }
        int i1 = -1; float v1 = -3.0e38f;
#pragma unroll
        for (int e = 0; e < 8; ++e) if (e != i0 && lg[e] > v1) { v1 = lg[e]; i1 = e; }
        const float w0 = 1.f / (1.f + __expf(v1 - v0)), w1 = 1.f - w0;
        ((int*)(p.ws + O_ROUTE))[r] = i0 | (i1 << 8); ((float2*)(p.ws + O_RW))[r] = make_float2(w0, w1);
      }
    }
    if (more) {
#pragma unroll
      for (int i = 0; i < 4; ++i) v[i] = vn[i];
    }
  }
}

template <int MI, int BM, int BN, class ACC>
DI void resid_epi(const Prm& p, ACC& acc, int row0, int col0, int l, int gchunk, int lane) {
  const float* mod = (const float*)(p.ws + O_MOD);
#pragma unroll
  for (int i = 0; i < MI; ++i) {
    const int row = row0 + i * 16 + (lane & 15);
    float* xr = xrow(p, row);
    const float* xs = (l == 0 && gchunk == 2) ? xrow_in(p, row) : (const float*)xr;
    const float* gt = mod + (size_t)(l * 2 + (row >= S ? 1 : 0)) * 6144 + gchunk * D;
#pragma unroll
    for (int j = 0; j < 4; ++j) {
      const int col = col0 + j * 16 + 4 * (lane >> 4);
      const float4 g4 = *(const float4*)(gt + col); float4 xv = *(const float4*)(xs + col);
      xv.x += g4.x * acc[i][j][0]; xv.y += g4.y * acc[i][j][1]; xv.z += g4.z * acc[i][j][2]; xv.w += g4.w * acc[i][j][3];
      *(float4*)(xr + col) = xv;
    }
  }
}
DI void resid_gemm(const Prm& p, const bf16_t* A, int K, const bf16_t* Wt, int l, int gchunk, bf16_t* sm, int cv0 = 0, int cv1 = 0) {
  gemm_split<false>(true, R / 256, D / 256, K, sm, p.ws,
    [&](int mt, int nt, auto&& use) {
      use([&](int r) { return A + (size_t)(mt * 256 + r) * K; },
          [&](int r) { return Wt + (size_t)(nt * 256 + r) * K; },
          [&](f32x4 (&acc)[8][4], int wm, int wn, int lane) { resid_epi<8, 256, 256>(p, acc, mt * 256 + wm * 128, nt * 256 + wn * 64, l, gchunk, lane); });
    },
    [&](int mt, int nt, auto&& use) {
      use([&](int r) { return A + (size_t)(mt * 64 + r) * K; },
          [&](int r) { return Wt + (size_t)(nt * 128 + r) * K; },
          [&](f32x4 (&acc)[1][4], int wm, int wn, int lane) { resid_epi<1, 64, 128>(p, acc, mt * 64 + wm * 16, nt * 128 + wn * 64, l, gchunk, lane); });
    }, &p, cv0, cv1);
}

template <int MI, class ACC>
DI void swiglu_epi(bf16_t* ACT, ACC& acc, int row0, int ff0, int lane) {
#pragma unroll
  for (int i = 0; i < MI; ++i) {
    const int row = row0 + i * 16 + (lane & 15), ff = ff0 + 8 * (lane >> 4);
    f32x4 o0, o1;
#pragma unroll
    for (int q = 0; q < 4; ++q) { o0[q] = siluf(acc[i][0][q]) * acc[i][2][q]; o1[q] = siluf(acc[i][1][q]) * acc[i][3][q]; }
    const uint2 w0 = pack4(o0), w1 = pack4(o1);
    *(uint4*)(ACT + (size_t)row * FF + ff) = make_uint4(w0.x, w0.y, w1.x, w1.y);
  }
}
DI void ffn_gu(const Prm& p, const bf16_t* Wt, bf16_t* sm, int cv0 = 0, int cv1 = 0) {
  const bf16_t* H = (const bf16_t*)(p.ws + O_H); bf16_t* ACT = (bf16_t*)(p.ws + O_ACT);
  gemm_split<false>(false, R / 256, 2 * FF / 256, D, sm, p.ws,
    [&](int mt, int nt, auto&& use) {
      use([&](int r) { return H + (size_t)(mt * 256 + r) * D; },
          [&](int r) { return Wt + (size_t)ileave8(nt * 256 + r, FF) * D; },
          [&](f32x4 (&acc)[8][4], int wm, int wn, int lane) { swiglu_epi<8>(ACT, acc, mt * 256 + wm * 128, (nt * 4 + wn) * 32, lane); });
    },
    [&](int mt, int nt, auto&& use) {
      use([&](int r) { return H + (size_t)(mt * 64 + r) * D; },
          [&](int r) { return Wt + (size_t)ileave8(nt * 128 + r, FF) * D; },
          [&](f32x4 (&acc)[1][4], int wm, int wn, int lane) { swiglu_epi<1>(ACT, acc, mt * 64 + wm * 16, (nt * 2 + wn) * 32, lane); });
    }, &p, cv0, cv1);
}

struct MoeMap { int ntiles; int ts1, ts2, ts3, ts4, ts5, ts6, ts7; };
DI void moe_map(const Prm& p, int moe_idx, MoeMap& m) {
  const int* cnt = (const int*)(p.ws + O_CNT) + moe_idx * 8;
  int ts = 0;
  ts += (cnt[0] + 255) >> 8; m.ts1 = ts; ts += (cnt[1] + 255) >> 8; m.ts2 = ts; ts += (cnt[2] + 255) >> 8; m.ts3 = ts; ts += (cnt[3] + 255) >> 8; m.ts4 = ts;
  ts += (cnt[4] + 255) >> 8; m.ts5 = ts; ts += (cnt[5] + 255) >> 8; m.ts6 = ts; ts += (cnt[6] + 255) >> 8; m.ts7 = ts; ts += (cnt[7] + 255) >> 8; m.ntiles = ts;
}
DI void moe_find(const Prm& p, int moe_idx, const MoeMap& m, int mt, int& e, int& lt, int& ce) {
  e = 0; int st = 0;
  if (mt >= m.ts1) { e = 1; st = m.ts1; } if (mt >= m.ts2) { e = 2; st = m.ts2; } if (mt >= m.ts3) { e = 3; st = m.ts3; } if (mt >= m.ts4) { e = 4; st = m.ts4; }
  if (mt >= m.ts5) { e = 5; st = m.ts5; } if (mt >= m.ts6) { e = 6; st = m.ts6; } if (mt >= m.ts7) { e = 7; st = m.ts7; }
  lt = mt - st; ce = ((const int*)(p.ws + O_CNT))[moe_idx * 8 + e];
}

DI void moe_route(const Prm& p, int moe_idx, bf16_t* smraw) {
  const int b = obid(), tid = otid(), e = b & 7, seg = b >> 3, nseg = ogrid() >> 3, SEG = (R + nseg - 1) / nseg;
  int* sc = (int*)smraw;
  const int* route = (const int*)(p.ws + O_ROUTE); const float2* rw = (const float2*)(p.ws + O_RW);
  int* list = (int*)(p.ws + O_LIST) + ((size_t)moe_idx * NE + e) * R; float* lw = (float*)(p.ws + O_LW) + ((size_t)moe_idx * NE + e) * R;
  const int lane = tid & 63, wid = tid >> 6;
  int c = 0;
  const int tend = min(seg * SEG, R);
  for (int t = tid; t < tend; t += 8 * NTHR) {
    int rt[8];
#pragma unroll
    for (int u = 0; u < 8; ++u) rt[u] = (t + u * NTHR < tend) ? route[t + u * NTHR] : -1;
#pragma unroll
    for (int u = 0; u < 8; ++u) c += (rt[u] >= 0) & (((rt[u] & 255) == e) | ((rt[u] >> 8) == e));
  }
  for (int o = 32; o; o >>= 1) c += __shfl_xor(c, o);
  const int t0 = seg * SEG;
  const int ta = t0 + tid, tb = t0 + NTHR + tid;
  const bool ha = tid < SEG && ta < R, hb = NTHR + tid < SEG && tb < R;
  const int ra = ha ? route[ta] : -1, rb = hb ? route[tb] : -1;
  const bool ma = ha && (((ra & 255) == e) | ((ra >> 8) == e)), mb = hb && (((rb & 255) == e) | ((rb >> 8) == e));
  const unsigned long long ba = __ballot(ma), bb = __ballot(mb);
  const unsigned long long below = (1ull << lane) - 1ull;
  __syncthreads();
  if (lane == 0) { sc[wid] = c; sc[8 + wid] = __popcll(ba); sc[16 + wid] = __popcll(bb); }
  __syncthreads();
  int base = 0, tota = 0, prea = 0, preb = 0;
#pragma unroll
  for (int w = 0; w < 8; ++w) { base += sc[w]; tota += sc[8 + w]; if (w < wid) { prea += sc[8 + w]; preb += sc[16 + w]; } }
  int totb = 0;
#pragma unroll
  for (int w = 0; w < 8; ++w) totb += sc[16 + w];
  if (ma) { const int pos = base + prea + __popcll(ba & below); const float2 w = rw[ta]; list[pos] = ta * 2 + (((ra & 255) == e) ? 0 : 1); lw[pos] = ((ra & 255) == e) ? w.x : w.y; }
  if (mb) { const int pos = base + tota + preb + __popcll(bb & below); const float2 w = rw[tb]; list[pos] = tb * 2 + (((rb & 255) == e) ? 0 : 1); lw[pos] = ((rb & 255) == e) ? w.x : w.y; }
  if (seg == nseg - 1 && tid == 0) ((int*)(p.ws + O_CNT))[moe_idx * 8 + e] = base + tota + totb;
  __syncthreads();
}
DI void moe_combine(const Prm& p, int l) {
  const bf16_t* Y = (const bf16_t*)(p.ws + M_Y); const float* mod = (const float*)(p.ws + O_MOD);
  const int gt = obid() * NTHR + otid(), gn = ogrid() * NTHR;
  for (int e = gt; e < R * 256; e += gn) {
    const int r = e >> 8, c = (e & 255) * 4;
    float* xr = xrow(p, r) + c;
    const float4 g4 = *(const float4*)(mod + (size_t)(l * 2 + (r >= S ? 1 : 0)) * 6144 + 5 * D + c);
    const uint2 u0 = *(const uint2*)(Y + (size_t)(2 * r) * D + c), u1 = *(const uint2*)(Y + (size_t)(2 * r + 1) * D + c);
    float y0[4], y1[4]; unpack4(u0, y0); unpack4(u1, y1);
    float4 xv = *(float4*)xr;
    xv.x += g4.x * (y0[0] + y1[0]); xv.y += g4.y * (y0[1] + y1[1]); xv.z += g4.z * (y0[2] + y1[2]); xv.w += g4.w * (y0[3] + y1[3]);
    *(float4*)xr = xv;
  }
}
DI void moe_gu(const Prm& p, int moe_idx, bf16_t* sm, int cv0 = 0, int cv1 = 0) {
  MoeMap m; moe_map(p, moe_idx, m);
  const bf16_t* H = (const bf16_t*)(p.ws + O_H); bf16_t* ACT = (bf16_t*)(p.ws + O_ACT);
  const int* list = (const int*)(p.ws + O_LIST) + (size_t)moe_idx * NE * R;
  gemm_split<false>(cv0 >= cv1, m.ntiles, 2 * FF / 256, D, sm, p.ws,
    [&](int mt, int nt, auto&& use) {
      int e, lt, ce; moe_find(p, moe_idx, m, mt, e, lt, ce);
      const bf16_t* Wt = (const bf16_t*)(p.ws + W_MGU) + (size_t)(moe_idx * 8 + e) * 2 * FF * D;
      const int* le = list + (size_t)e * R;
      use([&](int r) { const int idx = min(lt * 256 + r, ce - 1); return H + (size_t)(le[idx] >> 1) * D; },
          [&](int r) { return Wt + (size_t)ileave8(nt * 256 + r, FF) * D; },
          [&](f32x4 (&acc)[8][4], int wm, int wn, int lane) { swiglu_epi<8>(ACT, acc, mt * 256 + wm * 128, (nt * 4 + wn) * 32, lane); });
    },
    [&](int mt, int nt, auto&& use) {
      int e, lt, ce; moe_find(p, moe_idx, m, mt >> 2, e, lt, ce);
      const bf16_t* Wt = (const bf16_t*)(p.ws + W_MGU) + (size_t)(moe_idx * 8 + e) * 2 * FF * D;
      const int* le = list + (size_t)e * R;
      use([&](int r) { const int idx = min(lt * 256 + (mt & 3) * 64 + r, ce - 1); return H + (size_t)(le[idx] >> 1) * D; },
          [&](int r) { return Wt + (size_t)ileave8(nt * 128 + r, FF) * D; },
          [&](f32x4 (&acc)[1][4], int wm, int wn, int lane) { swiglu_epi<1>(ACT, acc, mt * 64 + wm * 16, (nt * 2 + wn) * 32, lane); });
    }, &p, cv0, cv1);
}
template <int MI, class ACC>
DI void moedown_epi(const Prm& p, int moe_idx, ACC& acc, int e, int idx0, int ce, int col0, int lane) {
  const int* list = (const int*)(p.ws + O_LIST) + (size_t)moe_idx * NE * R;
  const float* lw = (const float*)(p.ws + O_LW) + (size_t)moe_idx * NE * R;
  bf16_t* Y = (bf16_t*)(p.ws + M_Y);
#pragma unroll
  for (int i = 0; i < MI; ++i) {
    const int idx = idx0 + i * 16 + (lane & 15);
    if (idx < ce) {
      const int slot = list[(size_t)e * R + idx]; const float w = lw[(size_t)e * R + idx];
      bf16_t* yr = Y + (size_t)slot * D;
#pragma unroll
      for (int j = 0; j < 4; j += 2) {
        const int col = col0 + (j >> 1) * 32 + 8 * (lane >> 4);
        *(uint4*)(yr + col) = pack8(acc[i][j] * w, acc[i][j + 1] * w);
      }
    }
  }
}
DI void moe_down(const Prm& p, int moe_idx, int l, bf16_t* sm, int cv0 = 0, int cv1 = 0) {
  MoeMap m; moe_map(p, moe_idx, m);
  const bf16_t* ACT = (const bf16_t*)(p.ws + O_ACT);
  gemm_split<false>(cv0 >= cv1, m.ntiles, D / 256, FF, sm, p.ws,
    [&](int mt, int nt, auto&& use) {
      int e, lt, ce; moe_find(p, moe_idx, m, mt, e, lt, ce);
      const bf16_t* Wt = (const bf16_t*)(p.ws + W_MDN) + (size_t)(moe_idx * 8 + e) * D * FF;
      use([&](int r) { return ACT + (size_t)(mt * 256 + r) * FF; },
          [&](int r) { return Wt + (size_t)(nt * 256 + perm8(r)) * FF; },
          [&](f32x4 (&acc)[8][4], int wm, int wn, int lane) { moedown_epi<8>(p, moe_idx, acc, e, lt * 256 + wm * 128, ce, nt * 256 + wn * 64, lane); });
    },
    [&](int mt, int nt, auto&& use) {
      int e, lt, ce; moe_find(p, moe_idx, m, mt >> 2, e, lt, ce);
      const bf16_t* Wt = (const bf16_t*)(p.ws + W_MDN) + (size_t)(moe_idx * 8 + e) * D * FF;
      use([&](int r) { return ACT + (size_t)(mt * 64 + r) * FF; },
          [&](int r) { return Wt + (size_t)(nt * 128 + perm8(r)) * FF; },
          [&](f32x4 (&acc)[1][4], int wm, int wn, int lane) { moedown_epi<1>(p, moe_idx, acc, e, lt * 256 + (mt & 3) * 64 + wm * 16, ce, nt * 128 + wn * 64, lane); });
    }, &p, cv0, cv1);
}

template <int MI, class ACC>
DI void inproj_epi(bf16_t* XZ, bf16_t* GG, ACC& acc, int row0, int col0, int lane) {
#pragma unroll
  for (int i = 0; i < MI; ++i) {
    const int row = row0 + i * 16 + (lane & 15);
#pragma unroll
    for (int jj = 0; jj < 4; jj += 2) {
      const int col = col0 + (jj >> 1) * 32 + 8 * (lane >> 4);
      if (col0 < D) *(uint4*)(XZ + (size_t)row * D + col) = pack8(acc[i][jj], acc[i][jj + 1]);
      else { f32x4 o0, o1; for (int q = 0; q < 4; ++q) { o0[q] = gelut(acc[i][jj][q]); o1[q] = gelut(acc[i][jj + 1][q]); } *(uint4*)(GG + (size_t)row * D + col - D) = pack8(o0, o1); }
    }
  }
}
DI void rg_inproj(const Prm& p, int j, bf16_t* sm, int cv0 = 0, int cv1 = 0) {
  const bf16_t* H = (const bf16_t*)(p.ws + O_H); const bf16_t* Wt = (const bf16_t*)(p.ws + W_RGIN) + (size_t)j * 2048 * D;
  bf16_t* XZ = (bf16_t*)(p.ws + M_XZ); bf16_t* GG = (bf16_t*)(p.ws + M_GG);
  gemm_split<false>(false, R / 256, 8, D, sm, p.ws,
    [&](int mt, int nt, auto&& use) {
      use([&](int r) { return H + (size_t)(mt * 256 + r) * D; },
          [&](int r) { return Wt + (size_t)(nt * 256 + perm8(r)) * D; },
          [&](f32x4 (&acc)[8][4], int wm, int wn, int lane) { inproj_epi<8>(XZ, GG, acc, mt * 256 + wm * 128, nt * 256 + wn * 64, lane); });
    },
    [&](int mt, int nt, auto&& use) {
      use([&](int r) { return H + (size_t)(mt * 64 + r) * D; },
          [&](int r) { return Wt + (size_t)(nt * 128 + perm8(r)) * D; },
          [&](f32x4 (&acc)[1][4], int wm, int wn, int lane) { inproj_epi<1>(XZ, GG, acc, mt * 64 + wm * 16, nt * 128 + wn * 64, lane); });
    }, &p, cv0, cv1);
}
DI void rg_conv(const Prm& p, int j) {
  const bf16_t* XZ = (const bf16_t*)(p.ws + M_XZ); bf16_t* XL = (bf16_t*)(p.ws + M_XL);
  const float* cw = p.conv_w + (size_t)j * 4 * D; const float* cb = p.conv_b + (size_t)j * D;
  const int gt = obid() * NTHR + otid(), gn = ogrid() * NTHR;
  if ((gn & 127) != 0) return;
  const int c0 = (gt & 127) * 8;
  float w[4][8], bias[8];
#pragma unroll
  for (int q = 0; q < 8; ++q) bias[q] = cb[c0 + q];
#pragma unroll
  for (int t = 0; t < 4; ++t)
#pragma unroll
    for (int q = 0; q < 8; ++q) w[t][q] = cw[t * D + c0 + q];
  const u32x4 z4 = {0u, 0u, 0u, 0u};
  auto ld = [&](int e, u32x4 (&v)[4]) {
    const int row = e >> 7, lo = row < S ? 0 : S, hi = row < S ? S : R;
#pragma unroll
    for (int t = 0; t < 4; ++t) { const int rr = row + t - 2; v[t] = (rr >= lo && rr < hi) ? *(const u32x4*)(XZ + (size_t)rr * D + c0) : z4; }
  };
  auto st = [&](int e, u32x4 (&v)[4]) {
    const int row = e >> 7;
    float a[8];
#pragma unroll
    for (int q = 0; q < 8; ++q) a[q] = bias[q];
#pragma unroll
    for (int t = 0; t < 4; ++t)
#pragma unroll
      for (int q = 0; q < 4; ++q) { a[2 * q] += __uint_as_float(v[t][q] << 16) * w[t][2 * q]; a[2 * q + 1] += __uint_as_float(v[t][q] & 0xffff0000u) * w[t][2 * q + 1]; }
    *(uint4*)(XL + (size_t)row * D + c0) = make_uint4(pack2(a[0], a[1]), pack2(a[2], a[3]), pack2(a[4], a[5]), pack2(a[6], a[7]));
  };
  u32x4 v0[4], v1[4];
  int e = gt;
  if (e < R * 128) ld(e, v0);
  for (; e < R * 128; e += 2 * gn) {
    const bool m1 = e + gn < R * 128, m2 = e + 2 * gn < R * 128;
    if (m1) ld(e + gn, v1);
    st(e, v0);
    if (m2) ld(e + 2 * gn, v0);
    if (m1) st(e + gn, v1);
  }
}
template <int MI, class ACC>
DI void gates_epi(const Prm& p, int j, ACC& acc, int row0, int col0, int lane) {
  const bf16_t* XL = (const bf16_t*)(p.ws + M_XL); bf16_t* LA = (bf16_t*)(p.ws + M_LA); bf16_t* IX = (bf16_t*)(p.ws + M_IX);
  const int d = col0 >> 11, gate = (col0 >> 10) & 1, chw = col0 & 1023;
  const float* bias = (gate ? p.rg_bi : p.rg_ba) + (size_t)(j * 2 + d) * D;
  const float* lam = p.rg_lam + (size_t)(j * 2 + d) * D;
#pragma unroll
  for (int i = 0; i < MI; ++i) {
    const int row = row0 + i * 16 + (lane & 15);
#pragma unroll
    for (int jj = 0; jj < 4; jj += 2) {
      const int ch = chw + (jj >> 1) * 32 + 8 * (lane >> 4);
      float bb[8], v[8];
      { const float4 b0 = *(const float4*)(bias + ch), b1 = *(const float4*)(bias + ch + 4); bb[0] = b0.x; bb[1] = b0.y; bb[2] = b0.z; bb[3] = b0.w; bb[4] = b1.x; bb[5] = b1.y; bb[6] = b1.z; bb[7] = b1.w; }
#pragma unroll
      for (int q = 0; q < 4; ++q) { v[q] = acc[i][jj][q]; v[4 + q] = acc[i][jj + 1][q]; }
      f32x4 o0, o1;
      if (gate == 0) {
        float ll[8];
        { const float4 l0 = *(const float4*)(lam + ch), l1 = *(const float4*)(lam + ch + 4); ll[0] = l0.x; ll[1] = l0.y; ll[2] = l0.z; ll[3] = l0.w; ll[4] = l1.x; ll[5] = l1.y; ll[6] = l1.z; ll[7] = l1.w; }
#pragma unroll
        for (int q = 0; q < 4; ++q) { o0[q] = -8.f * sigm(v[q] + bb[q]) * softplus_neg(ll[q]); o1[q] = -8.f * sigm(v[4 + q] + bb[4 + q]) * softplus_neg(ll[4 + q]); }
        *(uint4*)(LA + ((size_t)d * R + row) * D + ch) = pack8(o0, o1);
      } else {
        const uint4 xv = *(const uint4*)(XL + (size_t)row * D + ch);
        float x0[4], x1[4]; unpack4(make_uint2(xv.x, xv.y), x0); unpack4(make_uint2(xv.z, xv.w), x1);
#pragma unroll
        for (int q = 0; q < 4; ++q) { o0[q] = sigm(v[q] + bb[q]) * x0[q]; o1[q] = sigm(v[4 + q] + bb[4 + q]) * x1[q]; }
        *(uint4*)(IX + ((size_t)d * R + row) * D + ch) = pack8(o0, o1);
      }
    }
  }
}
DI void rg_gates(const Prm& p, int j, bf16_t* sm, int cv0 = 0, int cv1 = 0) {
  const bf16_t* XL = (const bf16_t*)(p.ws + M_XL); const bf16_t* Wt = (const bf16_t*)(p.ws + W_GATE) + (size_t)j * 4096 * 256;
  gemm_split<false>(false, R / 256, 16, 256, sm, p.ws,
    [&](int mt, int nt, auto&& use) {
      const int nblk = ((nt * 256) & 1023) >> 8;
      use([&](int r) { return XL + (size_t)(mt * 256 + r) * D + nblk * 256; },
          [&](int r) { return Wt + (size_t)(nt * 256 + perm8(r)) * 256; },
          [&](f32x4 (&acc)[8][4], int wm, int wn, int lane) { gates_epi<8>(p, j, acc, mt * 256 + wm * 128, nt * 256 + wn * 64, lane); });
    },
    [&](int mt, int nt, auto&& use) {
      const int nblk = ((nt * 128) & 1023) >> 8;
      use([&](int r) { return XL + (size_t)(mt * 64 + r) * D + nblk * 256; },
          [&](int r) { return Wt + (size_t)(nt * 128 + perm8(r)) * 256; },
          [&](f32x4 (&acc)[1][4], int wm, int wn, int lane) { gates_epi<1>(p, j, acc, mt * 64 + wm * 16, nt * 128 + wn * 64, lane); });
    }, &p, cv0, cv1);
}
constexpr int SC = 64, NCH2 = R / SC;
DI int chunk_base(int j) { return j < S / SC ? j * SC : S + (j - S / SC) * SC; }
DI void ab_from(uint2 lav, uint2 ixv, float* a, float* b) {
  float la[4], ix[4]; unpack4(lav, la); unpack4(ixv, ix);
#pragma unroll
  for (int q = 0; q < 4; ++q) { a[q] = __expf(la[q]); b[q] = __builtin_amdgcn_sqrtf(fmaxf(1.f - a[q] * a[q], 0.f)) * ix[q]; }
}
DI void rg_scan1(const Prm& p) {
  const bf16_t* LA = (const bf16_t*)(p.ws + M_LA); const bf16_t* IX = (const bf16_t*)(p.ws + M_IX);
  float* CA = (float*)(p.ws + M_CA); float* CB = (float*)(p.ws + M_CB);
  const int gt = obid() * NTHR + otid(), gn = ogrid() * NTHR;
  for (int e = gt; e < 2 * NCH2 * 256; e += gn) {
    const int cq = e & 255, dj = e >> 8, d = dj / NCH2, j = dj % NCH2, base = chunk_base(j);
    float A[4] = {1.f, 1.f, 1.f, 1.f}, B[4] = {0.f, 0.f, 0.f, 0.f};
    const size_t off0 = ((size_t)d * R) * D + cq * 4;
    uint2 l0[8], i0[8], l1[8], i1[8];
    auto ld = [&](int s0, uint2 (&lv)[8], uint2 (&iv)[8]) {
#pragma unroll
      for (int u = 0; u < 8; ++u) { const int row = d ? base + SC - 1 - (s0 + u) : base + s0 + u; lv[u] = *(const uint2*)(LA + off0 + (size_t)row * D); iv[u] = *(const uint2*)(IX + off0 + (size_t)row * D); }
    };
    auto fold = [&](uint2 (&lv)[8], uint2 (&iv)[8]) {
#pragma unroll
      for (int u = 0; u < 8; ++u) {
        float a[4], b[4]; ab_from(lv[u], iv[u], a, b);
#pragma unroll
        for (int q = 0; q < 4; ++q) { B[q] = a[q] * B[q] + b[q]; A[q] *= a[q]; }
      }
    };
    ld(0, l0, i0);
    for (int s0 = 0; s0 < SC; s0 += 16) { ld(s0 + 8, l1, i1); fold(l0, i0); if (s0 + 16 < SC) ld(s0 + 16, l0, i0); fold(l1, i1); }
    *(float4*)(CA + (size_t)dj * D + cq * 4) = make_float4(A[0], A[1], A[2], A[3]);
    *(float4*)(CB + (size_t)dj * D + cq * 4) = make_float4(B[0], B[1], B[2], B[3]);
  }
}
DI void rg_scan2(const Prm& p) {
  const bf16_t* LA = (const bf16_t*)(p.ws + M_LA); const bf16_t* IX = (const bf16_t*)(p.ws + M_IX); const bf16_t* GG = (const bf16_t*)(p.ws + M_GG);
  const float* CA = (const float*)(p.ws + M_CA); const float* CB = (const float*)(p.ws + M_CB);
  bf16_t* TMP = (bf16_t*)(p.ws + M_TMP); bf16_t* YIN = (bf16_t*)(p.ws + M_YIN);
  const int gt = obid() * NTHR + otid(), gn = ogrid() * NTHR;
  constexpr int NL = S / SC, NC = CT / SC;
  for (int e = gt; e < NCH2 * 256; e += gn) {
    const int cq = e & 255, j = e >> 8, base = chunk_base(j);
    float hf[4] = {0.f, 0.f, 0.f, 0.f}, hb[4] = {0.f, 0.f, 0.f, 0.f};
    const int pf = j >= NL ? j - NL : j + NC;
    for (int p0 = 0; p0 < pf; p0 += 8) {
      float4 av[8], bv[8];
#pragma unroll
      for (int u = 0; u < 8; ++u) { const int pos = min(p0 + u, pf - 1); const int i = pos < NC ? NL + pos : pos - NC; av[u] = *(const float4*)(CA + (size_t)i * D + cq * 4); bv[u] = *(const float4*)(CB + (size_t)i * D + cq * 4); }
#pragma unroll
      for (int u = 0; u < 8; ++u) if (p0 + u < pf) { hf[0] = av[u].x * hf[0] + bv[u].x; hf[1] = av[u].y * hf[1] + bv[u].y; hf[2] = av[u].z * hf[2] + bv[u].z; hf[3] = av[u].w * hf[3] + bv[u].w; }
    }
    const int pb = NCH2 - 1 - j;
    for (int p0 = 0; p0 < pb; p0 += 8) {
      float4 av[8], bv[8];
#pragma unroll
      for (int u = 0; u < 8; ++u) { const int pos = min(p0 + u, pb - 1); const int i = NCH2 - 1 - pos; av[u] = *(const float4*)(CA + (size_t)(NCH2 + i) * D + cq * 4); bv[u] = *(const float4*)(CB + (size_t)(NCH2 + i) * D + cq * 4); }
#pragma unroll
      for (int u = 0; u < 8; ++u) if (p0 + u < pb) { hb[0] = av[u].x * hb[0] + bv[u].x; hb[1] = av[u].y * hb[1] + bv[u].y; hb[2] = av[u].z * hb[2] + bv[u].z; hb[3] = av[u].w * hb[3] + bv[u].w; }
    }
    const size_t c0 = (size_t)cq * 4;
    {
      uint2 l0[8], i0[8], l1[8], i1[8];
      auto ld = [&](int s0, uint2 (&lv)[8], uint2 (&iv)[8]) {
#pragma unroll
        for (int u = 0; u < 8; ++u) { const size_t ix = (size_t)(base + s0 + u) * D + c0; lv[u] = *(const uint2*)(LA + ix); iv[u] = *(const uint2*)(IX + ix); }
      };
      auto fold = [&](int s0, uint2 (&lv)[8], uint2 (&iv)[8]) {
#pragma unroll
        for (int u = 0; u < 8; ++u) {
          float a[4], b[4]; ab_from(lv[u], iv[u], a, b);
#pragma unroll
          for (int q = 0; q < 4; ++q) hf[q] = a[q] * hf[q] + b[q];
          *(uint2*)(TMP + (size_t)(base + s0 + u) * D + c0) = make_uint2(pack2(hf[0], hf[1]), pack2(hf[2], hf[3]));
        }
      };
      ld(0, l0, i0);
      for (int s0 = 0; s0 < SC; s0 += 16) { ld(s0 + 8, l1, i1); fold(s0, l0, i0); if (s0 + 16 < SC) ld(s0 + 16, l0, i0); fold(s0 + 8, l1, i1); }
    }
    {
      uint2 l0[8], i0[8], t0[8], g0[8], l1[8], i1[8], t1[8], g1[8];
      auto ld = [&](int s0, uint2 (&lv)[8], uint2 (&iv)[8], uint2 (&tv)[8], uint2 (&gv)[8]) {
#pragma unroll
        for (int u = 0; u < 8; ++u) { const size_t ix = (size_t)(base + SC - 1 - (s0 + u)) * D + c0; lv[u] = *(const uint2*)(LA + (size_t)R * D + ix); iv[u] = *(const uint2*)(IX + (size_t)R * D + ix); tv[u] = *(const uint2*)(TMP + ix); gv[u] = *(const uint2*)(GG + ix); }
      };
      auto fold = [&](int s0, uint2 (&lv)[8], uint2 (&iv)[8], uint2 (&tv)[8], uint2 (&gv)[8]) {
#pragma unroll
        for (int u = 0; u < 8; ++u) {
          float a[4], b[4], t[4], g[4]; ab_from(lv[u], iv[u], a, b); unpack4(tv[u], t); unpack4(gv[u], g);
#pragma unroll
          for (int q = 0; q < 4; ++q) hb[q] = a[q] * hb[q] + b[q];
          *(uint2*)(YIN + (size_t)(base + SC - 1 - (s0 + u)) * D + c0) = make_uint2(pack2((t[0] + hb[0]) * g[0], (t[1] + hb[1]) * g[1]), pack2((t[2] + hb[2]) * g[2], (t[3] + hb[3]) * g[3]));
        }
      };
      ld(0, l0, i0, t0, g0);
      for (int s0 = 0; s0 < SC; s0 += 16) { ld(s0 + 8, l1, i1, t1, g1); fold(s0, l0, i0, t0, g0); if (s0 + 16 < SC) ld(s0 + 16, l0, i0, t0, g0); fold(s0 + 8, l1, i1, t1, g1); }
    }
  }
}

template <int MI, class ACC>
DI void qk_epi(const Prm& p, ACC& acc, int row0, int col0, int lane) {
  bf16_t* Qb = (bf16_t*)(p.ws + M_Q); bf16_t* Kb = (bf16_t*)(p.ws + M_K);
  const bool isq = col0 < D; const float* gv = isq ? p.na_qg : p.na_kg; bf16_t* O = isq ? Qb : Kb;
  const int colb = col0 & 1023; const float osc = isq ? 0.125f : 1.f;
#pragma unroll
  for (int i = 0; i < MI; ++i) {
    const int row = row0 + i * 16 + (lane & 15);
    float ss = 0.f;
#pragma unroll
    for (int jj = 0; jj < 4; ++jj)
#pragma unroll
      for (int q = 0; q < 4; ++q) ss += acc[i][jj][q] * acc[i][jj][q];
    ss += __shfl_xor(ss, 16); ss += __shfl_xor(ss, 32);
    const float rstd = __builtin_amdgcn_rsqf(ss * (1.f / 64.f) + 1e-6f) * osc;
#pragma unroll
    for (int jj = 0; jj < 4; jj += 2) {
      const int dc = (jj >> 1) * 32 + 8 * (lane >> 4);
      const f32x4 g0 = *(const f32x4*)(gv + dc), g1 = *(const f32x4*)(gv + dc + 4);
      *(uint4*)(O + (size_t)row * D + colb + dc) = pack8(acc[i][jj] * rstd * g0, acc[i][jj + 1] * rstd * g1);
    }
  }
}
template <int MI, class ACC>
DI void v_epi(bf16_t* VT, ACC& acc, int tok0, int hd0, int lane) {
#pragma unroll
  for (int i = 0; i < MI; ++i) {
    const int tok = tok0 + i * 16 + 4 * (lane >> 4);
#pragma unroll
    for (int jj = 0; jj < 4; ++jj) {
      const int hd = hd0 + jj * 16 + (lane & 15);
      *(uint2*)(VT + (size_t)hd * R + tok) = pack4(acc[i][jj]);
    }
  }
}
DI void na_qkv(const Prm& p, bf16_t* sm, int cv0 = 0, int cv1 = 0) {
  const int cvm = cv0 + (cv1 - cv0) / 2;
  const bf16_t* H = (const bf16_t*)(p.ws + O_H); const bf16_t* Wt = (const bf16_t*)(p.ws + W_QKV);
  bf16_t* VT = (bf16_t*)(p.ws + M_VT);
  gemm_split<false>(false, R / 256, 8, D, sm, p.ws,
    [&](int mt, int nt, auto&& use) {
      use([&](int r) { return H + (size_t)(mt * 256 + r) * D; },
          [&](int r) { return Wt + (size_t)(nt * 256 + perm8(r)) * D; },
          [&](f32x4 (&acc)[8][4], int wm, int wn, int lane) { qk_epi<8>(p, acc, mt * 256 + wm * 128, nt * 256 + wn * 64, lane); });
    },
    [&](int mt, int nt, auto&& use) {
      use([&](int r) { return H + (size_t)(mt * 64 + r) * D; },
          [&](int r) { return Wt + (size_t)(nt * 128 + perm8(r)) * D; },
          [&](f32x4 (&acc)[1][4], int wm, int wn, int lane) { qk_epi<1>(p, acc, mt * 64 + wm * 16, nt * 128 + wn * 64, lane); });
    }, &p, cv0, cvm);
  gemm_split<true>(false, R / 256, 4, D, sm, p.ws,
    [&](int mt, int nt, auto&& use) {
      use([&](int r) { return H + (size_t)(mt * 256 + r) * D; },
          [&](int r) { return Wt + (size_t)(2048 + nt * 256 + r) * D; },
          [&](f32x4 (&acc)[8][4], int wm, int wn, int lane) { v_epi<8>(VT, acc, mt * 256 + wm * 128, nt * 256 + wn * 64, lane); });
    },
    [&](int mt, int nt, auto&& use) {
      use([&](int r) { return H + (size_t)(mt * 64 + r) * D; },
          [&](int r) { return Wt + (size_t)(2048 + nt * 128 + r) * D; },
          [&](f32x4 (&acc)[1][4], int wm, int wn, int lane) { v_epi<1>(VT, acc, mt * 64 + wm * 16, nt * 128 + wn * 64, lane); });
    }, &p, cvm, cv1);
}
DI void na_attn(const Prm& p, bf16_t* sm0) {
  const int tid0 = otid(), half = tid0 >> 8, tid = tid0 & 255;
  bf16_t* sm = sm0 + half * 36864;
  bf16_t* Ks = sm; bf16_t* VTs = sm + 256 * 72; float* rp = (float*)(sm + 256 * 72 + 64 * 264);
  const bf16_t* Qb = (const bf16_t*)(p.ws + M_Q); const bf16_t* Kb = (const bf16_t*)(p.ws + M_K); const bf16_t* VT = (const bf16_t*)(p.ws + M_VT);
  bf16_t* Ob = (bf16_t*)(p.ws + M_O);
  const int lane = tid & 63, w = tid >> 6, g = lane >> 4, ql = lane & 15;
  const int G = ogrid(), b = obid();
  const int nbx = G >> 3, li = b >> 3;
  {
    const int xx = b & 7;
    for (int jj = li * 2 + half; jj < 520; jj += nbx * 2) {
      const bool lat = jj < 512;
      int h, r = 0, rs = 0, qtok;
      if (lat) { const int it = xx * 512 + jj; h = it >> 8; r = it & 255; rs = min(max(r - 4, 0), 248); qtok = r * 64 + 16 * w + ql; }
      else { const int t = xx * 8 + (jj - 512); h = t >> 2; qtok = S + (t & 3) * 64 + 16 * w + ql; }
      const int qc = 16 * w + ql, cst = min(max(qc - 8, 0), 48), cs0 = min(max(16 * w - 8, 0), 32);
      bf16x8 qf[2];
#pragma unroll
      for (int ks = 0; ks < 2; ++ks) qf[ks] = *(const bf16x8*)(Qb + (size_t)qtok * D + h * 64 + ks * 32 + g * 8);
      float m_run = -1e30f, l_run = 0.f;
      f32x4 o[4];
#pragma unroll
      for (int db = 0; db < 4; ++db) o[db] = (f32x4){0.f, 0.f, 0.f, 0.f};
      __syncthreads();
      if (lat) for (int e = tid; e < 465; e += 256) rp[e] = p.na_rpb[(size_t)h * 465 + e];
      const char* const kbase = (const char*)Kb + (size_t)h * 128; const char* const vbase = (const char*)VT + (size_t)h * 64 * R * 2;
      for (int c = lat ? 0 : 2; c < 4; ++c) {
        __syncthreads();
        {
          const int nkeys = c < 2 ? 256 : 128, tok0 = c < 2 ? (rs + 4 * c) * 64 : S + (c - 2) * 128, psh = c < 2 ? 5 : 4, pmk = (1 << psh) - 1, ni = nkeys >> 5;
          u32x4 kreg[8], vreg[8];
#pragma unroll
          for (int i = 0; i < 8; ++i) if (i < ni) {
            const int ch = tid + 256 * i;
            const unsigned ko = (unsigned)((tok0 + (ch >> 3)) * D + (ch & 7) * 8) * 2u, vo = (unsigned)((ch >> psh) * R + tok0 + (ch & pmk) * 8) * 2u;
            kreg[i] = *(const u32x4*)(kbase + ko);
            vreg[i] = *(const u32x4*)(vbase + vo);
          }
#pragma unroll
          for (int i = 0; i < 8; ++i) if (i < ni) {
            const int ch = tid + 256 * i;
            *(u32x4*)(Ks + (ch >> 3) * 72 + (ch & 7) * 8) = kreg[i];
            *(u32x4*)(VTs + (ch >> psh) * 264 + (ch & pmk) * 8) = vreg[i];
          }
        }
        __syncthreads();
        f32x4 s[8];
#pragma unroll
        for (int kb = 0; kb < 8; ++kb) {
          const int kbase = c < 2 ? (kb >> 1) * 64 + cs0 + 16 * (kb & 1) : kb * 16;
          s[kb] = (f32x4){0.f, 0.f, 0.f, 0.f};
#pragma unroll
          for (int ks = 0; ks < 2; ++ks) { const bf16x8 kf = *(const bf16x8*)(Ks + (kbase + ql) * 72 + ks * 32 + g * 8); s[kb] = MFMA16(kf, qf[ks], s[kb]); }
        }
        if (c < 2) {
#pragma unroll
          for (int kb = 0; kb < 8; ++kb) {
            const int krow = rs + 4 * c + (kb >> 1), rbi = krow - r + 7;
#pragma unroll
            for (int q = 0; q < 4; ++q) {
              const int kc = cs0 + 16 * (kb & 1) + 4 * g + q;
              const bool valid = (kc >= cst) && (kc < cst + 16);
              const int cbi = min(max(kc - qc + 15, 0), 30);
              s[kb][q] = valid ? s[kb][q] + rp[rbi * 31 + cbi] : -1e30f;
            }
          }
        }
        float mx = -1e30f;
#pragma unroll
        for (int kb = 0; kb < 8; ++kb)
#pragma unroll
          for (int q = 0; q < 4; ++q) mx = fmaxf(mx, s[kb][q]);
        mx = fmaxf(mx, __shfl_xor(mx, 16)); mx = fmaxf(mx, __shfl_xor(mx, 32));
        const float m_new = fmaxf(m_run, mx), alpha = __expf(m_run - m_new);
        float ls = 0.f;
#pragma unroll
        for (int kb = 0; kb < 8; ++kb)
#pragma unroll
          for (int q = 0; q < 4; ++q) { s[kb][q] = __expf(s[kb][q] - m_new); ls += s[kb][q]; }
        l_run = l_run * alpha + ls; m_run = m_new;
#pragma unroll
        for (int db = 0; db < 4; ++db) { o[db][0] *= alpha; o[db][1] *= alpha; o[db][2] *= alpha; o[db][3] *= alpha; }
#pragma unroll
        for (int t = 0; t < 4; ++t) {
          const int kb0 = c < 2 ? ((2 * t) >> 1) * 64 + cs0 : (2 * t) * 16, kb1 = c < 2 ? kb0 + 16 : kb0 + 16;
          const uint2 p0 = pack4(s[2 * t]), p1 = pack4(s[2 * t + 1]);
          const uint4 pu = make_uint4(p0.x, p0.y, p1.x, p1.y);
          const bf16x8 pf = __builtin_bit_cast(bf16x8, pu);
#pragma unroll
          for (int db = 0; db < 4; ++db) {
            const s16x4 v0 = *(const s16x4*)(VTs + (db * 16 + ql) * 264 + kb0 + 4 * g), v1 = *(const s16x4*)(VTs + (db * 16 + ql) * 264 + kb1 + 4 * g);
            const bf16x8 vf = __builtin_shufflevector(v0, v1, 0, 1, 2, 3, 4, 5, 6, 7);
            o[db] = MFMA16(vf, pf, o[db]);
          }
        }
      }
      l_run += __shfl_xor(l_run, 16); l_run += __shfl_xor(l_run, 32);
      const float inv = 1.f / l_run;
#pragma unroll
      for (int db = 0; db < 4; ++db) { f32x4 v = o[db]; v[0] *= inv; v[1] *= inv; v[2] *= inv; v[3] *= inv; *(uint2*)(Ob + (size_t)qtok * D + h * 64 + db * 16 + 4 * g) = pack4(v); }
    }
  }
}

DI void ft_chan(const Prm& p, bf16_t* sm) {
  const bf16_t* H = (const bf16_t*)(p.ws + O_H); const bf16_t* Bc = (const bf16_t*)(p.ws + W_BC);
  bf16_t* UT = (bf16_t*)(p.ws + M_UT); bf16_t* UTC = (bf16_t*)(p.ws + M_UTC);
  gemm_stream<true, 4, 2, 4>(130, 8, 256, sm, p.ws, [&](int mt, int nt, auto&& use) {
    const int grp = nt >> 1;
    use(
        [&](int r0) { const int r = perm8(r0); const int tok = mt < 128 ? 128 * r + mt : S + (mt - 128) * 128 + r; return H + (size_t)tok * D + grp * 256; },
        [&](int r) { return Bc + (size_t)((nt & 1) * 256 + r) * 256; },
        [&](f32x4 (&acc)[4][4], int wm, int wn, int lane) {
#pragma unroll
          for (int i = 0; i < 4; i += 2) {
            const int tr = wm * 64 + (i >> 1) * 32 + 8 * (lane >> 4);
#pragma unroll
            for (int jj = 0; jj < 4; ++jj) {
              const int cc = (nt & 1) * 256 + wn * 64 + jj * 16 + (lane & 15), ri = cc >> 8, ch = grp * 256 + (cc & 255);
              const uint4 w = pack8(acc[i][jj], acc[i + 1][jj]);
              if (mt < 128) *(uint4*)(UT + (((size_t)mt * D + ch) * 2 + ri) * 128 + tr) = w;
              else *(uint4*)(UTC + ((size_t)ch * 2 + ri) * 256 + (mt - 128) * 128 + tr) = w;
            }
          }
        });
  });
}
DI void ft_step1(const Prm& p, bf16_t* sm) {
  const bf16_t* UT = (const bf16_t*)(p.ws + M_UT); const bf16_t* UTC = (const bf16_t*)(p.ws + M_UTC);
  const bf16_t* D1 = (const bf16_t*)(p.ws + W_D1); const bf16_t* Dc = (const bf16_t*)(p.ws + W_DC);
  bf16_t* AT = (bf16_t*)(p.ws + M_AT); bf16_t* F = (bf16_t*)(p.ws + M_F);
  gemm_stream<true, 4, 2, 4>(1024, 1, 256, sm, p.ws, [&](int mt, int nt, auto&& use) {
    const int ch = mt;
    use(
        [&](int r) { return UT + ((size_t)perm8(r) * D + ch) * 256; },
        [&](int r) { return D1 + (size_t)ileave(r, 128) * 256; },
        [&](f32x4 (&acc)[4][4], int wm, int wn, int lane) {
#pragma unroll
          for (int i = 0; i < 4; i += 2) {
            const int t2 = wm * 64 + (i >> 1) * 32 + 8 * (lane >> 4);
#pragma unroll
            for (int jj = 0; jj < 2; ++jj) {
              const int k1 = wn * 32 + jj * 16 + (lane & 15);
              f32x4 orr[2], oi[2];
#pragma unroll
              for (int u = 0; u < 2; ++u)
#pragma unroll
                for (int q = 0; q < 4; ++q) {
                  float st, ct; sincos_rev((float)(k1 * (t2 + 4 * u + q)) * (1.f / 16384.f), &st, &ct);
                  const float ar = acc[i + u][jj][q], ai = acc[i + u][jj + 2][q];
                  orr[u][q] = ar * ct + ai * st; oi[u][q] = ai * ct - ar * st;
                }
              *(uint4*)(AT + (((size_t)k1 * D + ch) * 2 + 0) * 128 + t2) = pack8(orr[0], orr[1]);
              *(uint4*)(AT + (((size_t)k1 * D + ch) * 2 + 1) * 128 + t2) = pack8(oi[0], oi[1]);
            }
          }
        });
  });
  gemm_stream<true, 4, 2, 4>(8, 1, 512, sm, p.ws, [&](int mt, int nt, auto&& use) {
    const int ch0 = mt * 128;
    use(
        [&](int r) { return UTC + (size_t)(ch0 + perm8(r)) * 512; },
        [&](int r) { return Dc + (size_t)r * 512; },
        [&](f32x4 (&acc)[4][4], int wm, int wn, int lane) {
#pragma unroll
          for (int i = 0; i < 4; i += 2) {
            const int ch = ch0 + wm * 64 + (i >> 1) * 32 + 8 * (lane >> 4);
#pragma unroll
            for (int jj = 0; jj < 4; ++jj) {
              const int k = wn * 64 + jj * 16 + (lane & 15);
              *(uint4*)(F + (size_t)(S + k) * D + ch) = pack8(acc[i][jj], acc[i + 1][jj]);
            }
          }
        });
  });
}
DI void ft_step3(const Prm& p, bf16_t* sm) {
  const bf16_t* AT = (const bf16_t*)(p.ws + M_AT); const bf16_t* D3 = (const bf16_t*)(p.ws + W_D3); bf16_t* F = (bf16_t*)(p.ws + M_F);
  gemm_stream<true, 4, 4, 2>(512, 1, 256, sm, p.ws, [&](int mt, int nt, auto&& use) {
    const int k1 = mt >> 2, ch0 = (mt & 3) * 256;
    use(
        [&](int r) { return AT + ((size_t)k1 * D + ch0 + perm8(r)) * 256; },
        [&](int r) { return D3 + (size_t)r * 256; },
        [&](f32x4 (&acc)[4][4], int wm, int wn, int lane) {
#pragma unroll
          for (int i = 0; i < 4; i += 2) {
            const int ch = ch0 + wm * 64 + (i >> 1) * 32 + 8 * (lane >> 4);
#pragma unroll
            for (int jj = 0; jj < 4; ++jj) {
              const int k2 = wn * 64 + jj * 16 + (lane & 15);
              *(uint4*)(F + (size_t)(128 * k2 + k1) * D + ch) = pack8(acc[i][jj], acc[i + 1][jj]);
            }
          }
        });
  });
}

#define XB_TMO      128
#define XB_XCNT(j)  (256  + 64 * (j))
#define XB_XSUB(j)  (1280 + 64 * (j))
#define XB_XGEN(j)  (2304 + 64 * (j))
#define XB_TOP      3328
#define XB_TOPGEN   3392
#define XCD_BAR_WORDS 3456
#define XB_SPIN_CAP (1u << 18)
#define LAS __attribute__((address_space(3)))

__device__ __forceinline__ unsigned xb_ld(unsigned* p)              { return __hip_atomic_load(p, __ATOMIC_RELAXED, __HIP_MEMORY_SCOPE_AGENT); }
__device__ __forceinline__ unsigned xb_add(unsigned* p, unsigned v) { return __hip_atomic_fetch_add(p, v, __ATOMIC_RELAXED, __HIP_MEMORY_SCOPE_AGENT); }
__device__ __forceinline__ unsigned xb_xcc_id() { return (unsigned)__builtin_amdgcn_s_getreg((3 << 11) | 20) & 0xFu; }
#define XB_SPIN(cond, bar) do { unsigned _sp = 0; while (cond) { __builtin_amdgcn_s_sleep(1); \
    if ((++_sp & 255u) == 0u) { if (xb_ld(&(bar)[XB_TMO])) break; if (_sp > XB_SPIN_CAP) { atomicAdd(&(bar)[XB_TMO], 1u); break; } } } } while (0)

struct XcdBarrier {
    unsigned* bar; unsigned x;
    volatile LAS unsigned* st;
};

__device__ __forceinline__ XcdBarrier xcd_barrier_post(unsigned* bar, volatile LAS unsigned* st) {
    XcdBarrier b; b.bar = bar; b.x = xb_xcc_id(); b.st = st;
    if (threadIdx.x == 0) (void)xb_add(&bar[XB_XCNT(b.x)], 1u);
    return b;
}
__device__ __forceinline__ void xcd_barrier_complete(unsigned* bar, unsigned x, unsigned& nloc, unsigned& nx) {
    const unsigned G = gridDim.x * gridDim.y * gridDim.z;
    unsigned sum, cnt, mine, sp = 0u;
    for (;;) {
        sum = 0u; cnt = 0u; mine = 0u;
#pragma unroll
        for (unsigned j = 0; j < 16; ++j) { const unsigned c = xb_ld(&bar[XB_XCNT(j)]); sum += c; cnt += (c > 0u) ? 1u : 0u; mine = (j == x) ? c : mine; }
        if (sum == G) break;
        __builtin_amdgcn_s_sleep(1);
        if ((++sp & 255u) == 0u) { if (xb_ld(&bar[XB_TMO])) break; if (sp > XB_SPIN_CAP) { atomicAdd(&bar[XB_TMO], 1u); break; } }
    }
    nloc = mine > 0u ? mine : 1u; nx = cnt > 0u ? cnt : 1u;
}

__device__ __forceinline__ void xcd_barrier(const XcdBarrier& b) {
    asm volatile("s_waitcnt vmcnt(0)" ::: "memory");
    __syncthreads();
    if (threadIdx.x == 0) {
        unsigned* bar = b.bar;
        __builtin_amdgcn_s_waitcnt(0);
        unsigned nloc = b.st[0], nx = b.st[1];
        if (nloc == 0u) { xcd_barrier_complete(bar, b.x, nloc, nx); b.st[0] = nloc; b.st[1] = nx; }
        const unsigned old = xb_add(&bar[XB_XSUB(b.x)], 1u);
        const unsigned gen = old / nloc;
        if (old + 1u == (gen + 1u) * nloc) {
            __builtin_amdgcn_fence(__ATOMIC_RELEASE, "agent");
            asm volatile("s_waitcnt vmcnt(0)" ::: "memory");
            const unsigned og = xb_add(&bar[XB_TOP], 1u);
            const unsigned tg = og / nx;
            if (og + 1u == (tg + 1u) * nx) xb_add(&bar[XB_TOPGEN], 1u);
            else XB_SPIN(xb_ld(&bar[XB_TOPGEN]) == tg, bar);
            __builtin_amdgcn_fence(__ATOMIC_ACQUIRE, "agent");
            xb_add(&bar[XB_XGEN(b.x)], 1u);
            asm volatile("s_waitcnt vmcnt(0)" ::: "memory");
        } else {
            XB_SPIN(xb_ld(&bar[XB_XGEN(b.x)]) == gen, bar);
            __builtin_amdgcn_fence(__ATOMIC_ACQUIRE, "agent");
            asm volatile("s_waitcnt vmcnt(0)" ::: "memory");
        }
    }
    __syncthreads();
}


__global__ void __launch_bounds__(512) fwd_megakernel(Prm p) {
  __shared__ __attribute__((aligned(16))) unsigned char smem_raw[SMEM_BYTES];
  bf16_t* sm = (bf16_t*)smem_raw;
  __shared__ uint4 xb_words;
  if (threadIdx.x == 0) {
    xb_words = make_uint4(0u, 0u, 0u, 0u);
#pragma unroll
    for (int j = 0; j < NJOB; ++j) g_jobs_s[j] = p.jobs[j];
  }
  __syncthreads();
  XcdBarrier xb = xcd_barrier_post((unsigned*)(p.ws + O_BAR), (volatile LAS unsigned*)&xb_words);
  if (p.never) { cg::grid_group grid = cg::this_grid(); grid.sync(); }
#define GSYNC() do { for (int rs_ = 0; rs_ < REP_SYNC; ++rs_) xcd_barrier(xb); } while (0)
#define WITH_CONV(c0, c1, call) do { const bool cf_ = ((obid() >> 3) & 1) == 0; if (cf_) conv_range(p, (c0), (c1), sm); call; if (!cf_) conv_range(p, (c0), (c1), sm); } while (0)
  phase0(p, sm); GSYNC();
  int rg_j = 0, dense_j = 0, moe_j = 0;
  for (int l = 0; l < 4; ++l) {
    norm_phase(p, l, 0, -1, sm, l == 2 ? 1 : -1); GSYNC();
    const int kind = l % 3;
    if (kind == 0) {
      const int c0 = l == 0 ? CV_P0 : CV_L2_DN, c1 = l == 0 ? CV_L0_IN : CV_L3_IN, c2 = l == 0 ? CV_L0_GATES : CV_L3_GATES, c3 = l == 0 ? CV_L0_OUT : CV_L3_OUT;
      for (int q_ = 0; q_ < REP_OG; ++q_) { rg_inproj(p, rg_j, sm, c0, c1); GSYNC(); }
      for (int q_ = 0; q_ < REP_ATT; ++q_) { rg_conv(p, rg_j); GSYNC(); }
      for (int q_ = 0; q_ < REP_OG; ++q_) { rg_gates(p, rg_j, sm, c1, c2); GSYNC(); }
      for (int q_ = 0; q_ < REP_SCAN; ++q_) { rg_scan1(p); GSYNC(); rg_scan2(p); GSYNC(); }
      resid_gemm(p, (const bf16_t*)(p.ws + M_YIN), D, (const bf16_t*)(p.ws + W_RGOUT) + (size_t)rg_j * D * D, l, 2, sm, c2, c3);
      ++rg_j;
    } else if (kind == 1) {
      for (int q_ = 0; q_ < REP_OG; ++q_) { na_qkv(p, sm, CV_L0_DN, CV_L1_QKV); GSYNC(); }
      for (int q_ = 0; q_ < REP_ATT; ++q_) { na_attn(p, sm); GSYNC(); }
      resid_gemm(p, (const bf16_t*)(p.ws + M_O), D, (const bf16_t*)(p.ws + W_O), l, 2, sm, CV_L1_QKV, CV_L1_O);
    } else {
      for (int q_ = 0; q_ < REP_OG; ++q_) { ft_chan(p, sm); GSYNC(); ft_step1(p, sm); GSYNC(); ft_step3(p, sm); GSYNC(); }
      resid_gemm(p, (const bf16_t*)(p.ws + M_F), D, (const bf16_t*)(p.ws + W_FT), l, 2, sm);
    }
    GSYNC();
    const bool moe = (l & 1);
    norm_phase(p, l, 1, moe ? moe_j : -1, sm); GSYNC();
    if (!moe) {
      const int c0 = l == 0 ? CV_L0_OUT : CV_L1_MDN, c1 = l == 0 ? CV_L0_GU : CV_L2_GU, c2 = l == 0 ? CV_L0_DN : CV_L2_DN;
      ffn_gu(p, (const bf16_t*)(p.ws + W_FGU) + (size_t)dense_j * 2 * FF * D, sm, c0, c1); GSYNC();
      resid_gemm(p, (const bf16_t*)(p.ws + O_ACT), FF, (const bf16_t*)(p.ws + W_FDN) + (size_t)dense_j * D * FF, l, 5, sm, c1, c2);
      ++dense_j;
    } else {
      for (int q_ = 0; q_ < REP_ATT; ++q_) { moe_route(p, moe_j, sm); GSYNC(); }
      if (l == 1) moe_gu(p, moe_j, sm, CV_L1_O, CV_L1_MGU); else moe_gu(p, moe_j, sm);
      GSYNC();
      for (int q_ = 0; q_ < REP_MDN; ++q_) { if (l == 1) moe_down(p, moe_j, l, sm, CV_L1_MGU, CV_L1_MDN); else moe_down(p, moe_j, l, sm);
      GSYNC(); }
      if (l == 3) moe_combine(p, l);
      ++moe_j;
    }
    if (l < 3 && l != 1) GSYNC();
  }
}

static void add_job(Prm& p, const float* src, size_t dst_off, int K, int N, int nb, long long ss, long long ds) {
  Job& j = p.jobs[p.njob++];
  j.src = src; j.dst = (bf16_t*)(p.ws + dst_off); j.K = K; j.N = N; j.nb = nb; j.tiles = (K / 64) * (N / 64) * nb; j.ss = ss; j.ds = ds;
}

extern "C" void kernel_launch(void* const* d_in, const int* in_sizes, int n_in, void* d_out, int out_size, void* d_ws, size_t ws_size, hipStream_t stream) {
  static int grid_blocks = 0;
  if (!grid_blocks) {
    int dev = 0, cus = 0, per_cu = 0;
    hipGetDevice(&dev);
    hipDeviceGetAttribute(&cus, hipDeviceAttributeMultiprocessorCount, dev);
    hipOccupancyMaxActiveBlocksPerMultiprocessor(&per_cu, fwd_megakernel, NTHR, 0);
    if (per_cu < 1) per_cu = 1;
    if (per_cu > 1) per_cu = 1;
    grid_blocks = (cus * per_cu) & ~7;
  }
  Prm p; memset(&p, 0, sizeof(p));
  const float* const* in = (const float* const*)d_in;
  p.x = in[0]; p.c = in[1]; p.ctx = in[2]; p.cctx = in[3]; p.ada_w = in[4]; p.ada_b = in[5]; p.norm_g = in[6];
  p.conv_w = in[8]; p.conv_b = in[9]; p.rg_ba = in[11]; p.rg_bi = in[13]; p.rg_lam = in[14];
  p.na_qg = in[17]; p.na_kg = in[18]; p.na_rpb = in[19]; p.router = in[24];
  p.out = (float*)d_out; p.ws = (unsigned char*)d_ws;
  p.njob = 0;
  const long long GU = (long long)1024 * 7168, DN = (long long)3584 * 1024, SQ = (long long)1024 * 1024;
  auto gates = [&](int j) {
    for (int d = 0; d < 2; ++d) {
      const int jd = j * 2 + d;
      add_job(p, in[10] + (size_t)jd * 4 * 65536, W_GATE + ((size_t)(jd * 2 + 0) * 4 * 65536) * 2, 256, 256, 4, 65536, 65536);
      add_job(p, in[12] + (size_t)jd * 4 * 65536, W_GATE + ((size_t)(jd * 2 + 1) * 4 * 65536) * 2, 256, 256, 4, 65536, 65536);
    }
  };
  add_job(p, in[7], W_RGIN, 1024, 2048, 1, 0, 0); gates(0); add_job(p, in[15], W_RGOUT, 1024, 1024, 1, 0, 0);
  add_job(p, in[22], W_FGU, 1024, 7168, 1, 0, 0); add_job(p, in[23], W_FDN, 3584, 1024, 1, 0, 0);
  add_job(p, in[16], W_QKV, 1024, 3072, 1, 0, 0); add_job(p, in[20], W_O, 1024, 1024, 1, 0, 0);
  add_job(p, in[25], W_MGU, 1024, 7168, 8, GU, GU); add_job(p, in[26], W_MDN, 3584, 1024, 8, DN, DN);
  add_job(p, in[21], W_FT, 1024, 1024, 1, 0, 0);
  add_job(p, in[22] + GU, W_FGU + (size_t)GU * 2, 1024, 7168, 1, 0, 0); add_job(p, in[23] + DN, W_FDN + (size_t)DN * 2, 3584, 1024, 1, 0, 0);
  add_job(p, in[7] + 2 * SQ, W_RGIN + (size_t)2 * SQ * 2, 1024, 2048, 1, 0, 0); gates(1); add_job(p, in[15] + SQ, W_RGOUT + (size_t)SQ * 2, 1024, 1024, 1, 0, 0);
  add_job(p, in[25] + 8 * GU, W_MGU + (size_t)8 * GU * 2, 1024, 7168, 8, GU, GU); add_job(p, in[26] + 8 * DN, W_MDN + (size_t)8 * DN * 2, 3584, 1024, 8, DN, DN);
  {
    int tot = 0; for (int j = 0; j < p.njob; ++j) tot += p.jobs[j].tiles;
    if (tot != CV_TOTAL) fprintf(stderr, "conversion tile count %d != %d\n", tot, CV_TOTAL);
  }
  (void)hipMemsetAsync((unsigned char*)d_ws + O_BAR, 0, XCD_BAR_WORDS * 4, stream);
  void* args[] = {&p};
  hipError_t e = hipLaunchCooperativeKernel((void*)fwd_megakernel, dim3(grid_blocks), dim3(NTHR), args, 0, stream);
  if (e != hipSuccess) fprintf(stderr, "cooperative launch failed: %s (grid %d)\n", hipGetErrorString(e), grid_blocks);
}
```

```cpp
#ifndef REP_GU
#define REP_GU 1
#endif
#ifndef REP_NORM
#define REP_NORM 1
#endif
#ifndef REP_OG
#define REP_OG 1
#endif
#ifndef REP_MDN
#define REP_MDN 1
#endif
#ifndef REP_P0
#define REP_P0 1
#endif
#ifndef REP_SYNC
#define REP_SYNC 1
#endif
#ifndef REP_SCAN
#define REP_SCAN 1
#endif
#ifndef REP_ATT
#define REP_ATT 1
#endif
#ifndef REP_SK
#define REP_SK 1
#endif
#include <hip/hip_runtime.h>
#include <hip/hip_cooperative_groups.h>
#include <cstdio>
#include <cstdint>
#include <cstring>
namespace cg = cooperative_groups;

typedef unsigned short bf16_t;
typedef short bf16x8 __attribute__((ext_vector_type(8)));
typedef short s16x4 __attribute__((ext_vector_type(4)));
typedef float f32x4 __attribute__((ext_vector_type(4)));
typedef unsigned u32x4 __attribute__((ext_vector_type(4)));
#define DI __device__ __forceinline__
#define MFMA16(a, b, c) __builtin_amdgcn_mfma_f32_16x16x32_bf16((a), (b), (c), 0, 0, 0)

constexpr int S = 16384, CT = 256, R = S + CT, D = 1024, FF = 3584, NE = 8;
constexpr int NCH = 130;
constexpr int ACT_ROWS = 2 * R + NE * 256;

constexpr size_t al(size_t x) { return (x + 255) & ~(size_t)255; }
constexpr size_t W_RGIN = 0;
constexpr size_t W_GATE = W_RGIN + al((size_t)2 * 2048 * 1024 * 2);
constexpr size_t W_RGOUT = W_GATE + al((size_t)2 * 4096 * 256 * 2);
constexpr size_t W_QKV = W_RGOUT + al((size_t)2 * 1024 * 1024 * 2);
constexpr size_t W_O = W_QKV + al((size_t)3072 * 1024 * 2);
constexpr size_t W_FT = W_O + al((size_t)1024 * 1024 * 2);
constexpr size_t W_FGU = W_FT + al((size_t)1024 * 1024 * 2);
constexpr size_t W_FDN = W_FGU + al((size_t)2 * 7168 * 1024 * 2);
constexpr size_t W_MGU = W_FDN + al((size_t)2 * 1024 * 3584 * 2);
constexpr size_t W_MDN = W_MGU + al((size_t)16 * 7168 * 1024 * 2);
constexpr size_t W_BC = W_MDN + al((size_t)16 * 1024 * 3584 * 2);
constexpr size_t W_D1 = W_BC + al((size_t)512 * 256 * 2);
constexpr size_t W_D3 = W_D1 + al((size_t)256 * 256 * 2);
constexpr size_t W_DC = W_D3 + al((size_t)128 * 256 * 2);
constexpr size_t O_MOD = W_DC + al((size_t)256 * 512 * 2);
constexpr size_t O_XC = O_MOD + al((size_t)4 * 2 * 6144 * 4);
constexpr size_t O_CNT = O_XC + al((size_t)CT * D * 4);
constexpr size_t O_LIST = O_CNT + al(256);
constexpr size_t O_LW = O_LIST + al((size_t)2 * NE * R * 4);
constexpr size_t O_BAR = O_LW + al((size_t)2 * NE * R * 4);
constexpr size_t O_ROUTE = O_BAR + al(16384);
constexpr size_t O_RW = O_ROUTE + al((size_t)R * 4);
constexpr size_t O_H = O_RW + al((size_t)R * 8);
constexpr size_t O_ACT = O_H + al((size_t)R * D * 2);
constexpr size_t O_MIX = O_ACT + al((size_t)ACT_ROWS * FF * 2);
constexpr size_t RB = (size_t)R * D * 2;
constexpr size_t M_XZ = O_MIX, M_GG = M_XZ + al(RB), M_XL = M_GG + al(RB), M_LA = M_XL + al(RB), M_IX = M_LA + al(2 * RB),
                 M_TMP = M_IX + al(2 * RB), M_YIN = M_TMP + al(2 * RB), M_CA = M_YIN + al(RB), M_CB = M_CA + al((size_t)2 * 260 * D * 4),
                 M_END_RG = M_CB + al((size_t)2 * 260 * D * 4);
constexpr size_t M_Y = O_MIX;
constexpr size_t M_Q = O_MIX, M_K = M_Q + al(RB), M_VT = M_K + al(RB), M_O = M_VT + al(RB);
constexpr size_t M_UT = O_MIX, M_UTC = M_UT + al((size_t)S * 2048 * 2), M_AT = M_UTC + al((size_t)CT * 2048 * 2), M_F = M_AT + al((size_t)S * 2048 * 2);

struct Job { const float* src; bf16_t* dst; int K, N, nb, tiles; long long ss, ds; };
constexpr int NJOB = 24;
struct Prm {
  const float *x, *c, *ctx, *cctx, *ada_w, *ada_b, *norm_g, *conv_w, *conv_b, *rg_ba, *rg_bi, *rg_lam, *na_qg, *na_kg, *na_rpb, *router;
  float* out; unsigned char* ws;
  Job jobs[NJOB]; int njob; int never;
};

DI int otid() { int t = threadIdx.x; asm volatile("" : "+v"(t)); return t; }
DI int obid() { int t = blockIdx.x; asm volatile("" : "+s"(t)); return t; }
DI int ogrid() { int t = gridDim.x; asm volatile("" : "+s"(t)); return t; }
DI bf16_t f2bf(float x) { unsigned u = __float_as_uint(x); u += 0x7fffu + ((u >> 16) & 1u); return (bf16_t)(u >> 16); }
DI float bf2f(bf16_t h) { return __uint_as_float(((unsigned)h) << 16); }
DI unsigned pack2(float a, float b) { unsigned r; asm("v_cvt_pk_bf16_f32 %0, %1, %2" : "=v"(r) : "v"(a), "v"(b)); return r; }
DI uint2 pack4(f32x4 v) { return make_uint2(pack2(v[0], v[1]), pack2(v[2], v[3])); }
DI void unpack4(uint2 v, float* o) { o[0] = __uint_as_float(v.x << 16); o[1] = __uint_as_float(v.x & 0xffff0000u); o[2] = __uint_as_float(v.y << 16); o[3] = __uint_as_float(v.y & 0xffff0000u); }
DI int perm8(int r) { return (r & ~31) + ((r >> 2) & 3) * 8 + ((r >> 4) & 1) * 4 + (r & 3); }
DI uint4 pack8(f32x4 a, f32x4 b) { const uint2 x = pack4(a), y = pack4(b); return make_uint4(x.x, x.y, y.x, y.y); }
DI float sigm(float v) { return __builtin_amdgcn_rcpf(1.f + __expf(-v)); }
DI float siluf(float v) { return v * __builtin_amdgcn_rcpf(1.f + __expf(-v)); }
DI float gelut(float v) { float u = 0.7978845608f * (v + 0.044715f * v * v * v); float t = 1.f - 2.f * __builtin_amdgcn_rcpf(__expf(2.f * u) + 1.f); return 0.5f * v * (1.f + t); }
DI float softplus_neg(float lam) { const float x = __expf(-lam); return x < 0.05f ? x * (1.f - x * (0.5f - x * (1.f / 3.f - 0.25f * x))) : __logf(1.f + x); }
DI void sincos_rev(float rev, float* s, float* c) { *s = __builtin_amdgcn_sinf(rev); *c = __builtin_amdgcn_cosf(rev); }
DI float wsum(float v) { for (int o = 32; o; o >>= 1) v += __shfl_xor(v, o); return v; }
DI const float* xrow_in(const Prm& p, int r) { return r < S ? p.x + (size_t)r * D : p.ctx + (size_t)(r - S) * D; }
DI float* xrow(const Prm& p, int r) { return r < S ? p.out + (size_t)r * D : (float*)(p.ws + O_XC) + (size_t)(r - S) * D; }

constexpr int NTHR = 512;
constexpr int LDSS = 72;
constexpr int SMEM_BYTES = 2 * 512 * LDSS * 2;
constexpr int CV_P0 = 1024, CV_L0_IN = 4024, CV_L0_GATES = 5024, CV_L0_OUT = 5324, CV_L0_GU = 8824, CV_L0_DN = 14824, CV_L1_QKV = 20024, CV_L1_O = 21024,
              CV_L1_MGU = 26240, CV_L1_MDN = 42240, CV_L2_GU = 45740, CV_L2_DN = 49740, CV_L3_IN = 51240, CV_L3_GATES = 51712, CV_L3_OUT = 51712, CV_TOTAL = 51712;
__shared__ Job g_jobs_s[NJOB];
#define g_jobs ((const Job*)g_jobs_s)
struct CvTile { const float* src; bf16_t* dst; int N, K, valid, pad; };
DI CvTile cv_tile(const Job* jobs, int t, int c0, int c1) {
  CvTile r; r.valid = t < c1; r.pad = 0;
  int j = 0, tt = r.valid ? t : c0;
  while (tt >= jobs[j].tiles) { tt -= jobs[j].tiles; ++j; }
  const Job jb = jobs[j];
  const int tk = jb.K >> 6, tn = jb.N >> 6, per = tk * tn;
  const int bi = tt / per, rr = tt % per, kt = rr % tk, nt = rr / tk;
  r.src = jb.src + (size_t)bi * jb.ss + (size_t)(kt * 64) * jb.N + nt * 64;
  r.dst = jb.dst + (size_t)bi * jb.ds + (size_t)(nt * 64) * jb.K + kt * 64;
  r.N = jb.N; r.K = jb.K;
  return r;
}
DI void conv_range(const Prm& p, int c0, int c1, bf16_t* smraw, int widx = -1, int wn = 0) {
  if (c0 >= c1) return;
  const int tid = otid(), G = widx < 0 ? ogrid() : wn, b = widx < 0 ? obid() : widx;
  float* smf = (float*)smraw;
  const int half = tid >> 8, vt = tid & 255;
  float* smh = smf + half * (64 * 65);
  const int kr = vt >> 4, nc = (vt & 15) * 4;
  int t0 = c0 + b * 2;
  if (t0 >= c1) { __syncthreads(); return; }
  CvTile cur = cv_tile(g_jobs, t0 + half, c0, c1);
  float4 v[4];
#pragma unroll
  for (int i = 0; i < 4; ++i) v[i] = *(const float4*)(cur.src + (size_t)(kr + 16 * i) * cur.N + nc);
  for (; t0 < c1; t0 += 2 * G) {
    const bool more = t0 + 2 * G < c1;
    CvTile nx = cur; float4 vn[4];
    if (more) {
      nx = cv_tile(g_jobs, t0 + 2 * G + half, c0, c1);
#pragma unroll
      for (int i = 0; i < 4; ++i) vn[i] = *(const float4*)(nx.src + (size_t)(kr + 16 * i) * nx.N + nc);
    }
    __syncthreads();
#pragma unroll
    for (int i = 0; i < 4; ++i) { float* d = smh + (kr + 16 * i) * 65 + nc; d[0] = v[i].x; d[1] = v[i].y; d[2] = v[i].z; d[3] = v[i].w; }
    __syncthreads();
    if (cur.valid) {
      const int n = vt >> 2, kp = (vt & 3) * 16;
      unsigned o[8];
#pragma unroll
      for (int q = 0; q < 8; ++q) o[q] = pack2(smh[(kp + 2 * q) * 65 + n], smh[(kp + 2 * q + 1) * 65 + n]);
      uint4* d4 = (uint4*)(cur.dst + (size_t)n * cur.K + kp);
      d4[0] = make_uint4(o[0], o[1], o[2], o[3]); d4[1] = make_uint4(o[4], o[5], o[6], o[7]);
    }
    if (more) {
      cur = nx;
#pragma unroll
      for (int i = 0; i < 4; ++i) v[i] = vn[i];
    }
  }
  __syncthreads();
}

template <bool NAT, int MI, int WM, int WN, class F>
DI void gemm_stream(int MT, int NT, int K, bf16_t* sm, const void* gbase, F f, const Prm* cvp = nullptr, int cv0 = 0, int cv1 = 0, int lo = 0, int hi = -1, int SUB = 1) {
  constexpr int BM = WM * MI * 16, BN = WN * 64, AR = BM / 64, BR = BN / 64, STG = (BM + BN) * LDSS;
  static_assert(WM * WN == 8, "8 waves");
  const int G = ogrid(), b = obid(), nbx = G >> 3, xcd = b & 7, li = b >> 3;
  if (hi < 0) hi = MT * NT;
  const int T = (hi - lo) * SUB;
  const int full = NT >> 3, wl = NT & 7, gsz = MT * 8;
  const int start = (int)(((long long)T * xcd) >> 3) + li, end = (int)(((long long)T * (xcd + 1)) >> 3);
  const int ntb = start < end ? (end - start + nbx - 1) / nbx : 0;
  if (ntb > 0) {
  auto tile_at = [&](int j, int& mt, int& nt) {
    const int item = start + j * nbx, idx = lo + item / SUB, sb = item % SUB, g = idx / gsz;
    if (g < full) { const int rem = idx - g * gsz; mt = rem >> 3; nt = g * 8 + (rem & 7); }
    else { const int rem = idx - full * gsz; mt = rem / wl; nt = full * 8 + rem % wl; }
    if (SUB == 8) { mt = mt * 4 + (sb >> 1); nt = nt * 2 + (sb & 1); }
  };
  const int tid = otid(), lane = tid & 63, wid = tid >> 6, wm = wid / WN, wn = wid % WN;
  const int lr = tid >> 3, lc = (tid & 7) * 8;
  const char* const gb = (const char*)gbase;
  unsigned ap[AR], bp[BR];
  auto set_offs = [&](int j) {
    int mt, nt; tile_at(j, mt, nt);
    f(mt, nt, [&](auto&& a, auto&& bfn, auto&& ep) {
#pragma unroll
      for (int i = 0; i < AR; ++i) ap[i] = (unsigned)((const char*)a(lr + 64 * i) - gb) + lc * 2;
#pragma unroll
      for (int i = 0; i < BR; ++i) bp[i] = (unsigned)((const char*)bfn(lr + 64 * i) - gb) + lc * 2;
    });
  };
  u32x4 ra[AR], rb[BR];
  f32x4 acc[MI][4];
#pragma unroll
  for (int i = 0; i < MI; ++i)
#pragma unroll
    for (int j = 0; j < 4; ++j) acc[i][j] = (f32x4){0.f, 0.f, 0.f, 0.f};
  const int nk = K / 64, Q = ntb * nk;
  const int fro = (lane & 15) * LDSS + (lane >> 4) * 8;
  set_offs(0);
#pragma unroll
  for (int i = 0; i < AR; ++i) ra[i] = *(const u32x4*)(gb + ap[i]);
#pragma unroll
  for (int i = 0; i < BR; ++i) rb[i] = *(const u32x4*)(gb + bp[i]);
#pragma unroll
  for (int i = 0; i < AR; ++i) *(u32x4*)(sm + (lr + 64 * i) * LDSS + lc) = ra[i];
#pragma unroll
  for (int i = 0; i < BR; ++i) *(u32x4*)(sm + BM * LDSS + (lr + 64 * i) * LDSS + lc) = rb[i];
#pragma unroll
  for (int i = 0; i < AR; ++i) ra[i] = *(const u32x4*)(gb + 128 + ap[i]);
#pragma unroll
  for (int i = 0; i < BR; ++i) rb[i] = *(const u32x4*)(gb + 128 + bp[i]);
  __syncthreads();
  int kt = 0, jt = 0;
  for (int q = 0; q < Q; ++q) {
    bf16_t* sA = sm + (q & 1) * STG; bf16_t* sB = sA + BM * LDSS;
    constexpr int FA = MI < 4 ? MI : 4, HG = MI / FA, NG = 2 * HG;
    bf16x8 fb[2][4], fa[2][FA];
    const bf16_t* pA = sA + (wm * MI * 16) * LDSS + fro; const bf16_t* pB = sB + (wn * 64) * LDSS + fro;
#pragma unroll
    for (int j = 0; j < 4; ++j) fb[0][j] = *(const bf16x8*)(pB + (j * 16) * LDSS);
#pragma unroll
    for (int i = 0; i < FA; ++i) fa[0][i] = *(const bf16x8*)(pA + (i * 16) * LDSS);
    __builtin_amdgcn_sched_barrier(0);
    if (q + 1 < Q) {
      bf16_t* nA = sm + ((q + 1) & 1) * STG; bf16_t* nB = nA + BM * LDSS;
#pragma unroll
      for (int i = 0; i < AR; ++i) *(u32x4*)(nA + (lr + 64 * i) * LDSS + lc) = ra[i];
#pragma unroll
      for (int i = 0; i < BR; ++i) *(u32x4*)(nB + (lr + 64 * i) * LDSS + lc) = rb[i];
    }
    if (q + 2 < Q) {
      int kt2 = kt + 2;
      if (kt2 >= nk) { kt2 -= nk; if (kt2 == 0) set_offs(jt + 1); }
      const char* gk = gb + kt2 * 128;
#pragma unroll
      for (int i = 0; i < AR; ++i) ra[i] = *(const u32x4*)(gk + ap[i]);
#pragma unroll
      for (int i = 0; i < BR; ++i) rb[i] = *(const u32x4*)(gk + bp[i]);
    }
    __builtin_amdgcn_sched_barrier(0);
    {
#pragma unroll
      for (int gi = 0; gi < NG; ++gi) {
        const int ks = gi / HG;
        if (gi + 1 < NG) {
          const int ks1 = (gi + 1) / HG, h1 = (gi + 1) % HG;
          if (ks1 != ks) {
#pragma unroll
            for (int j = 0; j < 4; ++j) fb[ks1 & 1][j] = *(const bf16x8*)(pB + (j * 16) * LDSS + ks1 * 32);
          }
#pragma unroll
          for (int i = 0; i < FA; ++i) fa[(gi + 1) & 1][i] = *(const bf16x8*)(pA + ((h1 * FA + i) * 16) * LDSS + ks1 * 32);
        }
        const int h = gi % HG;
#pragma unroll
        for (int i = 0; i < FA; ++i)
#pragma unroll
          for (int j = 0; j < 4; ++j)
            acc[h * FA + i][j] = NAT ? MFMA16(fa[gi & 1][i], fb[ks & 1][j], acc[h * FA + i][j]) : MFMA16(fb[ks & 1][j], fa[gi & 1][i], acc[h * FA + i][j]);
        __builtin_amdgcn_sched_barrier(0);
      }
    }
    if (kt == nk - 1) {
      int mt, nt; tile_at(jt, mt, nt);
      f(mt, nt, [&](auto&& a, auto&& bfn, auto&& ep) { ep(acc, wm, wn, lane); });
#pragma unroll
      for (int i = 0; i < MI; ++i)
#pragma unroll
        for (int j = 0; j < 4; ++j) acc[i][j] = (f32x4){0.f, 0.f, 0.f, 0.f};
      kt = 0; ++jt;
    } else ++kt;
    __syncthreads();
  }
  }
  if (cvp && cv0 < cv1) {
    int n_idle = 0, my_idx = -1;
#pragma unroll
    for (int x = 0; x < 8; ++x) {
      const int sx = (int)(((long long)T * x) >> 3), ex = (int)(((long long)T * (x + 1)) >> 3), rem = (ex - sx) % nbx;
      if (rem) { if (x == xcd && li >= rem) my_idx = n_idle + (li - rem); n_idle += nbx - rem; }
    }
    if (n_idle == 0) conv_range(*cvp, cv0, cv1, sm);
    else if (my_idx >= 0) conv_range(*cvp, cv0, cv1, sm, my_idx, n_idle);
  }
}

template <bool NAT, class FB, class FS>
DI void gemm_split(bool split, int MT, int NT, int K, bf16_t* sm, const void* gbase, FB fb, FS fs, const Prm* cvp = nullptr, int cv0 = 0, int cv1 = 0) {
  if (!split) { gemm_stream<NAT, 8, 2, 4>(MT, NT, K, sm, gbase, fb, cvp, cv0, cv1); return; }
  const int T = MT * NT, G = ogrid(), tfull = (T / G) * G;
  if (tfull > 0) gemm_stream<NAT, 8, 2, 4>(MT, NT, K, sm, gbase, fb, nullptr, 0, 0, 0, tfull, 1);
  if (tfull < T) gemm_stream<NAT, 1, 4, 2>(MT, NT, K, sm, gbase, fs, cvp, cv0, cv1, tfull, T, 8);
  else if (cvp && cv0 < cv1) conv_range(*cvp, cv0, cv1, sm);
}

DI int ileave(int pc, int half) { const int q = pc >> 6, w = pc & 63; return (w < 32) ? q * 32 + w : half + q * 32 + (w - 32); }
DI int ileave8(int pc, int half) { const int q = pc >> 6, w = pc & 63, c = w & 31, j = c >> 4, g = (c >> 2) & 3, e = c & 3; return (w < 32 ? 0 : half) + q * 32 + 8 * g + 4 * j + e; }

DI void phase0(const Prm& p, bf16_t* smraw) {
  const int tid = otid(), G = ogrid(), b = obid();
  float* smf = (float*)smraw;
  for (int u = b; u < 384; u += G) {
    const int l = u / 96, cg0 = (u % 96) * 64, kq = tid >> 4, cq = tid & 15;
    const float* w = p.ada_w + ((size_t)l * 1024 + kq * 32) * 6144 + cg0 + cq * 4;
    float4 a0 = make_float4(0, 0, 0, 0), a1 = a0;
#pragma unroll 8
    for (int k = 0; k < 32; ++k) {
      const float4 wv = *(const float4*)(w + (size_t)k * 6144);
      const float s0 = siluf(p.c[kq * 32 + k]), s1 = siluf(p.cctx[kq * 32 + k]);
      a0.x += s0 * wv.x; a0.y += s0 * wv.y; a0.z += s0 * wv.z; a0.w += s0 * wv.w;
      a1.x += s1 * wv.x; a1.y += s1 * wv.y; a1.z += s1 * wv.z; a1.w += s1 * wv.w;
    }
    __syncthreads();
    *(float4*)(smf + (kq * 16 + cq) * 8) = a0; *(float4*)(smf + (kq * 16 + cq) * 8 + 4) = a1;
    __syncthreads();
    if (tid < 128) {
      const int wsel = tid >> 6, col = tid & 63; float s = 0.f;
      for (int q = 0; q < 32; ++q) s += smf[(q * 16 + (col >> 2)) * 8 + wsel * 4 + (col & 3)];
      float* mod = (float*)(p.ws + O_MOD);
      mod[(size_t)(l * 2 + wsel) * 6144 + cg0 + col] = s + p.ada_b[(size_t)l * 6144 + cg0 + col];
    }
    __syncthreads();
  }
  if (b == G - 1 && tid < 64) ((int*)(p.ws + O_CNT))[tid] = 0;
  {
    const int gt = b * NTHR + tid, gn = G * NTHR;
    bf16_t* Bc = (bf16_t*)(p.ws + W_BC); bf16_t* D1 = (bf16_t*)(p.ws + W_D1); bf16_t* D3 = (bf16_t*)(p.ws + W_D3); bf16_t* Dc = (bf16_t*)(p.ws + W_DC);
    for (int e = gt; e < 512 * 256; e += gn) { const int rr = e >> 8, c = e & 255, ri = rr >> 8, m = rr & 255; float sn, cs; sincos_rev((float)((m * c) & 255) / 256.f, &sn, &cs); Bc[e] = f2bf((ri ? -sn : cs) * 0.0625f); }
    for (int e = gt; e < 256 * 256; e += gn) { const int rr = e >> 8, c = e & 255, ri = rr >> 7, k1 = rr & 127, ri2 = c >> 7, t1 = c & 127; float sn, cs; sincos_rev((float)((k1 * t1) & 127) / 128.f, &sn, &cs);
      const float v = (ri == ri2) ? cs : (ri == 0 ? sn : -sn); D1[e] = f2bf(v * 0.08838834764831845f); }
    for (int e = gt; e < 128 * 256; e += gn) { const int k2 = e >> 8, c = e & 255, ri = c >> 7, t2 = c & 127; float sn, cs; sincos_rev((float)((k2 * t2) & 127) / 128.f, &sn, &cs); D3[e] = f2bf((ri ? sn : cs) * 0.08838834764831845f); }
    for (int e = gt; e < 256 * 512; e += gn) { const int k = e >> 9, c = e & 511, ri = c >> 8, t = c & 255; float sn, cs; sincos_rev((float)((k * t) & 255) / 256.f, &sn, &cs); Dc[e] = f2bf((ri ? sn : cs) * 0.0625f); }
  }
  conv_range(p, 0, CV_P0, smraw);
}

DI void norm_phase(const Prm& p, int l, int which, int moe_idx, bf16_t* smraw, int comb_l = -1) {
  const int lane = otid() & 63, wv = obid() * 8 + (otid() >> 6), nw = ogrid() * 8;
  const float* g = p.norm_g + (size_t)(l * 2 + which) * D;
  const float* mod = (const float*)(p.ws + O_MOD);
  bf16_t* H = (bf16_t*)(p.ws + O_H);
  float* rts = (float*)smraw;
  if (moe_idx >= 0) {
    const float4* rsrc = (const float4*)(p.router + (size_t)moe_idx * D * NE);
    for (int e = otid(); e < D * NE / 4; e += NTHR) ((float4*)rts)[e] = rsrc[e];
    __syncthreads();
  }
  f32x4 gs0[4], sv0[4];
  {
    const float* sh = mod + (size_t)(l * 2) * 6144 + (which ? 3 : 0) * D; const float* sc = mod + (size_t)(l * 2) * 6144 + (which ? 4 : 1) * D;
#pragma unroll
    for (int i = 0; i < 4; ++i) {
      const int col = i * 256 + lane * 4;
      const float4 g4 = *(const float4*)(g + col), s4 = *(const float4*)(sc + col);
      gs0[i] = (f32x4){g4.x * (1.f + s4.x), g4.y * (1.f + s4.y), g4.z * (1.f + s4.z), g4.w * (1.f + s4.w)}; sv0[i] = *(const f32x4*)(sh + col);
    }
  }
  const bf16_t* Ycmb = (const bf16_t*)(p.ws + M_Y);
  auto load_row = [&](int r, f32x4 (&dst)[4]) {
    const float* xr = (l == 0 && which == 0) ? xrow_in(p, r) : (const float*)xrow(p, r);
#pragma unroll
    for (int i = 0; i < 4; ++i) dst[i] = *(const f32x4*)(xr + i * 256 + lane * 4);
    if (comb_l >= 0) {
      const float* g5 = mod + (size_t)(comb_l * 2 + (r >= S ? 1 : 0)) * 6144 + 5 * D;
#pragma unroll
      for (int i = 0; i < 4; ++i) {
        const int col = i * 256 + lane * 4;
        const uint2 u0 = *(const uint2*)(Ycmb + (size_t)(2 * r) * D + col), u1 = *(const uint2*)(Ycmb + (size_t)(2 * r + 1) * D + col);
        float a0[4], a1[4]; unpack4(u0, a0); unpack4(u1, a1);
        const f32x4 ys = {a0[0] + a1[0], a0[1] + a1[1], a0[2] + a1[2], a0[3] + a1[3]};
        dst[i] += *(const f32x4*)(g5 + col) * ys;
      }
    }
  };
  f32x4 v[4];
  if (wv < R) load_row(wv, v);
  for (int r = wv; r < R; r += nw) {
    f32x4 vn[4];
    const bool more = r + nw < R;
    if (more) load_row(r + nw, vn);
    if (comb_l >= 0) {
      float* xw = xrow(p, r);
#pragma unroll
      for (int i = 0; i < 4; ++i) *(f32x4*)(xw + i * 256 + lane * 4) = v[i];
    }
    float ss = 0.f;
#pragma unroll
    for (int i = 0; i < 4; ++i) ss += v[i][0] * v[i][0] + v[i][1] * v[i][1] + v[i][2] * v[i][2] + v[i][3] * v[i][3];
    ss = wsum(ss);
    const float rstd = __builtin_amdgcn_rsqf(ss * (1.f / 1024.f) + 1e-6f);
    float lg[8];
#pragma unroll
    for (int e = 0; e < 8; ++e) lg[e] = 0.f;
#pragma unroll
    for (int i = 0; i < 4; ++i) {
      const int col = i * 256 + lane * 4;
      f32x4 gs = gs0[i], sv = sv0[i];
      if (r >= S) {
        const float* md = mod + (size_t)(l * 2 + 1) * 6144;
        const float4 g4 = *(const float4*)(g + col), s4 = *(const float4*)(md + (which ? 4 : 1) * D + col);
        gs = (f32x4){g4.x * (1.f + s4.x), g4.y * (1.f + s4.y), g4.z * (1.f + s4.z), g4.w * (1.f + s4.w)}; sv = *(const f32x4*)(md + (which ? 3 : 0) * D + col);
      }
      f32x4 h;
      h = v[i] * rstd * gs + sv;
      *(uint2*)(H + (size_t)r * D + col) = pack4(h);
      if (moe_idx >= 0) {
        const float* rt = rts + (size_t)col * NE;
#pragma unroll
        for (int q = 0; q < 4; ++q) {
          const float4 r0 = *(const float4*)(rt + q * 8), r1 = *(const float4*)(rt + q * 8 + 4);
          lg[0] += h[q] * r0.x; lg[1] += h[q] * r0.y; lg[2] += h[q] * r0.z; lg[3] += h[q] * r0.w;
          lg[4] += h[q] * r1.x; lg[5] += h[q] * r1.y; lg[6] += h[q] * r1.z; lg[7] += h[q] * r1.w;
        }
      }
    }
    if (moe_idx >= 0) {
#pragma unroll
      for (int e = 0; e < 8; ++e) lg[e] = wsum(lg[e]);
      if (lane == 0) {
        int i0 = 0; float v0 = lg[0];
#pragma unroll
        for (int e = 1; e < 8; ++e) if (lg[e] > v0) { v0 = lg[e]; i0 = e; }
        int i1 = -1; float v1 = -3.0e38f;
#pragma unroll
        for (int e = 0; e < 8; ++e) if (e != i0 && lg[e] > v1) { v1 = lg[e]; i1 = e; }
        const float w0 = 1.f / (1.f + __expf(v1 - v0)), w1 = 1.f - w0;
        ((int*)(p.ws + O_ROUTE))[r] = i0 | (i1 << 8); ((float2*)(p.ws + O_RW))[r] = make_float2(w0, w1);
      }
    }
    if (more) {
#pragma unroll
      for (int i = 0; i < 4; ++i) v[i] = vn[i];
    }
  }
}

template <int MI, int BM, int BN, class ACC>
DI void resid_epi(const Prm& p, ACC& acc, int row0, int col0, int l, int gchunk, int lane) {
  const float* mod = (const float*)(p.ws + O_MOD);
#pragma unroll
  for (int i = 0; i < MI; ++i) {
    const int row = row0 + i * 16 + (lane & 15);
    float* xr = xrow(p, row);
    const float* xs = (l == 0 && gchunk == 2) ? xrow_in(p, row) : (const float*)xr;
    const float* gt = mod + (size_t)(l * 2 + (row >= S ? 1 : 0)) * 6144 + gchunk * D;
#pragma unroll
    for (int j = 0; j < 4; ++j) {
      const int col = col0 + j * 16 + 4 * (lane >> 4);
      const float4 g4 = *(const float4*)(gt + col); float4 xv = *(const float4*)(xs + col);
      xv.x += g4.x * acc[i][j][0]; xv.y += g4.y * acc[i][j][1]; xv.z += g4.z * acc[i][j][2]; xv.w += g4.w * acc[i][j][3];
      *(float4*)(xr + col) = xv;
    }
  }
}
DI void resid_gemm(const Prm& p, const bf16_t* A, int K, const bf16_t* Wt, int l, int gchunk, bf16_t* sm, int cv0 = 0, int cv1 = 0) {
  gemm_split<false>(true, R / 256, D / 256, K, sm, p.ws,
    [&](int mt, int nt, auto&& use) {
      use([&](int r) { return A + (size_t)(mt * 256 + r) * K; },
          [&](int r) { return Wt + (size_t)(nt * 256 + r) * K; },
          [&](f32x4 (&acc)[8][4], int wm, int wn, int lane) { resid_epi<8, 256, 256>(p, acc, mt * 256 + wm * 128, nt * 256 + wn * 64, l, gchunk, lane); });
    },
    [&](int mt, int nt, auto&& use) {
      use([&](int r) { return A + (size_t)(mt * 64 + r) * K; },
          [&](int r) { return Wt + (size_t)(nt * 128 + r) * K; },
          [&](f32x4 (&acc)[1][4], int wm, int wn, int lane) { resid_epi<1, 64, 128>(p, acc, mt * 64 + wm * 16, nt * 128 + wn * 64, l, gchunk, lane); });
    }, &p, cv0, cv1);
}

template <int MI, class ACC>
DI void swiglu_epi(bf16_t* ACT, ACC& acc, int row0, int ff0, int lane) {
#pragma unroll
  for (int i = 0; i < MI; ++i) {
    const int row = row0 + i * 16 + (lane & 15), ff = ff0 + 8 * (lane >> 4);
    f32x4 o0, o1;
#pragma unroll
    for (int q = 0; q < 4; ++q) { o0[q] = siluf(acc[i][0][q]) * acc[i][2][q]; o1[q] = siluf(acc[i][1][q]) * acc[i][3][q]; }
    const uint2 w0 = pack4(o0), w1 = pack4(o1);
    *(uint4*)(ACT + (size_t)row * FF + ff) = make_uint4(w0.x, w0.y, w1.x, w1.y);
  }
}
DI void ffn_gu(const Prm& p, const bf16_t* Wt, bf16_t* sm, int cv0 = 0, int cv1 = 0) {
  const bf16_t* H = (const bf16_t*)(p.ws + O_H); bf16_t* ACT = (bf16_t*)(p.ws + O_ACT);
  gemm_split<false>(false, R / 256, 2 * FF / 256, D, sm, p.ws,
    [&](int mt, int nt, auto&& use) {
      use([&](int r) { return H + (size_t)(mt * 256 + r) * D; },
          [&](int r) { return Wt + (size_t)ileave8(nt * 256 + r, FF) * D; },
          [&](f32x4 (&acc)[8][4], int wm, int wn, int lane) { swiglu_epi<8>(ACT, acc, mt * 256 + wm * 128, (nt * 4 + wn) * 32, lane); });
    },
    [&](int mt, int nt, auto&& use) {
      use([&](int r) { return H + (size_t)(mt * 64 + r) * D; },
          [&](int r) { return Wt + (size_t)ileave8(nt * 128 + r, FF) * D; },
          [&](f32x4 (&acc)[1][4], int wm, int wn, int lane) { swiglu_epi<1>(ACT, acc, mt * 64 + wm * 16, (nt * 2 + wn) * 32, lane); });
    }, &p, cv0, cv1);
}

struct MoeMap { int ntiles; int ts1, ts2, ts3, ts4, ts5, ts6, ts7; };
DI void moe_map(const Prm& p, int moe_idx, MoeMap& m) {
  const int* cnt = (const int*)(p.ws + O_CNT) + moe_idx * 8;
  int ts = 0;
  ts += (cnt[0] + 255) >> 8; m.ts1 = ts; ts += (cnt[1] + 255) >> 8; m.ts2 = ts; ts += (cnt[2] + 255) >> 8; m.ts3 = ts; ts += (cnt[3] + 255) >> 8; m.ts4 = ts;
  ts += (cnt[4] + 255) >> 8; m.ts5 = ts; ts += (cnt[5] + 255) >> 8; m.ts6 = ts; ts += (cnt[6] + 255) >> 8; m.ts7 = ts; ts += (cnt[7] + 255) >> 8; m.ntiles = ts;
}
DI void moe_find(const Prm& p, int moe_idx, const MoeMap& m, int mt, int& e, int& lt, int& ce) {
  e = 0; int st = 0;
  if (mt >= m.ts1) { e = 1; st = m.ts1; } if (mt >= m.ts2) { e = 2; st = m.ts2; } if (mt >= m.ts3) { e = 3; st = m.ts3; } if (mt >= m.ts4) { e = 4; st = m.ts4; }
  if (mt >= m.ts5) { e = 5; st = m.ts5; } if (mt >= m.ts6) { e = 6; st = m.ts6; } if (mt >= m.ts7) { e = 7; st = m.ts7; }
  lt = mt - st; ce = ((const int*)(p.ws + O_CNT))[moe_idx * 8 + e];
}

DI void moe_route(const Prm& p, int moe_idx, bf16_t* smraw) {
  const int b = obid(), tid = otid(), e = b & 7, seg = b >> 3, nseg = ogrid() >> 3, SEG = (R + nseg - 1) / nseg;
  int* sc = (int*)smraw;
  const int* route = (const int*)(p.ws + O_ROUTE); const float2* rw = (const float2*)(p.ws + O_RW);
  int* list = (int*)(p.ws + O_LIST) + ((size_t)moe_idx * NE + e) * R; float* lw = (float*)(p.ws + O_LW) + ((size_t)moe_idx * NE + e) * R;
  const int lane = tid & 63, wid = tid >> 6;
  int c = 0;
  const int tend = min(seg * SEG, R);
  for (int t = tid; t < tend; t += 8 * NTHR) {
    int rt[8];
#pragma unroll
    for (int u = 0; u < 8; ++u) rt[u] = (t + u * NTHR < tend) ? route[t + u * NTHR] : -1;
#pragma unroll
    for (int u = 0; u < 8; ++u) c += (rt[u] >= 0) & (((rt[u] & 255) == e) | ((rt[u] >> 8) == e));
  }
  for (int o = 32; o; o >>= 1) c += __shfl_xor(c, o);
  const int t0 = seg * SEG;
  const int ta = t0 + tid, tb = t0 + NTHR + tid;
  const bool ha = tid < SEG && ta < R, hb = NTHR + tid < SEG && tb < R;
  const int ra = ha ? route[ta] : -1, rb = hb ? route[tb] : -1;
  const bool ma = ha && (((ra & 255) == e) | ((ra >> 8) == e)), mb = hb && (((rb & 255) == e) | ((rb >> 8) == e));
  const unsigned long long ba = __ballot(ma), bb = __ballot(mb);
  const unsigned long long below = (1ull << lane) - 1ull;
  __syncthreads();
  if (lane == 0) { sc[wid] = c; sc[8 + wid] = __popcll(ba); sc[16 + wid] = __popcll(bb); }
  __syncthreads();
  int base = 0, tota = 0, prea = 0, preb = 0;
#pragma unroll
  for (int w = 0; w < 8; ++w) { base += sc[w]; tota += sc[8 + w]; if (w < wid) { prea += sc[8 + w]; preb += sc[16 + w]; } }
  int totb = 0;
#pragma unroll
  for (int w = 0; w < 8; ++w) totb += sc[16 + w];
  if (ma) { const int pos = base + prea + __popcll(ba & below); const float2 w = rw[ta]; list[pos] = ta * 2 + (((ra & 255) == e) ? 0 : 1); lw[pos] = ((ra & 255) == e) ? w.x : w.y; }
  if (mb) { const int pos = base + tota + preb + __popcll(bb & below); const float2 w = rw[tb]; list[pos] = tb * 2 + (((rb & 255) == e) ? 0 : 1); lw[pos] = ((rb & 255) == e) ? w.x : w.y; }
  if (seg == nseg - 1 && tid == 0) ((int*)(p.ws + O_CNT))[moe_idx * 8 + e] = base + tota + totb;
  __syncthreads();
}
DI void moe_combine(const Prm& p, int l) {
  const bf16_t* Y = (const bf16_t*)(p.ws + M_Y); const float* mod = (const float*)(p.ws + O_MOD);
  const int gt = obid() * NTHR + otid(), gn = ogrid() * NTHR;
  for (int e = gt; e < R * 256; e += gn) {
    const int r = e >> 8, c = (e & 255) * 4;
    float* xr = xrow(p, r) + c;
    const float4 g4 = *(const float4*)(mod + (size_t)(l * 2 + (r >= S ? 1 : 0)) * 6144 + 5 * D + c);
    const uint2 u0 = *(const uint2*)(Y + (size_t)(2 * r) * D + c), u1 = *(const uint2*)(Y + (size_t)(2 * r + 1) * D + c);
    float y0[4], y1[4]; unpack4(u0, y0); unpack4(u1, y1);
    float4 xv = *(float4*)xr;
    xv.x += g4.x * (y0[0] + y1[0]); xv.y += g4.y * (y0[1] + y1[1]); xv.z += g4.z * (y0[2] + y1[2]); xv.w += g4.w * (y0[3] + y1[3]);
    *(float4*)xr = xv;
  }
}
DI void moe_gu(const Prm& p, int moe_idx, bf16_t* sm, int cv0 = 0, int cv1 = 0) {
  MoeMap m; moe_map(p, moe_idx, m);
  const bf16_t* H = (const bf16_t*)(p.ws + O_H); bf16_t* ACT = (bf16_t*)(p.ws + O_ACT);
  const int* list = (const int*)(p.ws + O_LIST) + (size_t)moe_idx * NE * R;
  gemm_split<false>(cv0 >= cv1, m.ntiles, 2 * FF / 256, D, sm, p.ws,
    [&](int mt, int nt, auto&& use) {
      int e, lt, ce; moe_find(p, moe_idx, m, mt, e, lt, ce);
      const bf16_t* Wt = (const bf16_t*)(p.ws + W_MGU) + (size_t)(moe_idx * 8 + e) * 2 * FF * D;
      const int* le = list + (size_t)e * R;
      use([&](int r) { const int idx = min(lt * 256 + r, ce - 1); return H + (size_t)(le[idx] >> 1) * D; },
          [&](int r) { return Wt + (size_t)ileave8(nt * 256 + r, FF) * D; },
          [&](f32x4 (&acc)[8][4], int wm, int wn, int lane) { swiglu_epi<8>(ACT, acc, mt * 256 + wm * 128, (nt * 4 + wn) * 32, lane); });
    },
    [&](int mt, int nt, auto&& use) {
      int e, lt, ce; moe_find(p, moe_idx, m, mt >> 2, e, lt, ce);
      const bf16_t* Wt = (const bf16_t*)(p.ws + W_MGU) + (size_t)(moe_idx * 8 + e) * 2 * FF * D;
      const int* le = list + (size_t)e * R;
      use([&](int r) { const int idx = min(lt * 256 + (mt & 3) * 64 + r, ce - 1); return H + (size_t)(le[idx] >> 1) * D; },
          [&](int r) { return Wt + (size_t)ileave8(nt * 128 + r, FF) * D; },
          [&](f32x4 (&acc)[1][4], int wm, int wn, int lane) { swiglu_epi<1>(ACT, acc, mt * 64 + wm * 16, (nt * 2 + wn) * 32, lane); });
    }, &p, cv0, cv1);
}
template <int MI, class ACC>
DI void moedown_epi(const Prm& p, int moe_idx, ACC& acc, int e, int idx0, int ce, int col0, int lane) {
  const int* list = (const int*)(p.ws + O_LIST) + (size_t)moe_idx * NE * R;
  const float* lw = (const float*)(p.ws + O_LW) + (size_t)moe_idx * NE * R;
  bf16_t* Y = (bf16_t*)(p.ws + M_Y);
#pragma unroll
  for (int i = 0; i < MI; ++i) {
    const int idx = idx0 + i * 16 + (lane & 15);
    if (idx < ce) {
      const int slot = list[(size_t)e * R + idx]; const float w = lw[(size_t)e * R + idx];
      bf16_t* yr = Y + (size_t)slot * D;
#pragma unroll
      for (int j = 0; j < 4; j += 2) {
        const int col = col0 + (j >> 1) * 32 + 8 * (lane >> 4);
        *(uint4*)(yr + col) = pack8(acc[i][j] * w, acc[i][j + 1] * w);
      }
    }
  }
}
DI void moe_down(const Prm& p, int moe_idx, int l, bf16_t* sm, int cv0 = 0, int cv1 = 0) {
  MoeMap m; moe_map(p, moe_idx, m);
  const bf16_t* ACT = (const bf16_t*)(p.ws + O_ACT);
  gemm_split<false>(cv0 >= cv1, m.ntiles, D / 256, FF, sm, p.ws,
    [&](int mt, int nt, auto&& use) {
      int e, lt, ce; moe_find(p, moe_idx, m, mt, e, lt, ce);
      const bf16_t* Wt = (const bf16_t*)(p.ws + W_MDN) + (size_t)(moe_idx * 8 + e) * D * FF;
      use([&](int r) { return ACT + (size_t)(mt * 256 + r) * FF; },
          [&](int r) { return Wt + (size_t)(nt * 256 + perm8(r)) * FF; },
          [&](f32x4 (&acc)[8][4], int wm, int wn, int lane) { moedown_epi<8>(p, moe_idx, acc, e, lt * 256 + wm * 128, ce, nt * 256 + wn * 64, lane); });
    },
    [&](int mt, int nt, auto&& use) {
      int e, lt, ce; moe_find(p, moe_idx, m, mt >> 2, e, lt, ce);
      const bf16_t* Wt = (const bf16_t*)(p.ws + W_MDN) + (size_t)(moe_idx * 8 + e) * D * FF;
      use([&](int r) { return ACT + (size_t)(mt * 64 + r) * FF; },
          [&](int r) { return Wt + (size_t)(nt * 128 + perm8(r)) * FF; },
          [&](f32x4 (&acc)[1][4], int wm, int wn, int lane) { moedown_epi<1>(p, moe_idx, acc, e, lt * 256 + (mt & 3) * 64 + wm * 16, ce, nt * 128 + wn * 64, lane); });
    }, &p, cv0, cv1);
}

template <int MI, class ACC>
DI void inproj_epi(bf16_t* XZ, bf16_t* GG, ACC& acc, int row0, int col0, int lane) {
#pragma unroll
  for (int i = 0; i < MI; ++i) {
    const int row = row0 + i * 16 + (lane & 15);
#pragma unroll
    for (int jj = 0; jj < 4; jj += 2) {
      const int col = col0 + (jj >> 1) * 32 + 8 * (lane >> 4);
      if (col0 < D) *(uint4*)(XZ + (size_t)row * D + col) = pack8(acc[i][jj], acc[i][jj + 1]);
      else { f32x4 o0, o1; for (int q = 0; q < 4; ++q) { o0[q] = gelut(acc[i][jj][q]); o1[q] = gelut(acc[i][jj + 1][q]); } *(uint4*)(GG + (size_t)row * D + col - D) = pack8(o0, o1); }
    }
  }
}
DI void rg_inproj(const Prm& p, int j, bf16_t* sm, int cv0 = 0, int cv1 = 0) {
  const bf16_t* H = (const bf16_t*)(p.ws + O_H); const bf16_t* Wt = (const bf16_t*)(p.ws + W_RGIN) + (size_t)j * 2048 * D;
  bf16_t* XZ = (bf16_t*)(p.ws + M_XZ); bf16_t* GG = (bf16_t*)(p.ws + M_GG);
  gemm_split<false>(false, R / 256, 8, D, sm, p.ws,
    [&](int mt, int nt, auto&& use) {
      use([&](int r) { return H + (size_t)(mt * 256 + r) * D; },
          [&](int r) { return Wt + (size_t)(nt * 256 + perm8(r)) * D; },
          [&](f32x4 (&acc)[8][4], int wm, int wn, int lane) { inproj_epi<8>(XZ, GG, acc, mt * 256 + wm * 128, nt * 256 + wn * 64, lane); });
    },
    [&](int mt, int nt, auto&& use) {
      use([&](int r) { return H + (size_t)(mt * 64 + r) * D; },
          [&](int r) { return Wt + (size_t)(nt * 128 + perm8(r)) * D; },
          [&](f32x4 (&acc)[1][4], int wm, int wn, int lane) { inproj_epi<1>(XZ, GG, acc, mt * 64 + wm * 16, nt * 128 + wn * 64, lane); });
    }, &p, cv0, cv1);
}
DI void rg_conv(const Prm& p, int j) {
  const bf16_t* XZ = (const bf16_t*)(p.ws + M_XZ); bf16_t* XL = (bf16_t*)(p.ws + M_XL);
  const float* cw = p.conv_w + (size_t)j * 4 * D; const float* cb = p.conv_b + (size_t)j * D;
  const int gt = obid() * NTHR + otid(), gn = ogrid() * NTHR;
  if ((gn & 127) != 0) return;
  const int c0 = (gt & 127) * 8;
  float w[4][8], bias[8];
#pragma unroll
  for (int q = 0; q < 8; ++q) bias[q] = cb[c0 + q];
#pragma unroll
  for (int t = 0; t < 4; ++t)
#pragma unroll
    for (int q = 0; q < 8; ++q) w[t][q] = cw[t * D + c0 + q];
  const u32x4 z4 = {0u, 0u, 0u, 0u};
  auto ld = [&](int e, u32x4 (&v)[4]) {
    const int row = e >> 7, lo = row < S ? 0 : S, hi = row < S ? S : R;
#pragma unroll
    for (int t = 0; t < 4; ++t) { const int rr = row + t - 2; v[t] = (rr >= lo && rr < hi) ? *(const u32x4*)(XZ + (size_t)rr * D + c0) : z4; }
  };
  auto st = [&](int e, u32x4 (&v)[4]) {
    const int row = e >> 7;
    float a[8];
#pragma unroll
    for (int q = 0; q < 8; ++q) a[q] = bias[q];
#pragma unroll
    for (int t = 0; t < 4; ++t)
#pragma unroll
      for (int q = 0; q < 4; ++q) { a[2 * q] += __uint_as_float(v[t][q] << 16) * w[t][2 * q]; a[2 * q + 1] += __uint_as_float(v[t][q] & 0xffff0000u) * w[t][2 * q + 1]; }
    *(uint4*)(XL + (size_t)row * D + c0) = make_uint4(pack2(a[0], a[1]), pack2(a[2], a[3]), pack2(a[4], a[5]), pack2(a[6], a[7]));
  };
  u32x4 v0[4], v1[4];
  int e = gt;
  if (e < R * 128) ld(e, v0);
  for (; e < R * 128; e += 2 * gn) {
    const bool m1 = e + gn < R * 128, m2 = e + 2 * gn < R * 128;
    if (m1) ld(e + gn, v1);
    st(e, v0);
    if (m2) ld(e + 2 * gn, v0);
    if (m1) st(e + gn, v1);
  }
}
template <int MI, class ACC>
DI void gates_epi(const Prm& p, int j, ACC& acc, int row0, int col0, int lane) {
  const bf16_t* XL = (const bf16_t*)(p.ws + M_XL); bf16_t* LA = (bf16_t*)(p.ws + M_LA); bf16_t* IX = (bf16_t*)(p.ws + M_IX);
  const int d = col0 >> 11, gate = (col0 >> 10) & 1, chw = col0 & 1023;
  const float* bias = (gate ? p.rg_bi : p.rg_ba) + (size_t)(j * 2 + d) * D;
  const float* lam = p.rg_lam + (size_t)(j * 2 + d) * D;
#pragma unroll
  for (int jj = 0; jj < 4; jj += 2) {
    const int ch = chw + (jj >> 1) * 32 + 8 * (lane >> 4);
    float bb[8], sp[8];
    { const float4 b0 = *(const float4*)(bias + ch), b1 = *(const float4*)(bias + ch + 4); bb[0] = b0.x; bb[1] = b0.y; bb[2] = b0.z; bb[3] = b0.w; bb[4] = b1.x; bb[5] = b1.y; bb[6] = b1.z; bb[7] = b1.w; }
    if (gate == 0) {
      const float4 l0 = *(const float4*)(lam + ch), l1 = *(const float4*)(lam + ch + 4);
      const float ll[8] = {l0.x, l0.y, l0.z, l0.w, l1.x, l1.y, l1.z, l1.w};
#pragma unroll
      for (int q = 0; q < 8; ++q) sp[q] = -8.f * softplus_neg(ll[q]);
    }
#pragma unroll
    for (int i = 0; i < MI; ++i) {
      const int row = row0 + i * 16 + (lane & 15);
      float v[8];
#pragma unroll
      for (int q = 0; q < 4; ++q) { v[q] = acc[i][jj][q]; v[4 + q] = acc[i][jj + 1][q]; }
      f32x4 o0, o1;
      if (gate == 0) {
#pragma unroll
        for (int q = 0; q < 4; ++q) { o0[q] = sp[q] * sigm(v[q] + bb[q]); o1[q] = sp[4 + q] * sigm(v[4 + q] + bb[4 + q]); }
        *(uint4*)(LA + ((size_t)d * R + row) * D + ch) = pack8(o0, o1);
      } else {
        const uint4 xv = *(const uint4*)(XL + (size_t)row * D + ch);
        float x0[4], x1[4]; unpack4(make_uint2(xv.x, xv.y), x0); unpack4(make_uint2(xv.z, xv.w), x1);
#pragma unroll
        for (int q = 0; q < 4; ++q) { o0[q] = sigm(v[q] + bb[q]) * x0[q]; o1[q] = sigm(v[4 + q] + bb[4 + q]) * x1[q]; }
        *(uint4*)(IX + ((size_t)d * R + row) * D + ch) = pack8(o0, o1);
      }
    }
  }
}
DI void rg_gates(const Prm& p, int j, bf16_t* sm, int cv0 = 0, int cv1 = 0) {
  const bf16_t* XL = (const bf16_t*)(p.ws + M_XL); const bf16_t* Wt = (const bf16_t*)(p.ws + W_GATE) + (size_t)j * 4096 * 256;
  gemm_split<false>(false, R / 256, 16, 256, sm, p.ws,
    [&](int mt, int nt, auto&& use) {
      const int nblk = ((nt * 256) & 1023) >> 8;
      use([&](int r) { return XL + (size_t)(mt * 256 + r) * D + nblk * 256; },
          [&](int r) { return Wt + (size_t)(nt * 256 + perm8(r)) * 256; },
          [&](f32x4 (&acc)[8][4], int wm, int wn, int lane) { gates_epi<8>(p, j, acc, mt * 256 + wm * 128, nt * 256 + wn * 64, lane); });
    },
    [&](int mt, int nt, auto&& use) {
      const int nblk = ((nt * 128) & 1023) >> 8;
      use([&](int r) { return XL + (size_t)(mt * 64 + r) * D + nblk * 256; },
          [&](int r) { return Wt + (size_t)(nt * 128 + perm8(r)) * 256; },
          [&](f32x4 (&acc)[1][4], int wm, int wn, int lane) { gates_epi<1>(p, j, acc, mt * 64 + wm * 16, nt * 128 + wn * 64, lane); });
    }, &p, cv0, cv1);
}
constexpr int SC = 64, NCH2 = R / SC;
DI int chunk_base(int j) { return j < S / SC ? j * SC : S + (j - S / SC) * SC; }
DI void ab_from(uint2 lav, uint2 ixv, float* a, float* b) {
  float la[4], ix[4]; unpack4(lav, la); unpack4(ixv, ix);
#pragma unroll
  for (int q = 0; q < 4; ++q) { a[q] = __expf(la[q]); b[q] = __builtin_amdgcn_sqrtf(fmaxf(1.f - a[q] * a[q], 0.f)) * ix[q]; }
}
DI void rg_scan1(const Prm& p) {
  const bf16_t* LA = (const bf16_t*)(p.ws + M_LA); const bf16_t* IX = (const bf16_t*)(p.ws + M_IX);
  float* CA = (float*)(p.ws + M_CA); float* CB = (float*)(p.ws + M_CB);
  const int gt = obid() * NTHR + otid(), gn = ogrid() * NTHR;
  for (int e = gt; e < 2 * NCH2 * 256; e += gn) {
    const int cq = e & 255, dj = e >> 8, d = dj / NCH2, j = dj % NCH2, base = chunk_base(j);
    float A[4] = {1.f, 1.f, 1.f, 1.f}, B[4] = {0.f, 0.f, 0.f, 0.f};
    const size_t off0 = ((size_t)d * R) * D + cq * 4;
    uint2 l0[8], i0[8], l1[8], i1[8];
    auto ld = [&](int s0, uint2 (&lv)[8], uint2 (&iv)[8]) {
#pragma unroll
      for (int u = 0; u < 8; ++u) { const int row = d ? base + SC - 1 - (s0 + u) : base + s0 + u; lv[u] = *(const uint2*)(LA + off0 + (size_t)row * D); iv[u] = *(const uint2*)(IX + off0 + (size_t)row * D); }
    };
    auto fold = [&](uint2 (&lv)[8], uint2 (&iv)[8]) {
#pragma unroll
      for (int u = 0; u < 8; ++u) {
        float a[4], b[4]; ab_from(lv[u], iv[u], a, b);
#pragma unroll
        for (int q = 0; q < 4; ++q) { B[q] = a[q] * B[q] + b[q]; A[q] *= a[q]; }
      }
    };
    ld(0, l0, i0);
    for (int s0 = 0; s0 < SC; s0 += 16) { ld(s0 + 8, l1, i1); fold(l0, i0); if (s0 + 16 < SC) ld(s0 + 16, l0, i0); fold(l1, i1); }
    *(float4*)(CA + (size_t)dj * D + cq * 4) = make_float4(A[0], A[1], A[2], A[3]);
    *(float4*)(CB + (size_t)dj * D + cq * 4) = make_float4(B[0], B[1], B[2], B[3]);
  }
}
DI void rg_scan2(const Prm& p) {
  const bf16_t* LA = (const bf16_t*)(p.ws + M_LA); const bf16_t* IX = (const bf16_t*)(p.ws + M_IX); const bf16_t* GG = (const bf16_t*)(p.ws + M_GG);
  const float* CA = (const float*)(p.ws + M_CA); const float* CB = (const float*)(p.ws + M_CB);
  bf16_t* TMP = (bf16_t*)(p.ws + M_TMP); bf16_t* YIN = (bf16_t*)(p.ws + M_YIN);
  const int gt = obid() * NTHR + otid(), gn = ogrid() * NTHR;
  constexpr int NL = S / SC, NC = CT / SC;
  for (int e = gt; e < NCH2 * 256; e += gn) {
    const int cq = e & 255, j = e >> 8, base = chunk_base(j);
    float hf[4] = {0.f, 0.f, 0.f, 0.f}, hb[4] = {0.f, 0.f, 0.f, 0.f};
    const int pf = j >= NL ? j - NL : j + NC;
    for (int p0 = 0; p0 < pf; p0 += 8) {
      float4 av[8], bv[8];
#pragma unroll
      for (int u = 0; u < 8; ++u) { const int pos = min(p0 + u, pf - 1); const int i = pos < NC ? NL + pos : pos - NC; av[u] = *(const float4*)(CA + (size_t)i * D + cq * 4); bv[u] = *(const float4*)(CB + (size_t)i * D + cq * 4); }
#pragma unroll
      for (int u = 0; u < 8; ++u) if (p0 + u < pf) { hf[0] = av[u].x * hf[0] + bv[u].x; hf[1] = av[u].y * hf[1] + bv[u].y; hf[2] = av[u].z * hf[2] + bv[u].z; hf[3] = av[u].w * hf[3] + bv[u].w; }
    }
    const int pb = NCH2 - 1 - j;
    for (int p0 = 0; p0 < pb; p0 += 8) {
      float4 av[8], bv[8];
#pragma unroll
      for (int u = 0; u < 8; ++u) { const int pos = min(p0 + u, pb - 1); const int i = NCH2 - 1 - pos; av[u] = *(const float4*)(CA + (size_t)(NCH2 + i) * D + cq * 4); bv[u] = *(const float4*)(CB + (size_t)(NCH2 + i) * D + cq * 4); }
#pragma unroll
      for (int u = 0; u < 8; ++u) if (p0 + u < pb) { hb[0] = av[u].x * hb[0] + bv[u].x; hb[1] = av[u].y * hb[1] + bv[u].y; hb[2] = av[u].z * hb[2] + bv[u].z; hb[3] = av[u].w * hb[3] + bv[u].w; }
    }
    const size_t c0 = (size_t)cq * 4;
    {
      uint2 l0[8], i0[8], l1[8], i1[8];
      auto ld = [&](int s0, uint2 (&lv)[8], uint2 (&iv)[8]) {
#pragma unroll
        for (int u = 0; u < 8; ++u) { const size_t ix = (size_t)(base + s0 + u) * D + c0; lv[u] = *(const uint2*)(LA + ix); iv[u] = *(const uint2*)(IX + ix); }
      };
      auto fold = [&](int s0, uint2 (&lv)[8], uint2 (&iv)[8]) {
#pragma unroll
        for (int u = 0; u < 8; ++u) {
          float a[4], b[4]; ab_from(lv[u], iv[u], a, b);
#pragma unroll
          for (int q = 0; q < 4; ++q) hf[q] = a[q] * hf[q] + b[q];
          *(uint2*)(TMP + (size_t)(base + s0 + u) * D + c0) = make_uint2(pack2(hf[0], hf[1]), pack2(hf[2], hf[3]));
        }
      };
      ld(0, l0, i0);
      for (int s0 = 0; s0 < SC; s0 += 16) { ld(s0 + 8, l1, i1); fold(s0, l0, i0); if (s0 + 16 < SC) ld(s0 + 16, l0, i0); fold(s0 + 8, l1, i1); }
    }
    {
      uint2 l0[8], i0[8], t0[8], g0[8], l1[8], i1[8], t1[8], g1[8];
      auto ld = [&](int s0, uint2 (&lv)[8], uint2 (&iv)[8], uint2 (&tv)[8], uint2 (&gv)[8]) {
#pragma unroll
        for (int u = 0; u < 8; ++u) { const size_t ix = (size_t)(base + SC - 1 - (s0 + u)) * D + c0; lv[u] = *(const uint2*)(LA + (size_t)R * D + ix); iv[u] = *(const uint2*)(IX + (size_t)R * D + ix); tv[u] = *(const uint2*)(TMP + ix); gv[u] = *(const uint2*)(GG + ix); }
      };
      auto fold = [&](int s0, uint2 (&lv)[8], uint2 (&iv)[8], uint2 (&tv)[8], uint2 (&gv)[8]) {
#pragma unroll
        for (int u = 0; u < 8; ++u) {
          float a[4], b[4], t[4], g[4]; ab_from(lv[u], iv[u], a, b); unpack4(tv[u], t); unpack4(gv[u], g);
#pragma unroll
          for (int q = 0; q < 4; ++q) hb[q] = a[q] * hb[q] + b[q];
          *(uint2*)(YIN + (size_t)(base + SC - 1 - (s0 + u)) * D + c0) = make_uint2(pack2((t[0] + hb[0]) * g[0], (t[1] + hb[1]) * g[1]), pack2((t[2] + hb[2]) * g[2], (t[3] + hb[3]) * g[3]));
        }
      };
      ld(0, l0, i0, t0, g0);
      for (int s0 = 0; s0 < SC; s0 += 16) { ld(s0 + 8, l1, i1, t1, g1); fold(s0, l0, i0, t0, g0); if (s0 + 16 < SC) ld(s0 + 16, l0, i0, t0, g0); fold(s0 + 8, l1, i1, t1, g1); }
    }
  }
}

template <int MI, class ACC>
DI void qk_epi(const Prm& p, ACC& acc, int row0, int col0, int lane) {
  bf16_t* Qb = (bf16_t*)(p.ws + M_Q); bf16_t* Kb = (bf16_t*)(p.ws + M_K);
  const bool isq = col0 < D; const float* gv = isq ? p.na_qg : p.na_kg; bf16_t* O = isq ? Qb : Kb;
  const int colb = col0 & 1023; const float osc = isq ? 0.125f : 1.f;
#pragma unroll
  for (int i = 0; i < MI; ++i) {
    const int row = row0 + i * 16 + (lane & 15);
    float ss = 0.f;
#pragma unroll
    for (int jj = 0; jj < 4; ++jj)
#pragma unroll
      for (int q = 0; q < 4; ++q) ss += acc[i][jj][q] * acc[i][jj][q];
    ss += __shfl_xor(ss, 16); ss += __shfl_xor(ss, 32);
    const float rstd = __builtin_amdgcn_rsqf(ss * (1.f / 64.f) + 1e-6f) * osc;
#pragma unroll
    for (int jj = 0; jj < 4; jj += 2) {
      const int dc = (jj >> 1) * 32 + 8 * (lane >> 4);
      const f32x4 g0 = *(const f32x4*)(gv + dc), g1 = *(const f32x4*)(gv + dc + 4);
      *(uint4*)(O + (size_t)row * D + colb + dc) = pack8(acc[i][jj] * rstd * g0, acc[i][jj + 1] * rstd * g1);
    }
  }
}
template <int MI, class ACC>
DI void v_epi(bf16_t* VT, ACC& acc, int tok0, int hd0, int lane) {
#pragma unroll
  for (int i = 0; i < MI; ++i) {
    const int tok = tok0 + i * 16 + 4 * (lane >> 4);
#pragma unroll
    for (int jj = 0; jj < 4; ++jj) {
      const int hd = hd0 + jj * 16 + (lane & 15);
      *(uint2*)(VT + (size_t)hd * R + tok) = pack4(acc[i][jj]);
    }
  }
}
DI void na_qkv(const Prm& p, bf16_t* sm, int cv0 = 0, int cv1 = 0) {
  const int cvm = cv0 + (cv1 - cv0) / 2;
  const bf16_t* H = (const bf16_t*)(p.ws + O_H); const bf16_t* Wt = (const bf16_t*)(p.ws + W_QKV);
  bf16_t* VT = (bf16_t*)(p.ws + M_VT);
  gemm_split<false>(false, R / 256, 8, D, sm, p.ws,
    [&](int mt, int nt, auto&& use) {
      use([&](int r) { return H + (size_t)(mt * 256 + r) * D; },
          [&](int r) { return Wt + (size_t)(nt * 256 + perm8(r)) * D; },
          [&](f32x4 (&acc)[8][4], int wm, int wn, int lane) { qk_epi<8>(p, acc, mt * 256 + wm * 128, nt * 256 + wn * 64, lane); });
    },
    [&](int mt, int nt, auto&& use) {
      use([&](int r) { return H + (size_t)(mt * 64 + r) * D; },
          [&](int r) { return Wt + (size_t)(nt * 128 + perm8(r)) * D; },
          [&](f32x4 (&acc)[1][4], int wm, int wn, int lane) { qk_epi<1>(p, acc, mt * 64 + wm * 16, nt * 128 + wn * 64, lane); });
    }, &p, cv0, cvm);
  gemm_split<true>(false, R / 256, 4, D, sm, p.ws,
    [&](int mt, int nt, auto&& use) {
      use([&](int r) { return H + (size_t)(mt * 256 + r) * D; },
          [&](int r) { return Wt + (size_t)(2048 + nt * 256 + r) * D; },
          [&](f32x4 (&acc)[8][4], int wm, int wn, int lane) { v_epi<8>(VT, acc, mt * 256 + wm * 128, nt * 256 + wn * 64, lane); });
    },
    [&](int mt, int nt, auto&& use) {
      use([&](int r) { return H + (size_t)(mt * 64 + r) * D; },
          [&](int r) { return Wt + (size_t)(2048 + nt * 128 + r) * D; },
          [&](f32x4 (&acc)[1][4], int wm, int wn, int lane) { v_epi<1>(VT, acc, mt * 64 + wm * 16, nt * 128 + wn * 64, lane); });
    }, &p, cvm, cv1);
}
DI void na_attn(const Prm& p, bf16_t* sm0) {
  const int tid0 = otid(), half = tid0 >> 8, tid = tid0 & 255;
  bf16_t* sm = sm0 + half * 36864;
  bf16_t* Ks = sm; bf16_t* VTs = sm + 256 * 72; float* rp = (float*)(sm + 256 * 72 + 64 * 264);
  const bf16_t* Qb = (const bf16_t*)(p.ws + M_Q); const bf16_t* Kb = (const bf16_t*)(p.ws + M_K); const bf16_t* VT = (const bf16_t*)(p.ws + M_VT);
  bf16_t* Ob = (bf16_t*)(p.ws + M_O);
  const int lane = tid & 63, w = tid >> 6, g = lane >> 4, ql = lane & 15;
  const int G = ogrid(), b = obid();
  const int nbx = G >> 3, li = b >> 3;
  {
    const int xx = b & 7;
    for (int jj = li * 2 + half; jj < 520; jj += nbx * 2) {
      const bool lat = jj < 512;
      int h, r = 0, rs = 0, qtok;
      if (lat) { const int it = xx * 512 + jj; h = it >> 8; r = it & 255; rs = min(max(r - 4, 0), 248); qtok = r * 64 + 16 * w + ql; }
      else { const int t = xx * 8 + (jj - 512); h = t >> 2; qtok = S + (t & 3) * 64 + 16 * w + ql; }
      const int qc = 16 * w + ql, cst = min(max(qc - 8, 0), 48), cs0 = min(max(16 * w - 8, 0), 32);
      bf16x8 qf[2];
#pragma unroll
      for (int ks = 0; ks < 2; ++ks) qf[ks] = *(const bf16x8*)(Qb + (size_t)qtok * D + h * 64 + ks * 32 + g * 8);
      float m_run = -1e30f, l_run = 0.f;
      f32x4 o[4];
#pragma unroll
      for (int db = 0; db < 4; ++db) o[db] = (f32x4){0.f, 0.f, 0.f, 0.f};
      __syncthreads();
      if (lat) for (int e = tid; e < 465; e += 256) rp[e] = p.na_rpb[(size_t)h * 465 + e];
      const char* const kbase = (const char*)Kb + (size_t)h * 128; const char* const vbase = (const char*)VT + (size_t)h * 64 * R * 2;
      for (int c = lat ? 0 : 2; c < 4; ++c) {
        __syncthreads();
        {
          const int nkeys = c < 2 ? 256 : 128, tok0 = c < 2 ? (rs + 4 * c) * 64 : S + (c - 2) * 128, psh = c < 2 ? 5 : 4, pmk = (1 << psh) - 1, ni = nkeys >> 5;
          u32x4 kreg[8], vreg[8];
#pragma unroll
          for (int i = 0; i < 8; ++i) if (i < ni) {
            const int ch = tid + 256 * i;
            const unsigned ko = (unsigned)((tok0 + (ch >> 3)) * D + (ch & 7) * 8) * 2u, vo = (unsigned)((ch >> psh) * R + tok0 + (ch & pmk) * 8) * 2u;
            kreg[i] = *(const u32x4*)(kbase + ko);
            vreg[i] = *(const u32x4*)(vbase + vo);
          }
#pragma unroll
          for (int i = 0; i < 8; ++i) if (i < ni) {
            const int ch = tid + 256 * i;
            *(u32x4*)(Ks + (ch >> 3) * 72 + (ch & 7) * 8) = kreg[i];
            *(u32x4*)(VTs + (ch >> psh) * 264 + (ch & pmk) * 8) = vreg[i];
          }
        }
        __syncthreads();
        f32x4 s[8];
#pragma unroll
        for (int kb = 0; kb < 8; ++kb) {
          const int kbase = c < 2 ? (kb >> 1) * 64 + cs0 + 16 * (kb & 1) : kb * 16;
          s[kb] = (f32x4){0.f, 0.f, 0.f, 0.f};
#pragma unroll
          for (int ks = 0; ks < 2; ++ks) { const bf16x8 kf = *(const bf16x8*)(Ks + (kbase + ql) * 72 + ks * 32 + g * 8); s[kb] = MFMA16(kf, qf[ks], s[kb]); }
        }
        if (c < 2) {
#pragma unroll
          for (int kb = 0; kb < 8; ++kb) {
            const int krow = rs + 4 * c + (kb >> 1), rbi = krow - r + 7;
#pragma unroll
            for (int q = 0; q < 4; ++q) {
              const int kc = cs0 + 16 * (kb & 1) + 4 * g + q;
              const bool valid = (kc >= cst) && (kc < cst + 16);
              const int cbi = min(max(kc - qc + 15, 0), 30);
              s[kb][q] = valid ? s[kb][q] + rp[rbi * 31 + cbi] : -1e30f;
            }
          }
        }
        float mx = -1e30f;
#pragma unroll
        for (int kb = 0; kb < 8; ++kb)
#pragma unroll
          for (int q = 0; q < 4; ++q) mx = fmaxf(mx, s[kb][q]);
        mx = fmaxf(mx, __shfl_xor(mx, 16)); mx = fmaxf(mx, __shfl_xor(mx, 32));
        const float m_new = fmaxf(m_run, mx), alpha = __expf(m_run - m_new);
        float ls = 0.f;
#pragma unroll
        for (int kb = 0; kb < 8; ++kb)
#pragma unroll
          for (int q = 0; q < 4; ++q) { s[kb][q] = __expf(s[kb][q] - m_new); ls += s[kb][q]; }
        l_run = l_run * alpha + ls; m_run = m_new;
#pragma unroll
        for (int db = 0; db < 4; ++db) { o[db][0] *= alpha; o[db][1] *= alpha; o[db][2] *= alpha; o[db][3] *= alpha; }
#pragma unroll
        for (int t = 0; t < 4; ++t) {
          const int kb0 = c < 2 ? ((2 * t) >> 1) * 64 + cs0 : (2 * t) * 16, kb1 = c < 2 ? kb0 + 16 : kb0 + 16;
          const uint2 p0 = pack4(s[2 * t]), p1 = pack4(s[2 * t + 1]);
          const uint4 pu = make_uint4(p0.x, p0.y, p1.x, p1.y);
          const bf16x8 pf = __builtin_bit_cast(bf16x8, pu);
#pragma unroll
          for (int db = 0; db < 4; ++db) {
            const s16x4 v0 = *(const s16x4*)(VTs + (db * 16 + ql) * 264 + kb0 + 4 * g), v1 = *(const s16x4*)(VTs + (db * 16 + ql) * 264 + kb1 + 4 * g);
            const bf16x8 vf = __builtin_shufflevector(v0, v1, 0, 1, 2, 3, 4, 5, 6, 7);
            o[db] = MFMA16(vf, pf, o[db]);
          }
        }
      }
      l_run += __shfl_xor(l_run, 16); l_run += __shfl_xor(l_run, 32);
      const float inv = 1.f / l_run;
#pragma unroll
      for (int db = 0; db < 4; ++db) { f32x4 v = o[db]; v[0] *= inv; v[1] *= inv; v[2] *= inv; v[3] *= inv; *(uint2*)(Ob + (size_t)qtok * D + h * 64 + db * 16 + 4 * g) = pack4(v); }
    }
  }
}

DI void ft_chan(const Prm& p, bf16_t* sm) {
  const bf16_t* H = (const bf16_t*)(p.ws + O_H); const bf16_t* Bc = (const bf16_t*)(p.ws + W_BC);
  bf16_t* UT = (bf16_t*)(p.ws + M_UT); bf16_t* UTC = (bf16_t*)(p.ws + M_UTC);
  gemm_stream<true, 4, 2, 4>(130, 8, 256, sm, p.ws, [&](int mt, int nt, auto&& use) {
    const int grp = nt >> 1;
    use(
        [&](int r0) { const int r = perm8(r0); const int tok = mt < 128 ? 128 * r + mt : S + (mt - 128) * 128 + r; return H + (size_t)tok * D + grp * 256; },
        [&](int r) { return Bc + (size_t)((nt & 1) * 256 + r) * 256; },
        [&](f32x4 (&acc)[4][4], int wm, int wn, int lane) {
#pragma unroll
          for (int i = 0; i < 4; i += 2) {
            const int tr = wm * 64 + (i >> 1) * 32 + 8 * (lane >> 4);
#pragma unroll
            for (int jj = 0; jj < 4; ++jj) {
              const int cc = (nt & 1) * 256 + wn * 64 + jj * 16 + (lane & 15), ri = cc >> 8, ch = grp * 256 + (cc & 255);
              const uint4 w = pack8(acc[i][jj], acc[i + 1][jj]);
              if (mt < 128) *(uint4*)(UT + (((size_t)mt * D + ch) * 2 + ri) * 128 + tr) = w;
              else *(uint4*)(UTC + ((size_t)ch * 2 + ri) * 256 + (mt - 128) * 128 + tr) = w;
            }
          }
        });
  });
}
DI void ft_step1(const Prm& p, bf16_t* sm) {
  const bf16_t* UT = (const bf16_t*)(p.ws + M_UT); const bf16_t* UTC = (const bf16_t*)(p.ws + M_UTC);
  const bf16_t* D1 = (const bf16_t*)(p.ws + W_D1); const bf16_t* Dc = (const bf16_t*)(p.ws + W_DC);
  bf16_t* AT = (bf16_t*)(p.ws + M_AT); bf16_t* F = (bf16_t*)(p.ws + M_F);
  gemm_stream<true, 4, 2, 4>(1024, 1, 256, sm, p.ws, [&](int mt, int nt, auto&& use) {
    const int ch = mt;
    use(
        [&](int r) { return UT + ((size_t)perm8(r) * D + ch) * 256; },
        [&](int r) { return D1 + (size_t)ileave(r, 128) * 256; },
        [&](f32x4 (&acc)[4][4], int wm, int wn, int lane) {
#pragma unroll
          for (int i = 0; i < 4; i += 2) {
            const int t2 = wm * 64 + (i >> 1) * 32 + 8 * (lane >> 4);
#pragma unroll
            for (int jj = 0; jj < 2; ++jj) {
              const int k1 = wn * 32 + jj * 16 + (lane & 15);
              f32x4 orr[2], oi[2];
#pragma unroll
              for (int u = 0; u < 2; ++u)
#pragma unroll
                for (int q = 0; q < 4; ++q) {
                  float st, ct; sincos_rev((float)(k1 * (t2 + 4 * u + q)) * (1.f / 16384.f), &st, &ct);
                  const float ar = acc[i + u][jj][q], ai = acc[i + u][jj + 2][q];
                  orr[u][q] = ar * ct + ai * st; oi[u][q] = ai * ct - ar * st;
                }
              *(uint4*)(AT + (((size_t)k1 * D + ch) * 2 + 0) * 128 + t2) = pack8(orr[0], orr[1]);
              *(uint4*)(AT + (((size_t)k1 * D + ch) * 2 + 1) * 128 + t2) = pack8(oi[0], oi[1]);
            }
          }
        });
  });
  gemm_stream<true, 4, 2, 4>(8, 1, 512, sm, p.ws, [&](int mt, int nt, auto&& use) {
    const int ch0 = mt * 128;
    use(
        [&](int r) { return UTC + (size_t)(ch0 + perm8(r)) * 512; },
        [&](int r) { return Dc + (size_t)r * 512; },
        [&](f32x4 (&acc)[4][4], int wm, int wn, int lane) {
#pragma unroll
          for (int i = 0; i < 4; i += 2) {
            const int ch = ch0 + wm * 64 + (i >> 1) * 32 + 8 * (lane >> 4);
#pragma unroll
            for (int jj = 0; jj < 4; ++jj) {
              const int k = wn * 64 + jj * 16 + (lane & 15);
              *(uint4*)(F + (size_t)(S + k) * D + ch) = pack8(acc[i][jj], acc[i + 1][jj]);
            }
          }
        });
  });
}
DI void ft_step3(const Prm& p, bf16_t* sm) {
  const bf16_t* AT = (const bf16_t*)(p.ws + M_AT); const bf16_t* D3 = (const bf16_t*)(p.ws + W_D3); bf16_t* F = (bf16_t*)(p.ws + M_F);
  gemm_stream<true, 4, 4, 2>(512, 1, 256, sm, p.ws, [&](int mt, int nt, auto&& use) {
    const int k1 = mt >> 2, ch0 = (mt & 3) * 256;
    use(
        [&](int r) { return AT + ((size_t)k1 * D + ch0 + perm8(r)) * 256; },
        [&](int r) { return D3 + (size_t)r * 256; },
        [&](f32x4 (&acc)[4][4], int wm, int wn, int lane) {
#pragma unroll
          for (int i = 0; i < 4; i += 2) {
            const int ch = ch0 + wm * 64 + (i >> 1) * 32 + 8 * (lane >> 4);
#pragma unroll
            for (int jj = 0; jj < 4; ++jj) {
              const int k2 = wn * 64 + jj * 16 + (lane & 15);
              *(uint4*)(F + (size_t)(128 * k2 + k1) * D + ch) = pack8(acc[i][jj], acc[i + 1][jj]);
            }
          }
        });
  });
}

#define XB_TMO      128
#define XB_XCNT(j)  (256  + 64 * (j))
#define XB_XSUB(j)  (1280 + 64 * (j))
#define XB_XGEN(j)  (2304 + 64 * (j))
#define XB_TOP      3328
#define XB_TOPGEN   3392
#define XCD_BAR_WORDS 3456
#define XB_SPIN_CAP (1u << 18)
#define LAS __attribute__((address_space(3)))

__device__ __forceinline__ unsigned xb_ld(unsigned* p)              { return __hip_atomic_load(p, __ATOMIC_RELAXED, __HIP_MEMORY_SCOPE_AGENT); }
__device__ __forceinline__ unsigned xb_add(unsigned* p, unsigned v) { return __hip_atomic_fetch_add(p, v, __ATOMIC_RELAXED, __HIP_MEMORY_SCOPE_AGENT); }
__device__ __forceinline__ unsigned xb_xcc_id() { return (unsigned)__builtin_amdgcn_s_getreg((3 << 11) | 20) & 0xFu; }
#define XB_SPIN(cond, bar) do { unsigned _sp = 0; while (cond) { __builtin_amdgcn_s_sleep(1); \
    if ((++_sp & 255u) == 0u) { if (xb_ld(&(bar)[XB_TMO])) break; if (_sp > XB_SPIN_CAP) { atomicAdd(&(bar)[XB_TMO], 1u); break; } } } } while (0)

struct XcdBarrier {
    unsigned* bar; unsigned x;
    volatile LAS unsigned* st;
};

__device__ __forceinline__ XcdBarrier xcd_barrier_post(unsigned* bar, volatile LAS unsigned* st) {
    XcdBarrier b; b.bar = bar; b.x = xb_xcc_id(); b.st = st;
    if (threadIdx.x == 0) (void)xb_add(&bar[XB_XCNT(b.x)], 1u);
    return b;
}
__device__ __forceinline__ void xcd_barrier_complete(unsigned* bar, unsigned x, unsigned& nloc, unsigned& nx) {
    const unsigned G = gridDim.x * gridDim.y * gridDim.z;
    unsigned sum, cnt, mine, sp = 0u;
    for (;;) {
        sum = 0u; cnt = 0u; mine = 0u;
#pragma unroll
        for (unsigned j = 0; j < 16; ++j) { const unsigned c = xb_ld(&bar[XB_XCNT(j)]); sum += c; cnt += (c > 0u) ? 1u : 0u; mine = (j == x) ? c : mine; }
        if (sum == G) break;
        __builtin_amdgcn_s_sleep(1);
        if ((++sp & 255u) == 0u) { if (xb_ld(&bar[XB_TMO])) break; if (sp > XB_SPIN_CAP) { atomicAdd(&bar[XB_TMO], 1u); break; } }
    }
    nloc = mine > 0u ? mine : 1u; nx = cnt > 0u ? cnt : 1u;
}

__device__ __forceinline__ void xcd_barrier(const XcdBarrier& b) {
    asm volatile("s_waitcnt vmcnt(0)" ::: "memory");
    __syncthreads();
    if (threadIdx.x == 0) {
        unsigned* bar = b.bar;
        __builtin_amdgcn_s_waitcnt(0);
        unsigned nloc = b.st[0], nx = b.st[1];
        if (nloc == 0u) { xcd_barrier_complete(bar, b.x, nloc, nx); b.st[0] = nloc; b.st[1] = nx; }
        const unsigned old = xb_add(&bar[XB_XSUB(b.x)], 1u);
        const unsigned gen = old / nloc;
        if (old + 1u == (gen + 1u) * nloc) {
            __builtin_amdgcn_fence(__ATOMIC_RELEASE, "agent");
            asm volatile("s_waitcnt vmcnt(0)" ::: "memory");
            const unsigned og = xb_add(&bar[XB_TOP], 1u);
            const unsigned tg = og / nx;
            if (og + 1u == (tg + 1u) * nx) xb_add(&bar[XB_TOPGEN], 1u);
            else XB_SPIN(xb_ld(&bar[XB_TOPGEN]) == tg, bar);
            __builtin_amdgcn_fence(__ATOMIC_ACQUIRE, "agent");
            xb_add(&bar[XB_XGEN(b.x)], 1u);
            asm volatile("s_waitcnt vmcnt(0)" ::: "memory");
        } else {
            XB_SPIN(xb_ld(&bar[XB_XGEN(b.x)]) == gen, bar);
            __builtin_amdgcn_fence(__ATOMIC_ACQUIRE, "agent");
            asm volatile("s_waitcnt vmcnt(0)" ::: "memory");
        }
    }
    __syncthreads();
}


__global__ void __launch_bounds__(512) fwd_megakernel(Prm p) {
  __shared__ __attribute__((aligned(16))) unsigned char smem_raw[SMEM_BYTES];
  bf16_t* sm = (bf16_t*)smem_raw;
  __shared__ uint4 xb_words;
  if (threadIdx.x == 0) {
    xb_words = make_uint4(0u, 0u, 0u, 0u);
#pragma unroll
    for (int j = 0; j < NJOB; ++j) g_jobs_s[j] = p.jobs[j];
  }
  __syncthreads();
  XcdBarrier xb = xcd_barrier_post((unsigned*)(p.ws + O_BAR), (volatile LAS unsigned*)&xb_words);
  if (p.never) { cg::grid_group grid = cg::this_grid(); grid.sync(); }
#define GSYNC() do { for (int rs_ = 0; rs_ < REP_SYNC; ++rs_) xcd_barrier(xb); } while (0)
#define WITH_CONV(c0, c1, call) do { const bool cf_ = ((obid() >> 3) & 1) == 0; if (cf_) conv_range(p, (c0), (c1), sm); call; if (!cf_) conv_range(p, (c0), (c1), sm); } while (0)
  phase0(p, sm); GSYNC();
  int rg_j = 0, dense_j = 0, moe_j = 0;
  for (int l = 0; l < 4; ++l) {
    norm_phase(p, l, 0, -1, sm, l == 2 ? 1 : -1); GSYNC();
    const int kind = l % 3;
    if (kind == 0) {
      const int c0 = l == 0 ? CV_P0 : CV_L2_DN, c1 = l == 0 ? CV_L0_IN : CV_L3_IN, c2 = l == 0 ? CV_L0_GATES : CV_L3_GATES, c3 = l == 0 ? CV_L0_OUT : CV_L3_OUT;
      for (int q_ = 0; q_ < REP_OG; ++q_) { rg_inproj(p, rg_j, sm, c0, c1); GSYNC(); }
      for (int q_ = 0; q_ < REP_ATT; ++q_) { rg_conv(p, rg_j); GSYNC(); }
      for (int q_ = 0; q_ < REP_OG; ++q_) { rg_gates(p, rg_j, sm, c1, c2); GSYNC(); }
      for (int q_ = 0; q_ < REP_SCAN; ++q_) { rg_scan1(p); GSYNC(); rg_scan2(p); GSYNC(); }
      resid_gemm(p, (const bf16_t*)(p.ws + M_YIN), D, (const bf16_t*)(p.ws + W_RGOUT) + (size_t)rg_j * D * D, l, 2, sm, c2, c3);
      ++rg_j;
    } else if (kind == 1) {
      for (int q_ = 0; q_ < REP_OG; ++q_) { na_qkv(p, sm, CV_L0_DN, CV_L1_QKV); GSYNC(); }
      for (int q_ = 0; q_ < REP_ATT; ++q_) { na_attn(p, sm); GSYNC(); }
      resid_gemm(p, (const bf16_t*)(p.ws + M_O), D, (const bf16_t*)(p.ws + W_O), l, 2, sm, CV_L1_QKV, CV_L1_O);
    } else {
      for (int q_ = 0; q_ < REP_OG; ++q_) { ft_chan(p, sm); GSYNC(); ft_step1(p, sm); GSYNC(); ft_step3(p, sm); GSYNC(); }
      resid_gemm(p, (const bf16_t*)(p.ws + M_F), D, (const bf16_t*)(p.ws + W_FT), l, 2, sm);
    }
    GSYNC();
    const bool moe = (l & 1);
    norm_phase(p, l, 1, moe ? moe_j : -1, sm); GSYNC();
    if (!moe) {
      const int c0 = l == 0 ? CV_L0_OUT : CV_L1_MDN, c1 = l == 0 ? CV_L0_GU : CV_L2_GU, c2 = l == 0 ? CV_L0_DN : CV_L2_DN;
      ffn_gu(p, (const bf16_t*)(p.ws + W_FGU) + (size_t)dense_j * 2 * FF * D, sm, c0, c1); GSYNC();
      resid_gemm(p, (const bf16_t*)(p.ws + O_ACT), FF, (const bf16_t*)(p.ws + W_FDN) + (size_t)dense_j * D * FF, l, 5, sm, c1, c2);
      ++dense_j;
    } else {
      for (int q_ = 0; q_ < REP_ATT; ++q_) { moe_route(p, moe_j, sm); GSYNC(); }
      if (l == 1) moe_gu(p, moe_j, sm, CV_L1_O, CV_L1_MGU); else moe_gu(p, moe_j, sm);
      GSYNC();
      for (int q_ = 0; q_ < REP_MDN; ++q_) { if (l == 1) moe_down(p, moe_j, l, sm, CV_L1_MGU, CV_L1_MDN); else moe_down(p, moe_j, l, sm);
      GSYNC(); }
      if (l == 3) moe_combine(p, l);
      ++moe_j;
    }
    if (l < 3 && l != 1) GSYNC();
  }
}

static void add_job(Prm& p, const float* src, size_t dst_off, int K, int N, int nb, long long ss, long long ds) {
  Job& j = p.jobs[p.njob++];
  j.src = src; j.dst = (bf16_t*)(p.ws + dst_off); j.K = K; j.N = N; j.nb = nb; j.tiles = (K / 64) * (N / 64) * nb; j.ss = ss; j.ds = ds;
}

extern "C" void kernel_launch(void* const* d_in, const int* in_sizes, int n_in, void* d_out, int out_size, void* d_ws, size_t ws_size, hipStream_t stream) {
  static int grid_blocks = 0;
  if (!grid_blocks) {
    int dev = 0, cus = 0, per_cu = 0;
    hipGetDevice(&dev);
    hipDeviceGetAttribute(&cus, hipDeviceAttributeMultiprocessorCount, dev);
    hipOccupancyMaxActiveBlocksPerMultiprocessor(&per_cu, fwd_megakernel, NTHR, 0);
    if (per_cu < 1) per_cu = 1;
    if (per_cu > 1) per_cu = 1;
    grid_blocks = (cus * per_cu) & ~7;
  }
  Prm p; memset(&p, 0, sizeof(p));
  const float* const* in = (const float* const*)d_in;
  p.x = in[0]; p.c = in[1]; p.ctx = in[2]; p.cctx = in[3]; p.ada_w = in[4]; p.ada_b = in[5]; p.norm_g = in[6];
  p.conv_w = in[8]; p.conv_b = in[9]; p.rg_ba = in[11]; p.rg_bi = in[13]; p.rg_lam = in[14];
  p.na_qg = in[17]; p.na_kg = in[18]; p.na_rpb = in[19]; p.router = in[24];
  p.out = (float*)d_out; p.ws = (unsigned char*)d_ws;
  p.njob = 0;
  const long long GU = (long long)1024 * 7168, DN = (long long)3584 * 1024, SQ = (long long)1024 * 1024;
  auto gates = [&](int j) {
    for (int d = 0; d < 2; ++d) {
      const int jd = j * 2 + d;
      add_job(p, in[10] + (size_t)jd * 4 * 65536, W_GATE + ((size_t)(jd * 2 + 0) * 4 * 65536) * 2, 256, 256, 4, 65536, 65536);
      add_job(p, in[12] + (size_t)jd * 4 * 65536, W_GATE + ((size_t)(jd * 2 + 1) * 4 * 65536) * 2, 256, 256, 4, 65536, 65536);
    }
  };
  add_job(p, in[7], W_RGIN, 1024, 2048, 1, 0, 0); gates(0); add_job(p, in[15], W_RGOUT, 1024, 1024, 1, 0, 0);
  add_job(p, in[22], W_FGU, 1024, 7168, 1, 0, 0); add_job(p, in[23], W_FDN, 3584, 1024, 1, 0, 0);
  add_job(p, in[16], W_QKV, 1024, 3072, 1, 0, 0); add_job(p, in[20], W_O, 1024, 1024, 1, 0, 0);
  add_job(p, in[25], W_MGU, 1024, 7168, 8, GU, GU); add_job(p, in[26], W_MDN, 3584, 1024, 8, DN, DN);
  add_job(p, in[21], W_FT, 1024, 1024, 1, 0, 0);
  add_job(p, in[22] + GU, W_FGU + (size_t)GU * 2, 1024, 7168, 1, 0, 0); add_job(p, in[23] + DN, W_FDN + (size_t)DN * 2, 3584, 1024, 1, 0, 0);
  add_job(p, in[7] + 2 * SQ, W_RGIN + (size_t)2 * SQ * 2, 1024, 2048, 1, 0, 0); gates(1); add_job(p, in[15] + SQ, W_RGOUT + (size_t)SQ * 2, 1024, 1024, 1, 0, 0);
  add_job(p, in[25] + 8 * GU, W_MGU + (size_t)8 * GU * 2, 1024, 7168, 8, GU, GU); add_job(p, in[26] + 8 * DN, W_MDN + (size_t)8 * DN * 2, 3584, 1024, 8, DN, DN);
  {
    int tot = 0; for (int j = 0; j < p.njob; ++j) tot += p.jobs[j].tiles;
    if (tot != CV_TOTAL) fprintf(stderr, "conversion tile count %d != %d\n", tot, CV_TOTAL);
  }
  (void)hipMemsetAsync((unsigned char*)d_ws + O_BAR, 0, XCD_BAR_WORDS * 4, stream);
  void* args[] = {&p};
  hipError_t e = hipLaunchCooperativeKernel((void*)fwd_megakernel, dim3(grid_blocks), dim3(NTHR), args, 0, stream);
  if (e != hipSuccess) fprintf(stderr, "cooperative launch failed: %s (grid %d)\n", hipGetErrorString(e), grid_blocks);
}
```

```cpp
#ifndef REP_GU
#define REP_GU 1
#endif
#ifndef REP_NORM
#define REP_NORM 1
#endif
#ifndef REP_OG
#define REP_OG 1
#endif
#ifndef REP_MDN
#define REP_MDN 1
#endif
#ifndef REP_P0
#define REP_P0 1
#endif
#ifndef REP_SYNC
#define REP_SYNC 1
#endif
#ifndef REP_SCAN
#define REP_SCAN 1
#endif
#ifndef REP_ATT
#define REP_ATT 1
#endif
#ifndef REP_SK
#define REP_SK 1
#endif
#include <hip/hip_runtime.h>
#include <hip/hip_cooperative_groups.h>
#include <cstdio>
#include <cstdint>
#include <cstring>
namespace cg = cooperative_groups;

typedef unsigned short bf16_t;
typedef short bf16x8 __attribute__((ext_vector_type(8)));
typedef short s16x4 __attribute__((ext_vector_type(4)));
typedef float f32x4 __attribute__((ext_vector_type(4)));
typedef unsigned u32x4 __attribute__((ext_vector_type(4)));
#define DI __device__ __forceinline__
#define MFMA16(a, b, c) __builtin_amdgcn_mfma_f32_16x16x32_bf16((a), (b), (c), 0, 0, 0)

constexpr int S = 16384, CT = 256, R = S + CT, D = 1024, FF = 3584, NE = 8;
constexpr int NCH = 130;
constexpr int ACT_ROWS = 2 * R + NE * 256;

constexpr size_t al(size_t x) { return (x + 255) & ~(size_t)255; }
constexpr size_t W_RGIN = 0;
constexpr size_t W_GATE = W_RGIN + al((size_t)2 * 2048 * 1024 * 2);
constexpr size_t W_RGOUT = W_GATE + al((size_t)2 * 4096 * 256 * 2);
constexpr size_t W_QKV = W_RGOUT + al((size_t)2 * 1024 * 1024 * 2);
constexpr size_t W_O = W_QKV + al((size_t)3072 * 1024 * 2);
constexpr size_t W_FT = W_O + al((size_t)1024 * 1024 * 2);
constexpr size_t W_FGU = W_FT + al((size_t)1024 * 1024 * 2);
constexpr size_t W_FDN = W_FGU + al((size_t)2 * 7168 * 1024 * 2);
constexpr size_t W_MGU = W_FDN + al((size_t)2 * 1024 * 3584 * 2);
constexpr size_t W_MDN = W_MGU + al((size_t)16 * 7168 * 1024 * 2);
constexpr size_t W_BC = W_MDN + al((size_t)16 * 1024 * 3584 * 2);
constexpr size_t W_D1 = W_BC + al((size_t)512 * 256 * 2);
constexpr size_t W_D3 = W_D1 + al((size_t)256 * 256 * 2);
constexpr size_t W_DC = W_D3 + al((size_t)128 * 256 * 2);
constexpr size_t O_MOD = W_DC + al((size_t)256 * 512 * 2);
constexpr size_t O_XC = O_MOD + al((size_t)4 * 2 * 6144 * 4);
constexpr size_t O_CNT = O_XC + al((size_t)CT * D * 4);
constexpr size_t O_LIST = O_CNT + al(256);
constexpr size_t O_LW = O_LIST + al((size_t)2 * NE * R * 4);
constexpr size_t O_BAR = O_LW + al((size_t)2 * NE * R * 4);
constexpr size_t O_ROUTE = O_BAR + al(16384);
constexpr size_t O_RW = O_ROUTE + al((size_t)R * 4);
constexpr size_t O_H = O_RW + al((size_t)R * 8);
constexpr size_t O_ACT = O_H + al((size_t)R * D * 2);
constexpr size_t O_MIX = O_ACT + al((size_t)ACT_ROWS * FF * 2);
constexpr size_t RB = (size_t)R * D * 2;
constexpr size_t M_XZ = O_MIX, M_GG = M_XZ + al(RB), M_XL = M_GG + al(RB), M_LA = M_XL + al(RB), M_IX = M_LA + al(2 * RB),
                 M_TMP = M_IX + al(2 * RB), M_YIN = M_TMP + al(2 * RB), M_CA = M_YIN + al(RB), M_CB = M_CA + al((size_t)2 * 260 * D * 4),
                 M_END_RG = M_CB + al((size_t)2 * 260 * D * 4);
constexpr size_t M_Y = O_MIX;
constexpr size_t M_Q = O_MIX, M_K = M_Q + al(RB), M_VT = M_K + al(RB), M_O = M_VT + al(RB);
constexpr size_t M_UT = O_MIX, M_UTC = M_UT + al((size_t)S * 2048 * 2), M_AT = M_UTC + al((size_t)CT * 2048 * 2), M_F = M_AT + al((size_t)S * 2048 * 2);

struct Job { const float* src; bf16_t* dst; int K, N, nb, tiles; long long ss, ds; };
constexpr int NJOB = 24;
struct Prm {
  const float *x, *c, *ctx, *cctx, *ada_w, *ada_b, *norm_g, *conv_w, *conv_b, *rg_ba, *rg_bi, *rg_lam, *na_qg, *na_kg, *na_rpb, *router;
  float* out; unsigned char* ws;
  Job jobs[NJOB]; int njob; int never;
};

DI int otid() { int t = threadIdx.x; asm volatile("" : "+v"(t)); return t; }
DI int obid() { int t = blockIdx.x; asm volatile("" : "+s"(t)); return t; }
DI int ogrid() { int t = gridDim.x; asm volatile("" : "+s"(t)); return t; }
DI bf16_t f2bf(float x) { unsigned u = __float_as_uint(x); u += 0x7fffu + ((u >> 16) & 1u); return (bf16_t)(u >> 16); }
DI float bf2f(bf16_t h) { return __uint_as_float(((unsigned)h) << 16); }
DI unsigned pack2(float a, float b) { unsigned r; asm("v_cvt_pk_bf16_f32 %0, %1, %2" : "=v"(r) : "v"(a), "v"(b)); return r; }
DI uint2 pack4(f32x4 v) { return make_uint2(pack2(v[0], v[1]), pack2(v[2], v[3])); }
DI void unpack4(uint2 v, float* o) { o[0] = __uint_as_float(v.x << 16); o[1] = __uint_as_float(v.x & 0xffff0000u); o[2] = __uint_as_float(v.y << 16); o[3] = __uint_as_float(v.y & 0xffff0000u); }
DI int perm8(int r) { return (r & ~31) + ((r >> 2) & 3) * 8 + ((r >> 4) & 1) * 4 + (r & 3); }
DI uint4 pack8(f32x4 a, f32x4 b) { const uint2 x = pack4(a), y = pack4(b); return make_uint4(x.x, x.y, y.x, y.y); }
DI float sigm(float v) { return __builtin_amdgcn_rcpf(1.f + __expf(-v)); }
DI float siluf(float v) { return v * __builtin_amdgcn_rcpf(1.f + __expf(-v)); }
DI float gelut(float v) { float u = 0.7978845608f * (v + 0.044715f * v * v * v); float t = 1.f - 2.f * __builtin_amdgcn_rcpf(__expf(2.f * u) + 1.f); return 0.5f * v * (1.f + t); }
DI float softplus_neg(float lam) { const float x = __expf(-lam); return x < 0.05f ? x * (1.f - x * (0.5f - x * (1.f / 3.f - 0.25f * x))) : __logf(1.f + x); }
DI void sincos_rev(float rev, float* s, float* c) { *s = __builtin_amdgcn_sinf(rev); *c = __builtin_amdgcn_cosf(rev); }
DI float wsum(float v) { for (int o = 32; o; o >>= 1) v += __shfl_xor(v, o); return v; }
DI const float* xrow_in(const Prm& p, int r) { return r < S ? p.x + (size_t)r * D : p.ctx + (size_t)(r - S) * D; }
DI float* xrow(const Prm& p, int r) { return r < S ? p.out + (size_t)r * D : (float*)(p.ws + O_XC) + (size_t)(r - S) * D; }

constexpr int NTHR = 512;
constexpr int LDSS = 72;
constexpr int SMEM_BYTES = 2 * 512 * LDSS * 2;
constexpr int CV_P0 = 1024, CV_L0_IN = 4024, CV_L0_GATES = 5024, CV_L0_OUT = 5324, CV_L0_GU = 8824, CV_L0_DN = 14824, CV_L1_QKV = 20024, CV_L1_O = 21024,
              CV_L1_MGU = 26240, CV_L1_MDN = 42240, CV_L2_GU = 45740, CV_L2_DN = 49740, CV_L3_IN = 51240, CV_L3_GATES = 51712, CV_L3_OUT = 51712, CV_TOTAL = 51712;
__shared__ Job g_jobs_s[NJOB];
#define g_jobs ((const Job*)g_jobs_s)
struct CvTile { const float* src; bf16_t* dst; int N, K, valid, pad; };
DI CvTile cv_tile(const Job* jobs, int t, int c0, int c1) {
  CvTile r; r.valid = t < c1; r.pad = 0;
  int j = 0, tt = r.valid ? t : c0;
  while (tt >= jobs[j].tiles) { tt -= jobs[j].tiles; ++j; }
  const Job jb = jobs[j];
  const int tk = jb.K >> 6, tn = jb.N >> 6, per = tk * tn;
  const int bi = tt / per, rr = tt % per, kt = rr % tk, nt = rr / tk;
  r.src = jb.src + (size_t)bi * jb.ss + (size_t)(kt * 64) * jb.N + nt * 64;
  r.dst = jb.dst + (size_t)bi * jb.ds + (size_t)(nt * 64) * jb.K + kt * 64;
  r.N = jb.N; r.K = jb.K;
  return r;
}
DI void conv_range(const Prm& p, int c0, int c1, bf16_t* smraw, int widx = -1, int wn = 0) {
  if (c0 >= c1) return;
  const int tid = otid(), G = widx < 0 ? ogrid() : wn, b = widx < 0 ? obid() : widx;
  float* smf = (float*)smraw;
  const int half = tid >> 8, vt = tid & 255;
  float* smh = smf + half * (64 * 65);
  const int kr = vt >> 4, nc = (vt & 15) * 4;
  int t0 = c0 + b * 2;
  if (t0 >= c1) { __syncthreads(); return; }
  CvTile cur = cv_tile(g_jobs, t0 + half, c0, c1);
  float4 v[4];
#pragma unroll
  for (int i = 0; i < 4; ++i) v[i] = *(const float4*)(cur.src + (size_t)(kr + 16 * i) * cur.N + nc);
  for (; t0 < c1; t0 += 2 * G) {
    const bool more = t0 + 2 * G < c1;
    CvTile nx = cur; float4 vn[4];
    if (more) {
      nx = cv_tile(g_jobs, t0 + 2 * G + half, c0, c1);
#pragma unroll
      for (int i = 0; i < 4; ++i) vn[i] = *(const float4*)(nx.src + (size_t)(kr + 16 * i) * nx.N + nc);
    }
    __syncthreads();
#pragma unroll
    for (int i = 0; i < 4; ++i) { float* d = smh + (kr + 16 * i) * 65 + nc; d[0] = v[i].x; d[1] = v[i].y; d[2] = v[i].z; d[3] = v[i].w; }
    __syncthreads();
    if (cur.valid) {
      const int n = vt >> 2, kp = (vt & 3) * 16;
      unsigned o[8];
#pragma unroll
      for (int q = 0; q < 8; ++q) o[q] = pack2(smh[(kp + 2 * q) * 65 + n], smh[(kp + 2 * q + 1) * 65 + n]);
      uint4* d4 = (uint4*)(cur.dst + (size_t)n * cur.K + kp);
      d4[0] = make_uint4(o[0], o[1], o[2], o[3]); d4[1] = make_uint4(o[4], o[5], o[6], o[7]);
    }
    if (more) {
      cur = nx;
#pragma unroll
      for (int i = 0; i < 4; ++i) v[i] = vn[i];
    }
  }
  __syncthreads();
}

template <bool NAT, int MI, int WM, int WN, class F>
DI void gemm_stream(int MT, int NT, int K, bf16_t* sm, const void* gbase, F f, const Prm* cvp = nullptr, int cv0 = 0, int cv1 = 0, int lo = 0, int hi = -1, int SUB = 1) {
  constexpr int BM = WM * MI * 16, BN = WN * 64, AR = BM / 64, BR = BN / 64, STG = (BM + BN) * LDSS;
  static_assert(WM * WN == 8, "8 waves");
  const int G = ogrid(), b = obid(), nbx = G >> 3, xcd = b & 7, li = b >> 3;
  if (hi < 0) hi = MT * NT;
  const int T = (hi - lo) * SUB;
  const int full = NT >> 3, wl = NT & 7, gsz = MT * 8;
  const int start = (int)(((long long)T * xcd) >> 3) + li, end = (int)(((long long)T * (xcd + 1)) >> 3);
  const int ntb = start < end ? (end - start + nbx - 1) / nbx : 0;
  if (ntb > 0) {
  auto tile_at = [&](int j, int& mt, int& nt) {
    const int item = start + j * nbx, idx = lo + item / SUB, sb = item % SUB, g = idx / gsz;
    if (g < full) { const int rem = idx - g * gsz; mt = rem >> 3; nt = g * 8 + (rem & 7); }
    else { const int rem = idx - full * gsz; mt = rem / wl; nt = full * 8 + rem % wl; }
    if (SUB == 8) { mt = mt * 4 + (sb >> 1); nt = nt * 2 + (sb & 1); }
  };
  const int tid = otid(), lane = tid & 63, wid = tid >> 6, wm = wid / WN, wn = wid % WN;
  const int lr = tid >> 3, lc = (tid & 7) * 8;
  const char* const gb = (const char*)gbase;
  unsigned ap[AR], bp[BR];
  auto set_offs = [&](int j) {
    int mt, nt; tile_at(j, mt, nt);
    f(mt, nt, [&](auto&& a, auto&& bfn, auto&& ep) {
#pragma unroll
      for (int i = 0; i < AR; ++i) ap[i] = (unsigned)((const char*)a(lr + 64 * i) - gb) + lc * 2;
#pragma unroll
      for (int i = 0; i < BR; ++i) bp[i] = (unsigned)((const char*)bfn(lr + 64 * i) - gb) + lc * 2;
    });
  };
  u32x4 ra[AR], rb[BR];
  f32x4 acc[MI][4];
#pragma unroll
  for (int i = 0; i < MI; ++i)
#pragma unroll
    for (int j = 0; j < 4; ++j) acc[i][j] = (f32x4){0.f, 0.f, 0.f, 0.f};
  const int nk = K / 64, Q = ntb * nk;
  const int fro = (lane & 15) * LDSS + (lane >> 4) * 8;
  set_offs(0);
#pragma unroll
  for (int i = 0; i < AR; ++i) ra[i] = *(const u32x4*)(gb + ap[i]);
#pragma unroll
  for (int i = 0; i < BR; ++i) rb[i] = *(const u32x4*)(gb + bp[i]);
#pragma unroll
  for (int i = 0; i < AR; ++i) *(u32x4*)(sm + (lr + 64 * i) * LDSS + lc) = ra[i];
#pragma unroll
  for (int i = 0; i < BR; ++i) *(u32x4*)(sm + BM * LDSS + (lr + 64 * i) * LDSS + lc) = rb[i];
#pragma unroll
  for (int i = 0; i < AR; ++i) ra[i] = *(const u32x4*)(gb + 128 + ap[i]);
#pragma unroll
  for (int i = 0; i < BR; ++i) rb[i] = *(const u32x4*)(gb + 128 + bp[i]);
  __syncthreads();
  int kt = 0, jt = 0;
  for (int q = 0; q < Q; ++q) {
    bf16_t* sA = sm + (q & 1) * STG; bf16_t* sB = sA + BM * LDSS;
    constexpr int FA = MI < 4 ? MI : 4, HG = MI / FA, NG = 2 * HG;
    bf16x8 fb[2][4], fa[2][FA];
    const bf16_t* pA = sA + (wm * MI * 16) * LDSS + fro; const bf16_t* pB = sB + (wn * 64) * LDSS + fro;
#pragma unroll
    for (int j = 0; j < 4; ++j) fb[0][j] = *(const bf16x8*)(pB + (j * 16) * LDSS);
#pragma unroll
    for (int i = 0; i < FA; ++i) fa[0][i] = *(const bf16x8*)(pA + (i * 16) * LDSS);
    __builtin_amdgcn_sched_barrier(0);
    if (q + 1 < Q) {
      bf16_t* nA = sm + ((q + 1) & 1) * STG; bf16_t* nB = nA + BM * LDSS;
#pragma unroll
      for (int i = 0; i < AR; ++i) *(u32x4*)(nA + (lr + 64 * i) * LDSS + lc) = ra[i];
#pragma unroll
      for (int i = 0; i < BR; ++i) *(u32x4*)(nB + (lr + 64 * i) * LDSS + lc) = rb[i];
    }
    if (q + 2 < Q) {
      int kt2 = kt + 2;
      if (kt2 >= nk) { kt2 -= nk; if (kt2 == 0) set_offs(jt + 1); }
      const char* gk = gb + kt2 * 128;
#pragma unroll
      for (int i = 0; i < AR; ++i) ra[i] = *(const u32x4*)(gk + ap[i]);
#pragma unroll
      for (int i = 0; i < BR; ++i) rb[i] = *(const u32x4*)(gk + bp[i]);
    }
    __builtin_amdgcn_sched_barrier(0);
    {
#pragma unroll
      for (int gi = 0; gi < NG; ++gi) {
        const int ks = gi / HG;
        if (gi + 1 < NG) {
          const int ks1 = (gi + 1) / HG, h1 = (gi + 1) % HG;
          if (ks1 != ks) {
#pragma unroll
            for (int j = 0; j < 4; ++j) fb[ks1 & 1][j] = *(const bf16x8*)(pB + (j * 16) * LDSS + ks1 * 32);
          }
#pragma unroll
          for (int i = 0; i < FA; ++i) fa[(gi + 1) & 1][i] = *(const bf16x8*)(pA + ((h1 * FA + i) * 16) * LDSS + ks1 * 32);
        }
        const int h = gi % HG;
#pragma unroll
        for (int i = 0; i < FA; ++i)
#pragma unroll
          for (int j = 0; j < 4; ++j)
            acc[h * FA + i][j] = NAT ? MFMA16(fa[gi & 1][i], fb[ks & 1][j], acc[h * FA + i][j]) : MFMA16(fb[ks & 1][j], fa[gi & 1][i], acc[h * FA + i][j]);
        __builtin_amdgcn_sched_barrier(0);
      }
    }
    if (kt == nk - 1) {
      int mt, nt; tile_at(jt, mt, nt);
      f(mt, nt, [&](auto&& a, auto&& bfn, auto&& ep) { ep(acc, wm, wn, lane); });
#pragma unroll
      for (int i = 0; i < MI; ++i)
#pragma unroll
        for (int j = 0; j < 4; ++j) acc[i][j] = (f32x4){0.f, 0.f, 0.f, 0.f};
      kt = 0; ++jt;
    } else ++kt;
    __syncthreads();
  }
  }
  if (cvp && cv0 < cv1) {
    int n_idle = 0, my_idx = -1;
#pragma unroll
    for (int x = 0; x < 8; ++x) {
      const int sx = (int)(((long long)T * x) >> 3), ex = (int)(((long long)T * (x + 1)) >> 3), rem = (ex - sx) % nbx;
      if (rem) { if (x == xcd && li >= rem) my_idx = n_idle + (li - rem); n_idle += nbx - rem; }
    }
    if (n_idle == 0) conv_range(*cvp, cv0, cv1, sm);
    else if (my_idx >= 0) conv_range(*cvp, cv0, cv1, sm, my_idx, n_idle);
  }
}

template <bool NAT, class FB, class FS>
DI void gemm_split(bool split, int MT, int NT, int K, bf16_t* sm, const void* gbase, FB fb, FS fs, const Prm* cvp = nullptr, int cv0 = 0, int cv1 = 0) {
  if (!split) { gemm_stream<NAT, 8, 2, 4>(MT, NT, K, sm, gbase, fb, cvp, cv0, cv1); return; }
  const int T = MT * NT, G = ogrid(), tfull = (T / G) * G;
  if (tfull > 0) gemm_stream<NAT, 8, 2, 4>(MT, NT, K, sm, gbase, fb, nullptr, 0, 0, 0, tfull, 1);
  if (tfull < T) gemm_stream<NAT, 1, 4, 2>(MT, NT, K, sm, gbase, fs, cvp, cv0, cv1, tfull, T, 8);
  else if (cvp && cv0 < cv1) conv_range(*cvp, cv0, cv1, sm);
}

DI int ileave(int pc, int half) { const int q = pc >> 6, w = pc & 63; return (w < 32) ? q * 32 + w : half + q * 32 + (w - 32); }
DI int ileave8(int pc, int half) { const int q = pc >> 6, w = pc & 63, c = w & 31, j = c >> 4, g = (c >> 2) & 3, e = c & 3; return (w < 32 ? 0 : half) + q * 32 + 8 * g + 4 * j + e; }

DI void phase0(const Prm& p, bf16_t* smraw) {
  const int tid = otid(), G = ogrid(), b = obid();
  float* smf = (float*)smraw;
  for (int u = b; u < 384; u += G) {
    const int l = u / 96, cg0 = (u % 96) * 64, kq = tid >> 4, cq = tid & 15;
    const float* w = p.ada_w + ((size_t)l * 1024 + kq * 32) * 6144 + cg0 + cq * 4;
    float4 a0 = make_float4(0, 0, 0, 0), a1 = a0;
#pragma unroll 8
    for (int k = 0; k < 32; ++k) {
      const float4 wv = *(const float4*)(w + (size_t)k * 6144);
      const float s0 = siluf(p.c[kq * 32 + k]), s1 = siluf(p.cctx[kq * 32 + k]);
      a0.x += s0 * wv.x; a0.y += s0 * wv.y; a0.z += s0 * wv.z; a0.w += s0 * wv.w;
      a1.x += s1 * wv.x; a1.y += s1 * wv.y; a1.z += s1 * wv.z; a1.w += s1 * wv.w;
    }
    __syncthreads();
    *(float4*)(smf + (kq * 16 + cq) * 8) = a0; *(float4*)(smf + (kq * 16 + cq) * 8 + 4) = a1;
    __syncthreads();
    if (tid < 128) {
      const int wsel = tid >> 6, col = tid & 63; float s = 0.f;
      for (int q = 0; q < 32; ++q) s += smf[(q * 16 + (col >> 2)) * 8 + wsel * 4 + (col & 3)];
      float* mod = (float*)(p.ws + O_MOD);
      mod[(size_t)(l * 2 + wsel) * 6144 + cg0 + col] = s + p.ada_b[(size_t)l * 6144 + cg0 + col];
    }
    __syncthreads();
  }
  if (b == G - 1 && tid < 64) ((int*)(p.ws + O_CNT))[tid] = 0;
  {
    const int gt = b * NTHR + tid, gn = G * NTHR;
    bf16_t* Bc = (bf16_t*)(p.ws + W_BC); bf16_t* D1 = (bf16_t*)(p.ws + W_D1); bf16_t* D3 = (bf16_t*)(p.ws + W_D3); bf16_t* Dc = (bf16_t*)(p.ws + W_DC);
    for (int e = gt; e < 512 * 256; e += gn) { const int rr = e >> 8, c = e & 255, ri = rr >> 8, m = rr & 255; float sn, cs; sincos_rev((float)((m * c) & 255) / 256.f, &sn, &cs); Bc[e] = f2bf((ri ? -sn : cs) * 0.0625f); }
    for (int e = gt; e < 256 * 256; e += gn) { const int rr = e >> 8, c = e & 255, ri = rr >> 7, k1 = rr & 127, ri2 = c >> 7, t1 = c & 127; float sn, cs; sincos_rev((float)((k1 * t1) & 127) / 128.f, &sn, &cs);
      const float v = (ri == ri2) ? cs : (ri == 0 ? sn : -sn); D1[e] = f2bf(v * 0.08838834764831845f); }
    for (int e = gt; e < 128 * 256; e += gn) { const int k2 = e >> 8, c = e & 255, ri = c >> 7, t2 = c & 127; float sn, cs; sincos_rev((float)((k2 * t2) & 127) / 128.f, &sn, &cs); D3[e] = f2bf((ri ? sn : cs) * 0.08838834764831845f); }
    for (int e = gt; e < 256 * 512; e += gn) { const int k = e >> 9, c = e & 511, ri = c >> 8, t = c & 255; float sn, cs; sincos_rev((float)((k * t) & 255) / 256.f, &sn, &cs); Dc[e] = f2bf((ri ? sn : cs) * 0.0625f); }
  }
  conv_range(p, 0, CV_P0, smraw);
}

DI void norm_phase(const Prm& p, int l, int which, int moe_idx, bf16_t* smraw, int comb_l = -1) {
  const int lane = otid() & 63, wv = obid() * 8 + (otid() >> 6), nw = ogrid() * 8;
  const float* g = p.norm_g + (size_t)(l * 2 + which) * D;
  const float* mod = (const float*)(p.ws + O_MOD);
  bf16_t* H = (bf16_t*)(p.ws + O_H);
  float* rts = (float*)smraw;
  if (moe_idx >= 0) {
    const float* rsrc = p.router + (size_t)moe_idx * D * NE;
    for (int k = otid(); k < D; k += NTHR) {
      const float4 r0 = *(const float4*)(rsrc + (size_t)k * NE), r1 = *(const float4*)(rsrc + (size_t)k * NE + 4);
      rts[0 * D + k] = r0.x; rts[1 * D + k] = r0.y; rts[2 * D + k] = r0.z; rts[3 * D + k] = r0.w;
      rts[4 * D + k] = r1.x; rts[5 * D + k] = r1.y; rts[6 * D + k] = r1.z; rts[7 * D + k] = r1.w;
    }
    __syncthreads();
  }
  f32x4 gs0[4], sv0[4];
  {
    const float* sh = mod + (size_t)(l * 2) * 6144 + (which ? 3 : 0) * D; const float* sc = mod + (size_t)(l * 2) * 6144 + (which ? 4 : 1) * D;
#pragma unroll
    for (int i = 0; i < 4; ++i) {
      const int col = i * 256 + lane * 4;
      const float4 g4 = *(const float4*)(g + col), s4 = *(const float4*)(sc + col);
      gs0[i] = (f32x4){g4.x * (1.f + s4.x), g4.y * (1.f + s4.y), g4.z * (1.f + s4.z), g4.w * (1.f + s4.w)}; sv0[i] = *(const f32x4*)(sh + col);
    }
  }
  const bf16_t* Ycmb = (const bf16_t*)(p.ws + M_Y);
  auto load_row = [&](int r, f32x4 (&dst)[4]) {
    const float* xr = (l == 0 && which == 0) ? xrow_in(p, r) : (const float*)xrow(p, r);
#pragma unroll
    for (int i = 0; i < 4; ++i) dst[i] = *(const f32x4*)(xr + i * 256 + lane * 4);
    if (comb_l >= 0) {
      const float* g5 = mod + (size_t)(comb_l * 2 + (r >= S ? 1 : 0)) * 6144 + 5 * D;
#pragma unroll
      for (int i = 0; i < 4; ++i) {
        const int col = i * 256 + lane * 4;
        const uint2 u0 = *(const uint2*)(Ycmb + (size_t)(2 * r) * D + col), u1 = *(const uint2*)(Ycmb + (size_t)(2 * r + 1) * D + col);
        float a0[4], a1[4]; unpack4(u0, a0); unpack4(u1, a1);
        const f32x4 ys = {a0[0] + a1[0], a0[1] + a1[1], a0[2] + a1[2], a0[3] + a1[3]};
        dst[i] += *(const f32x4*)(g5 + col) * ys;
      }
    }
  };
  f32x4 v[4];
  if (wv < R) load_row(wv, v);
  for (int r = wv; r < R; r += nw) {
    f32x4 vn[4];
    const bool more = r + nw < R;
    if (more) load_row(r + nw, vn);
    if (comb_l >= 0) {
      float* xw = xrow(p, r);
#pragma unroll
      for (int i = 0; i < 4; ++i) *(f32x4*)(xw + i * 256 + lane * 4) = v[i];
    }
    float ss = 0.f;
#pragma unroll
    for (int i = 0; i < 4; ++i) ss += v[i][0] * v[i][0] + v[i][1] * v[i][1] + v[i][2] * v[i][2] + v[i][3] * v[i][3];
    ss = wsum(ss);
    const float rstd = __builtin_amdgcn_rsqf(ss * (1.f / 1024.f) + 1e-6f);
    float lg[8];
#pragma unroll
    for (int e = 0; e < 8; ++e) lg[e] = 0.f;
#pragma unroll
    for (int i = 0; i < 4; ++i) {
      const int col = i * 256 + lane * 4;
      f32x4 gs = gs0[i], sv = sv0[i];
      if (r >= S) {
        const float* md = mod + (size_t)(l * 2 + 1) * 6144;
        const float4 g4 = *(const float4*)(g + col), s4 = *(const float4*)(md + (which ? 4 : 1) * D + col);
        gs = (f32x4){g4.x * (1.f + s4.x), g4.y * (1.f + s4.y), g4.z * (1.f + s4.z), g4.w * (1.f + s4.w)}; sv = *(const f32x4*)(md + (which ? 3 : 0) * D + col);
      }
      f32x4 h;
      h = v[i] * rstd * gs + sv;
      *(uint2*)(H + (size_t)r * D + col) = pack4(h);
      if (moe_idx >= 0) {
#pragma unroll
        for (int e = 0; e < 8; ++e) {
          const f32x4 rv = *(const f32x4*)(rts + e * D + col);
          lg[e] += h[0] * rv[0] + h[1] * rv[1] + h[2] * rv[2] + h[3] * rv[3];
        }
      }
    }
    if (moe_idx >= 0) {
#pragma unroll
      for (int e = 0; e < 8; ++e) lg[e] = wsum(lg[e]);
      if (lane == 0) {
        int i0 = 0; float v0 = lg[0];
#pragma unroll
        for (int e = 1; e < 8; ++e) if (lg[e] > v0) { v0 = lg[e]; i0 = e; }
        int i1 = -1; float v1 = -3.0e38f;
#pragma unroll
        for (int e = 0; e < 8; ++e) if (e != i0 && lg[e] > v1) { v1 = lg[e]; i1 = e; }
        const float w0 = 1.f / (1.f + __expf(v1 - v0)), w1 = 1.f - w0;
        ((int*)(p.ws + O_ROUTE))[r] = i0 | (i1 << 8); ((float2*)(p.ws + O_RW))[r] = make_float2(w0, w1);
      }
    }
    if (more) {
#pragma unroll
      for (int i = 0; i < 4; ++i) v[i] = vn[i];
    }
  }
}

template <int MI, int BM, int BN, class ACC>
DI void resid_epi(const Prm& p, ACC& acc, int row0, int col0, int l, int gchunk, int lane) {
  const float* mod = (const float*)(p.ws + O_MOD);
#pragma unroll
  for (int i = 0; i < MI; ++i) {
    const int row = row0 + i * 16 + (lane & 15);
    float* xr = xrow(p, row);
    const float* xs = (l == 0 && gchunk == 2) ? xrow_in(p, row) : (const float*)xr;
    const float* gt = mod + (size_t)(l * 2 + (row >= S ? 1 : 0)) * 6144 + gchunk * D;
#pragma unroll
    for (int j = 0; j < 4; ++j) {
      const int col = col0 + j * 16 + 4 * (lane >> 4);
      const float4 g4 = *(const float4*)(gt + col); float4 xv = *(const float4*)(xs + col);
      xv.x += g4.x * acc[i][j][0]; xv.y += g4.y * acc[i][j][1]; xv.z += g4.z * acc[i][j][2]; xv.w += g4.w * acc[i][j][3];
      *(float4*)(xr + col) = xv;
    }
  }
}
DI void resid_gemm(const Prm& p, const bf16_t* A, int K, const bf16_t* Wt, int l, int gchunk, bf16_t* sm, int cv0 = 0, int cv1 = 0) {
  gemm_split<false>(true, R / 256, D / 256, K, sm, p.ws,
    [&](int mt, int nt, auto&& use) {
      use([&](int r) { return A + (size_t)(mt * 256 + r) * K; },
          [&](int r) { return Wt + (size_t)(nt * 256 + r) * K; },
          [&](f32x4 (&acc)[8][4], int wm, int wn, int lane) { resid_epi<8, 256, 256>(p, acc, mt * 256 + wm * 128, nt * 256 + wn * 64, l, gchunk, lane); });
    },
    [&](int mt, int nt, auto&& use) {
      use([&](int r) { return A + (size_t)(mt * 64 + r) * K; },
          [&](int r) { return Wt + (size_t)(nt * 128 + r) * K; },
          [&](f32x4 (&acc)[1][4], int wm, int wn, int lane) { resid_epi<1, 64, 128>(p, acc, mt * 64 + wm * 16, nt * 128 + wn * 64, l, gchunk, lane); });
    }, &p, cv0, cv1);
}

template <int MI, class ACC>
DI void swiglu_epi(bf16_t* ACT, ACC& acc, int row0, int ff0, int lane) {
#pragma unroll
  for (int i = 0; i < MI; ++i) {
    const int row = row0 + i * 16 + (lane & 15), ff = ff0 + 8 * (lane >> 4);
    f32x4 o0, o1;
#pragma unroll
    for (int q = 0; q < 4; ++q) { o0[q] = siluf(acc[i][0][q]) * acc[i][2][q]; o1[q] = siluf(acc[i][1][q]) * acc[i][3][q]; }
    const uint2 w0 = pack4(o0), w1 = pack4(o1);
    *(uint4*)(ACT + (size_t)row * FF + ff) = make_uint4(w0.x, w0.y, w1.x, w1.y);
  }
}
DI void ffn_gu(const Prm& p, const bf16_t* Wt, bf16_t* sm, int cv0 = 0, int cv1 = 0) {
  const bf16_t* H = (const bf16_t*)(p.ws + O_H); bf16_t* ACT = (bf16_t*)(p.ws + O_ACT);
  gemm_split<false>(false, R / 256, 2 * FF / 256, D, sm, p.ws,
    [&](int mt, int nt, auto&& use) {
      use([&](int r) { return H + (size_t)(mt * 256 + r) * D; },
          [&](int r) { return Wt + (size_t)ileave8(nt * 256 + r, FF) * D; },
          [&](f32x4 (&acc)[8][4], int wm, int wn, int lane) { swiglu_epi<8>(ACT, acc, mt * 256 + wm * 128, (nt * 4 + wn) * 32, lane); });
    },
    [&](int mt, int nt, auto&& use) {
      use([&](int r) { return H + (size_t)(mt * 64 + r) * D; },
          [&](int r) { return Wt + (size_t)ileave8(nt * 128 + r, FF) * D; },
          [&](f32x4 (&acc)[1][4], int wm, int wn, int lane) { swiglu_epi<1>(ACT, acc, mt * 64 + wm * 16, (nt * 2 + wn) * 32, lane); });
    }, &p, cv0, cv1);
}

struct MoeMap { int ntiles; int ts1, ts2, ts3, ts4, ts5, ts6, ts7; };
DI void moe_map(const Prm& p, int moe_idx, MoeMap& m) {
  const int* cnt = (const int*)(p.ws + O_CNT) + moe_idx * 8;
  int ts = 0;
  ts += (cnt[0] + 255) >> 8; m.ts1 = ts; ts += (cnt[1] + 255) >> 8; m.ts2 = ts; ts += (cnt[2] + 255) >> 8; m.ts3 = ts; ts += (cnt[3] + 255) >> 8; m.ts4 = ts;
  ts += (cnt[4] + 255) >> 8; m.ts5 = ts; ts += (cnt[5] + 255) >> 8; m.ts6 = ts; ts += (cnt[6] + 255) >> 8; m.ts7 = ts; ts += (cnt[7] + 255) >> 8; m.ntiles = ts;
}
DI void moe_find(const Prm& p, int moe_idx, const MoeMap& m, int mt, int& e, int& lt, int& ce) {
  e = 0; int st = 0;
  if (mt >= m.ts1) { e = 1; st = m.ts1; } if (mt >= m.ts2) { e = 2; st = m.ts2; } if (mt >= m.ts3) { e = 3; st = m.ts3; } if (mt >= m.ts4) { e = 4; st = m.ts4; }
  if (mt >= m.ts5) { e = 5; st = m.ts5; } if (mt >= m.ts6) { e = 6; st = m.ts6; } if (mt >= m.ts7) { e = 7; st = m.ts7; }
  lt = mt - st; ce = ((const int*)(p.ws + O_CNT))[moe_idx * 8 + e];
}

DI void moe_route(const Prm& p, int moe_idx, bf16_t* smraw) {
  const int b = obid(), tid = otid(), e = b & 7, seg = b >> 3, nseg = ogrid() >> 3, SEG = (R + nseg - 1) / nseg;
  int* sc = (int*)smraw;
  const int* route = (const int*)(p.ws + O_ROUTE); const float2* rw = (const float2*)(p.ws + O_RW);
  int* list = (int*)(p.ws + O_LIST) + ((size_t)moe_idx * NE + e) * R; float* lw = (float*)(p.ws + O_LW) + ((size_t)moe_idx * NE + e) * R;
  const int lane = tid & 63, wid = tid >> 6;
  int c = 0;
  const int tend = min(seg * SEG, R);
  for (int t = tid; t < tend; t += 8 * NTHR) {
    int rt[8];
#pragma unroll
    for (int u = 0; u < 8; ++u) rt[u] = (t + u * NTHR < tend) ? route[t + u * NTHR] : -1;
#pragma unroll
    for (int u = 0; u < 8; ++u) c += (rt[u] >= 0) & (((rt[u] & 255) == e) | ((rt[u] >> 8) == e));
  }
  for (int o = 32; o; o >>= 1) c += __shfl_xor(c, o);
  const int t0 = seg * SEG;
  const int ta = t0 + tid, tb = t0 + NTHR + tid;
  const bool ha = tid < SEG && ta < R, hb = NTHR + tid < SEG && tb < R;
  const int ra = ha ? route[ta] : -1, rb = hb ? route[tb] : -1;
  const bool ma = ha && (((ra & 255) == e) | ((ra >> 8) == e)), mb = hb && (((rb & 255) == e) | ((rb >> 8) == e));
  const unsigned long long ba = __ballot(ma), bb = __ballot(mb);
  const unsigned long long below = (1ull << lane) - 1ull;
  __syncthreads();
  if (lane == 0) { sc[wid] = c; sc[8 + wid] = __popcll(ba); sc[16 + wid] = __popcll(bb); }
  __syncthreads();
  int base = 0, tota = 0, prea = 0, preb = 0;
#pragma unroll
  for (int w = 0; w < 8; ++w) { base += sc[w]; tota += sc[8 + w]; if (w < wid) { prea += sc[8 + w]; preb += sc[16 + w]; } }
  int totb = 0;
#pragma unroll
  for (int w = 0; w < 8; ++w) totb += sc[16 + w];
  if (ma) { const int pos = base + prea + __popcll(ba & below); const float2 w = rw[ta]; list[pos] = ta * 2 + (((ra & 255) == e) ? 0 : 1); lw[pos] = ((ra & 255) == e) ? w.x : w.y; }
  if (mb) { const int pos = base + tota + preb + __popcll(bb & below); const float2 w = rw[tb]; list[pos] = tb * 2 + (((rb & 255) == e) ? 0 : 1); lw[pos] = ((rb & 255) == e) ? w.x : w.y; }
  if (seg == nseg - 1 && tid == 0) ((int*)(p.ws + O_CNT))[moe_idx * 8 + e] = base + tota + totb;
  __syncthreads();
}
DI void moe_combine(const Prm& p, int l) {
  const bf16_t* Y = (const bf16_t*)(p.ws + M_Y); const float* mod = (const float*)(p.ws + O_MOD);
  const int gt = obid() * NTHR + otid(), gn = ogrid() * NTHR;
  for (int e = gt; e < R * 256; e += gn) {
    const int r = e >> 8, c = (e & 255) * 4;
    float* xr = xrow(p, r) + c;
    const float4 g4 = *(const float4*)(mod + (size_t)(l * 2 + (r >= S ? 1 : 0)) * 6144 + 5 * D + c);
    const uint2 u0 = *(const uint2*)(Y + (size_t)(2 * r) * D + c), u1 = *(const uint2*)(Y + (size_t)(2 * r + 1) * D + c);
    float y0[4], y1[4]; unpack4(u0, y0); unpack4(u1, y1);
    float4 xv = *(float4*)xr;
    xv.x += g4.x * (y0[0] + y1[0]); xv.y += g4.y * (y0[1] + y1[1]); xv.z += g4.z * (y0[2] + y1[2]); xv.w += g4.w * (y0[3] + y1[3]);
    *(float4*)xr = xv;
  }
}
DI void moe_gu(const Prm& p, int moe_idx, bf16_t* sm, int cv0 = 0, int cv1 = 0) {
  MoeMap m; moe_map(p, moe_idx, m);
  const bf16_t* H = (const bf16_t*)(p.ws + O_H); bf16_t* ACT = (bf16_t*)(p.ws + O_ACT);
  const int* list = (const int*)(p.ws + O_LIST) + (size_t)moe_idx * NE * R;
  gemm_split<false>(cv0 >= cv1, m.ntiles, 2 * FF / 256, D, sm, p.ws,
    [&](int mt, int nt, auto&& use) {
      int e, lt, ce; moe_find(p, moe_idx, m, mt, e, lt, ce);
      const bf16_t* Wt = (const bf16_t*)(p.ws + W_MGU) + (size_t)(moe_idx * 8 + e) * 2 * FF * D;
      const int* le = list + (size_t)e * R;
      use([&](int r) { const int idx = min(lt * 256 + r, ce - 1); return H + (size_t)(le[idx] >> 1) * D; },
          [&](int r) { return Wt + (size_t)ileave8(nt * 256 + r, FF) * D; },
          [&](f32x4 (&acc)[8][4], int wm, int wn, int lane) { swiglu_epi<8>(ACT, acc, mt * 256 + wm * 128, (nt * 4 + wn) * 32, lane); });
    },
    [&](int mt, int nt, auto&& use) {
      int e, lt, ce; moe_find(p, moe_idx, m, mt >> 2, e, lt, ce);
      const bf16_t* Wt = (const bf16_t*)(p.ws + W_MGU) + (size_t)(moe_idx * 8 + e) * 2 * FF * D;
      const int* le = list + (size_t)e * R;
      use([&](int r) { const int idx = min(lt * 256 + (mt & 3) * 64 + r, ce - 1); return H + (size_t)(le[idx] >> 1) * D; },
          [&](int r) { return Wt + (size_t)ileave8(nt * 128 + r, FF) * D; },
          [&](f32x4 (&acc)[1][4], int wm, int wn, int lane) { swiglu_epi<1>(ACT, acc, mt * 64 + wm * 16, (nt * 2 + wn) * 32, lane); });
    }, &p, cv0, cv1);
}
template <int MI, class ACC>
DI void moedown_epi(const Prm& p, int moe_idx, ACC& acc, int e, int idx0, int ce, int col0, int lane) {
  const int* list = (const int*)(p.ws + O_LIST) + (size_t)moe_idx * NE * R;
  const float* lw = (const float*)(p.ws + O_LW) + (size_t)moe_idx * NE * R;
  bf16_t* Y = (bf16_t*)(p.ws + M_Y);
#pragma unroll
  for (int i = 0; i < MI; ++i) {
    const int idx = idx0 + i * 16 + (lane & 15);
    if (idx < ce) {
      const int slot = list[(size_t)e * R + idx]; const float w = lw[(size_t)e * R + idx];
      bf16_t* yr = Y + (size_t)slot * D;
#pragma unroll
      for (int j = 0; j < 4; j += 2) {
        const int col = col0 + (j >> 1) * 32 + 8 * (lane >> 4);
        *(uint4*)(yr + col) = pack8(acc[i][j] * w, acc[i][j + 1] * w);
      }
    }
  }
}
DI void moe_down(const Prm& p, int moe_idx, int l, bf16_t* sm, int cv0 = 0, int cv1 = 0) {
  MoeMap m; moe_map(p, moe_idx, m);
  const bf16_t* ACT = (const bf16_t*)(p.ws + O_ACT);
  gemm_split<false>(cv0 >= cv1, m.ntiles, D / 256, FF, sm, p.ws,
    [&](int mt, int nt, auto&& use) {
      int e, lt, ce; moe_find(p, moe_idx, m, mt, e, lt, ce);
      const bf16_t* Wt = (const bf16_t*)(p.ws + W_MDN) + (size_t)(moe_idx * 8 + e) * D * FF;
      use([&](int r) { return ACT + (size_t)(mt * 256 + r) * FF; },
          [&](int r) { return Wt + (size_t)(nt * 256 + perm8(r)) * FF; },
          [&](f32x4 (&acc)[8][4], int wm, int wn, int lane) { moedown_epi<8>(p, moe_idx, acc, e, lt * 256 + wm * 128, ce, nt * 256 + wn * 64, lane); });
    },
    [&](int mt, int nt, auto&& use) {
      int e, lt, ce; moe_find(p, moe_idx, m, mt >> 2, e, lt, ce);
      const bf16_t* Wt = (const bf16_t*)(p.ws + W_MDN) + (size_t)(moe_idx * 8 + e) * D * FF;
      use([&](int r) { return ACT + (size_t)(mt * 64 + r) * FF; },
          [&](int r) { return Wt + (size_t)(nt * 128 + perm8(r)) * FF; },
          [&](f32x4 (&acc)[1][4], int wm, int wn, int lane) { moedown_epi<1>(p, moe_idx, acc, e, lt * 256 + (mt & 3) * 64 + wm * 16, ce, nt * 128 + wn * 64, lane); });
    }, &p, cv0, cv1);
}

template <int MI, class ACC>
DI void inproj_epi(bf16_t* XZ, bf16_t* GG, ACC& acc, int row0, int col0, int lane) {
#pragma unroll
  for (int i = 0; i < MI; ++i) {
    const int row = row0 + i * 16 + (lane & 15);
#pragma unroll
    for (int jj = 0; jj < 4; jj += 2) {
      const int col = col0 + (jj >> 1) * 32 + 8 * (lane >> 4);
      if (col0 < D) *(uint4*)(XZ + (size_t)row * D + col) = pack8(acc[i][jj], acc[i][jj + 1]);
      else { f32x4 o0, o1; for (int q = 0; q < 4; ++q) { o0[q] = gelut(acc[i][jj][q]); o1[q] = gelut(acc[i][jj + 1][q]); } *(uint4*)(GG + (size_t)row * D + col - D) = pack8(o0, o1); }
    }
  }
}
DI void rg_inproj(const Prm& p, int j, bf16_t* sm, int cv0 = 0, int cv1 = 0) {
  const bf16_t* H = (const bf16_t*)(p.ws + O_H); const bf16_t* Wt = (const bf16_t*)(p.ws + W_RGIN) + (size_t)j * 2048 * D;
  bf16_t* XZ = (bf16_t*)(p.ws + M_XZ); bf16_t* GG = (bf16_t*)(p.ws + M_GG);
  gemm_split<false>(false, R / 256, 8, D, sm, p.ws,
    [&](int mt, int nt, auto&& use) {
      use([&](int r) { return H + (size_t)(mt * 256 + r) * D; },
          [&](int r) { return Wt + (size_t)(nt * 256 + perm8(r)) * D; },
          [&](f32x4 (&acc)[8][4], int wm, int wn, int lane) { inproj_epi<8>(XZ, GG, acc, mt * 256 + wm * 128, nt * 256 + wn * 64, lane); });
    },
    [&](int mt, int nt, auto&& use) {
      use([&](int r) { return H + (size_t)(mt * 64 + r) * D; },
          [&](int r) { return Wt + (size_t)(nt * 128 + perm8(r)) * D; },
          [&](f32x4 (&acc)[1][4], int wm, int wn, int lane) { inproj_epi<1>(XZ, GG, acc, mt * 64 + wm * 16, nt * 128 + wn * 64, lane); });
    }, &p, cv0, cv1);
}
DI void rg_conv(const Prm& p, int j) {
  const bf16_t* XZ = (const bf16_t*)(p.ws + M_XZ); bf16_t* XL = (bf16_t*)(p.ws + M_XL);
  const float* cw = p.conv_w + (size_t)j * 4 * D; const float* cb = p.conv_b + (size_t)j * D;
  const int gt = obid() * NTHR + otid(), gn = ogrid() * NTHR;
  if ((gn & 127) != 0) return;
  const int c0 = (gt & 127) * 8;
  float w[4][8], bias[8];
#pragma unroll
  for (int q = 0; q < 8; ++q) bias[q] = cb[c0 + q];
#pragma unroll
  for (int t = 0; t < 4; ++t)
#pragma unroll
    for (int q = 0; q < 8; ++q) w[t][q] = cw[t * D + c0 + q];
  const u32x4 z4 = {0u, 0u, 0u, 0u};
  auto ld = [&](int e, u32x4 (&v)[4]) {
    const int row = e >> 7, lo = row < S ? 0 : S, hi = row < S ? S : R;
#pragma unroll
    for (int t = 0; t < 4; ++t) { const int rr = row + t - 2; v[t] = (rr >= lo && rr < hi) ? *(const u32x4*)(XZ + (size_t)rr * D + c0) : z4; }
  };
  auto st = [&](int e, u32x4 (&v)[4]) {
    const int row = e >> 7;
    float a[8];
#pragma unroll
    for (int q = 0; q < 8; ++q) a[q] = bias[q];
#pragma unroll
    for (int t = 0; t < 4; ++t)
#pragma unroll
      for (int q = 0; q < 4; ++q) { a[2 * q] += __uint_as_float(v[t][q] << 16) * w[t][2 * q]; a[2 * q + 1] += __uint_as_float(v[t][q] & 0xffff0000u) * w[t][2 * q + 1]; }
    *(uint4*)(XL + (size_t)row * D + c0) = make_uint4(pack2(a[0], a[1]), pack2(a[2], a[3]), pack2(a[4], a[5]), pack2(a[6], a[7]));
  };
  u32x4 v0[4], v1[4];
  int e = gt;
  if (e < R * 128) ld(e, v0);
  for (; e < R * 128; e += 2 * gn) {
    const bool m1 = e + gn < R * 128, m2 = e + 2 * gn < R * 128;
    if (m1) ld(e + gn, v1);
    st(e, v0);
    if (m2) ld(e + 2 * gn, v0);
    if (m1) st(e + gn, v1);
  }
}
template <int MI, class ACC>
DI void gates_epi(const Prm& p, int j, ACC& acc, int row0, int col0, int lane) {
  const bf16_t* XL = (const bf16_t*)(p.ws + M_XL); bf16_t* LA = (bf16_t*)(p.ws + M_LA); bf16_t* IX = (bf16_t*)(p.ws + M_IX);
  const int d = col0 >> 11, gate = (col0 >> 10) & 1, chw = col0 & 1023;
  const float* bias = (gate ? p.rg_bi : p.rg_ba) + (size_t)(j * 2 + d) * D;
  const float* lam = p.rg_lam + (size_t)(j * 2 + d) * D;
#pragma unroll
  for (int jj = 0; jj < 4; jj += 2) {
    const int ch = chw + (jj >> 1) * 32 + 8 * (lane >> 4);
    float bb[8], sp[8];
    { const float4 b0 = *(const float4*)(bias + ch), b1 = *(const float4*)(bias + ch + 4); bb[0] = b0.x; bb[1] = b0.y; bb[2] = b0.z; bb[3] = b0.w; bb[4] = b1.x; bb[5] = b1.y; bb[6] = b1.z; bb[7] = b1.w; }
    if (gate == 0) {
      const float4 l0 = *(const float4*)(lam + ch), l1 = *(const float4*)(lam + ch + 4);
      const float ll[8] = {l0.x, l0.y, l0.z, l0.w, l1.x, l1.y, l1.z, l1.w};
#pragma unroll
      for (int q = 0; q < 8; ++q) sp[q] = -8.f * softplus_neg(ll[q]);
    }
#pragma unroll
    for (int i = 0; i < MI; ++i) {
      const int row = row0 + i * 16 + (lane & 15);
      float v[8];
#pragma unroll
      for (int q = 0; q < 4; ++q) { v[q] = acc[i][jj][q]; v[4 + q] = acc[i][jj + 1][q]; }
      f32x4 o0, o1;
      if (gate == 0) {
#pragma unroll
        for (int q = 0; q < 4; ++q) { o0[q] = sp[q] * sigm(v[q] + bb[q]); o1[q] = sp[4 + q] * sigm(v[4 + q] + bb[4 + q]); }
        *(uint4*)(LA + ((size_t)d * R + row) * D + ch) = pack8(o0, o1);
      } else {
        const uint4 xv = *(const uint4*)(XL + (size_t)row * D + ch);
        float x0[4], x1[4]; unpack4(make_uint2(xv.x, xv.y), x0); unpack4(make_uint2(xv.z, xv.w), x1);
#pragma unroll
        for (int q = 0; q < 4; ++q) { o0[q] = sigm(v[q] + bb[q]) * x0[q]; o1[q] = sigm(v[4 + q] + bb[4 + q]) * x1[q]; }
        *(uint4*)(IX + ((size_t)d * R + row) * D + ch) = pack8(o0, o1);
      }
    }
  }
}
DI void rg_gates(const Prm& p, int j, bf16_t* sm, int cv0 = 0, int cv1 = 0) {
  const bf16_t* XL = (const bf16_t*)(p.ws + M_XL); const bf16_t* Wt = (const bf16_t*)(p.ws + W_GATE) + (size_t)j * 4096 * 256;
  gemm_split<false>(false, R / 256, 16, 256, sm, p.ws,
    [&](int mt, int nt, auto&& use) {
      const int nblk = ((nt * 256) & 1023) >> 8;
      use([&](int r) { return XL + (size_t)(mt * 256 + r) * D + nblk * 256; },
          [&](int r) { return Wt + (size_t)(nt * 256 + perm8(r)) * 256; },
          [&](f32x4 (&acc)[8][4], int wm, int wn, int lane) { gates_epi<8>(p, j, acc, mt * 256 + wm * 128, nt * 256 + wn * 64, lane); });
    },
    [&](int mt, int nt, auto&& use) {
      const int nblk = ((nt * 128) & 1023) >> 8;
      use([&](int r) { return XL + (size_t)(mt * 64 + r) * D + nblk * 256; },
          [&](int r) { return Wt + (size_t)(nt * 128 + perm8(r)) * 256; },
          [&](f32x4 (&acc)[1][4], int wm, int wn, int lane) { gates_epi<1>(p, j, acc, mt * 64 + wm * 16, nt * 128 + wn * 64, lane); });
    }, &p, cv0, cv1);
}
constexpr int SC = 64, NCH2 = R / SC;
DI int chunk_base(int j) { return j < S / SC ? j * SC : S + (j - S / SC) * SC; }
DI void ab_from(uint2 lav, uint2 ixv, float* a, float* b) {
  float la[4], ix[4]; unpack4(lav, la); unpack4(ixv, ix);
#pragma unroll
  for (int q = 0; q < 4; ++q) { a[q] = __expf(la[q]); b[q] = __builtin_amdgcn_sqrtf(fmaxf(1.f - a[q] * a[q], 0.f)) * ix[q]; }
}
DI void rg_scan1(const Prm& p) {
  const bf16_t* LA = (const bf16_t*)(p.ws + M_LA); const bf16_t* IX = (const bf16_t*)(p.ws + M_IX);
  float* CA = (float*)(p.ws + M_CA); float* CB = (float*)(p.ws + M_CB);
  const int gt = obid() * NTHR + otid(), gn = ogrid() * NTHR;
  for (int e = gt; e < 2 * NCH2 * 256; e += gn) {
    const int cq = e & 255, dj = e >> 8, d = dj / NCH2, j = dj % NCH2, base = chunk_base(j);
    float A[4] = {1.f, 1.f, 1.f, 1.f}, B[4] = {0.f, 0.f, 0.f, 0.f};
    const size_t off0 = ((size_t)d * R) * D + cq * 4;
    uint2 l0[8], i0[8], l1[8], i1[8];
    auto ld = [&](int s0, uint2 (&lv)[8], uint2 (&iv)[8]) {
#pragma unroll
      for (int u = 0; u < 8; ++u) { const int row = d ? base + SC - 1 - (s0 + u) : base + s0 + u; lv[u] = *(const uint2*)(LA + off0 + (size_t)row * D); iv[u] = *(const uint2*)(IX + off0 + (size_t)row * D); }
    };
    auto fold = [&](uint2 (&lv)[8], uint2 (&iv)[8]) {
#pragma unroll
      for (int u = 0; u < 8; ++u) {
        float a[4], b[4]; ab_from(lv[u], iv[u], a, b);
#pragma unroll
        for (int q = 0; q < 4; ++q) { B[q] = a[q] * B[q] + b[q]; A[q] *= a[q]; }
      }
    };
    ld(0, l0, i0);
    for (int s0 = 0; s0 < SC; s0 += 16) { ld(s0 + 8, l1, i1); fold(l0, i0); if (s0 + 16 < SC) ld(s0 + 16, l0, i0); fold(l1, i1); }
    *(float4*)(CA + (size_t)dj * D + cq * 4) = make_float4(A[0], A[1], A[2], A[3]);
    *(float4*)(CB + (size_t)dj * D + cq * 4) = make_float4(B[0], B[1], B[2], B[3]);
  }
}
DI void rg_scan2(const Prm& p) {
  const bf16_t* LA = (const bf16_t*)(p.ws + M_LA); const bf16_t* IX = (const bf16_t*)(p.ws + M_IX); const bf16_t* GG = (const bf16_t*)(p.ws + M_GG);
  const float* CA = (const float*)(p.ws + M_CA); const float* CB = (const float*)(p.ws + M_CB);
  bf16_t* TMP = (bf16_t*)(p.ws + M_TMP); bf16_t* YIN = (bf16_t*)(p.ws + M_YIN);
  const int gt = obid() * NTHR + otid(), gn = ogrid() * NTHR;
  constexpr int NL = S / SC, NC = CT / SC;
  for (int e = gt; e < NCH2 * 256; e += gn) {
    const int cq = e & 255, j = e >> 8, base = chunk_base(j);
    float hf[4] = {0.f, 0.f, 0.f, 0.f}, hb[4] = {0.f, 0.f, 0.f, 0.f};
    const int pf = j >= NL ? j - NL : j + NC;
    for (int p0 = 0; p0 < pf; p0 += 8) {
      float4 av[8], bv[8];
#pragma unroll
      for (int u = 0; u < 8; ++u) { const int pos = min(p0 + u, pf - 1); const int i = pos < NC ? NL + pos : pos - NC; av[u] = *(const float4*)(CA + (size_t)i * D + cq * 4); bv[u] = *(const float4*)(CB + (size_t)i * D + cq * 4); }
#pragma unroll
      for (int u = 0; u < 8; ++u) if (p0 + u < pf) { hf[0] = av[u].x * hf[0] + bv[u].x; hf[1] = av[u].y * hf[1] + bv[u].y; hf[2] = av[u].z * hf[2] + bv[u].z; hf[3] = av[u].w * hf[3] + bv[u].w; }
    }
    const int pb = NCH2 - 1 - j;
    for (int p0 = 0; p0 < pb; p0 += 8) {
      float4 av[8], bv[8];
#pragma unroll
      for (int u = 0; u < 8; ++u) { const int pos = min(p0 + u, pb - 1); const int i = NCH2 - 1 - pos; av[u] = *(const float4*)(CA + (size_t)(NCH2 + i) * D + cq * 4); bv[u] = *(const float4*)(CB + (size_t)(NCH2 + i) * D + cq * 4); }
#pragma unroll
      for (int u = 0; u < 8; ++u) if (p0 + u < pb) { hb[0] = av[u].x * hb[0] + bv[u].x; hb[1] = av[u].y * hb[1] + bv[u].y; hb[2] = av[u].z * hb[2] + bv[u].z; hb[3] = av[u].w * hb[3] + bv[u].w; }
    }
    const size_t c0 = (size_t)cq * 4;
    {
      uint2 l0[8], i0[8], l1[8], i1[8];
      auto ld = [&](int s0, uint2 (&lv)[8], uint2 (&iv)[8]) {
#pragma unroll
        for (int u = 0; u < 8; ++u) { const size_t ix = (size_t)(base + s0 + u) * D + c0; lv[u] = *(const uint2*)(LA + ix); iv[u] = *(const uint2*)(IX + ix); }
      };
      auto fold = [&](int s0, uint2 (&lv)[8], uint2 (&iv)[8]) {
#pragma unroll
        for (int u = 0; u < 8; ++u) {
          float a[4], b[4]; ab_from(lv[u], iv[u], a, b);
#pragma unroll
          for (int q = 0; q < 4; ++q) hf[q] = a[q] * hf[q] + b[q];
          *(uint2*)(TMP + (size_t)(base + s0 + u) * D + c0) = make_uint2(pack2(hf[0], hf[1]), pack2(hf[2], hf[3]));
        }
      };
      ld(0, l0, i0);
      for (int s0 = 0; s0 < SC; s0 += 16) { ld(s0 + 8, l1, i1); fold(s0, l0, i0); if (s0 + 16 < SC) ld(s0 + 16, l0, i0); fold(s0 + 8, l1, i1); }
    }
    {
      uint2 l0[8], i0[8], t0[8], g0[8], l1[8], i1[8], t1[8], g1[8];
      auto ld = [&](int s0, uint2 (&lv)[8], uint2 (&iv)[8], uint2 (&tv)[8], uint2 (&gv)[8]) {
#pragma unroll
        for (int u = 0; u < 8; ++u) { const size_t ix = (size_t)(base + SC - 1 - (s0 + u)) * D + c0; lv[u] = *(const uint2*)(LA + (size_t)R * D + ix); iv[u] = *(const uint2*)(IX + (size_t)R * D + ix); tv[u] = *(const uint2*)(TMP + ix); gv[u] = *(const uint2*)(GG + ix); }
      };
      auto fold = [&](int s0, uint2 (&lv)[8], uint2 (&iv)[8], uint2 (&tv)[8], uint2 (&gv)[8]) {
#pragma unroll
        for (int u = 0; u < 8; ++u) {
          float a[4], b[4], t[4], g[4]; ab_from(lv[u], iv[u], a, b); unpack4(tv[u], t); unpack4(gv[u], g);
#pragma unroll
          for (int q = 0; q < 4; ++q) hb[q] = a[q] * hb[q] + b[q];
          *(uint2*)(YIN + (size_t)(base + SC - 1 - (s0 + u)) * D + c0) = make_uint2(pack2((t[0] + hb[0]) * g[0], (t[1] + hb[1]) * g[1]), pack2((t[2] + hb[2]) * g[2], (t[3] + hb[3]) * g[3]));
        }
      };
      ld(0, l0, i0, t0, g0);
      for (int s0 = 0; s0 < SC; s0 += 16) { ld(s0 + 8, l1, i1, t1, g1); fold(s0, l0, i0, t0, g0); if (s0 + 16 < SC) ld(s0 + 16, l0, i0, t0, g0); fold(s0 + 8, l1, i1, t1, g1); }
    }
  }
}

template <int MI, class ACC>
DI void qk_epi(const Prm& p, ACC& acc, int row0, int col0, int lane) {
  bf16_t* Qb = (bf16_t*)(p.ws + M_Q); bf16_t* Kb = (bf16_t*)(p.ws + M_K);
  const bool isq = col0 < D; const float* gv = isq ? p.na_qg : p.na_kg; bf16_t* O = isq ? Qb : Kb;
  const int colb = col0 & 1023; const float osc = isq ? 0.125f : 1.f;
#pragma unroll
  for (int i = 0; i < MI; ++i) {
    const int row = row0 + i * 16 + (lane & 15);
    float ss = 0.f;
#pragma unroll
    for (int jj = 0; jj < 4; ++jj)
#pragma unroll
      for (int q = 0; q < 4; ++q) ss += acc[i][jj][q] * acc[i][jj][q];
    ss += __shfl_xor(ss, 16); ss += __shfl_xor(ss, 32);
    const float rstd = __builtin_amdgcn_rsqf(ss * (1.f / 64.f) + 1e-6f) * osc;
#pragma unroll
    for (int jj = 0; jj < 4; jj += 2) {
      const int dc = (jj >> 1) * 32 + 8 * (lane >> 4);
      const f32x4 g0 = *(const f32x4*)(gv + dc), g1 = *(const f32x4*)(gv + dc + 4);
      *(uint4*)(O + (size_t)row * D + colb + dc) = pack8(acc[i][jj] * rstd * g0, acc[i][jj + 1] * rstd * g1);
    }
  }
}
template <int MI, class ACC>
DI void v_epi(bf16_t* VT, ACC& acc, int tok0, int hd0, int lane) {
#pragma unroll
  for (int i = 0; i < MI; ++i) {
    const int tok = tok0 + i * 16 + 4 * (lane >> 4);
#pragma unroll
    for (int jj = 0; jj < 4; ++jj) {
      const int hd = hd0 + jj * 16 + (lane & 15);
      *(uint2*)(VT + (size_t)hd * R + tok) = pack4(acc[i][jj]);
    }
  }
}
DI void na_qkv(const Prm& p, bf16_t* sm, int cv0 = 0, int cv1 = 0) {
  const int cvm = cv0 + (cv1 - cv0) / 2;
  const bf16_t* H = (const bf16_t*)(p.ws + O_H); const bf16_t* Wt = (const bf16_t*)(p.ws + W_QKV);
  bf16_t* VT = (bf16_t*)(p.ws + M_VT);
  gemm_split<false>(false, R / 256, 8, D, sm, p.ws,
    [&](int mt, int nt, auto&& use) {
      use([&](int r) { return H + (size_t)(mt * 256 + r) * D; },
          [&](int r) { return Wt + (size_t)(nt * 256 + perm8(r)) * D; },
          [&](f32x4 (&acc)[8][4], int wm, int wn, int lane) { qk_epi<8>(p, acc, mt * 256 + wm * 128, nt * 256 + wn * 64, lane); });
    },
    [&](int mt, int nt, auto&& use) {
      use([&](int r) { return H + (size_t)(mt * 64 + r) * D; },
          [&](int r) { return Wt + (size_t)(nt * 128 + perm8(r)) * D; },
          [&](f32x4 (&acc)[1][4], int wm, int wn, int lane) { qk_epi<1>(p, acc, mt * 64 + wm * 16, nt * 128 + wn * 64, lane); });
    }, &p, cv0, cvm);
  gemm_split<true>(false, R / 256, 4, D, sm, p.ws,
    [&](int mt, int nt, auto&& use) {
      use([&](int r) { return H + (size_t)(mt * 256 + r) * D; },
          [&](int r) { return Wt + (size_t)(2048 + nt * 256 + r) * D; },
          [&](f32x4 (&acc)[8][4], int wm, int wn, int lane) { v_epi<8>(VT, acc, mt * 256 + wm * 128, nt * 256 + wn * 64, lane); });
    },
    [&](int mt, int nt, auto&& use) {
      use([&](int r) { return H + (size_t)(mt * 64 + r) * D; },
          [&](int r) { return Wt + (size_t)(2048 + nt * 128 + r) * D; },
          [&](f32x4 (&acc)[1][4], int wm, int wn, int lane) { v_epi<1>(VT, acc, mt * 64 + wm * 16, nt * 128 + wn * 64, lane); });
    }, &p, cvm, cv1);
}
DI void na_attn(const Prm& p, bf16_t* sm0) {
  const int tid0 = otid(), half = tid0 >> 8, tid = tid0 & 255;
  bf16_t* sm = sm0 + half * 36864;
  bf16_t* Ks = sm; bf16_t* VTs = sm + 256 * 72; float* rp = (float*)(sm + 256 * 72 + 64 * 264);
  const bf16_t* Qb = (const bf16_t*)(p.ws + M_Q); const bf16_t* Kb = (const bf16_t*)(p.ws + M_K); const bf16_t* VT = (const bf16_t*)(p.ws + M_VT);
  bf16_t* Ob = (bf16_t*)(p.ws + M_O);
  const int lane = tid & 63, w = tid >> 6, g = lane >> 4, ql = lane & 15;
  const int G = ogrid(), b = obid();
  const int nbx = G >> 3, li = b >> 3;
  {
    const int xx = b & 7;
    for (int jj = li * 2 + half; jj < 520; jj += nbx * 2) {
      const bool lat = jj < 512;
      int h, r = 0, rs = 0, qtok;
      if (lat) { const int it = xx * 512 + jj; h = it >> 8; r = it & 255; rs = min(max(r - 4, 0), 248); qtok = r * 64 + 16 * w + ql; }
      else { const int t = xx * 8 + (jj - 512); h = t >> 2; qtok = S + (t & 3) * 64 + 16 * w + ql; }
      const int qc = 16 * w + ql, cst = min(max(qc - 8, 0), 48), cs0 = min(max(16 * w - 8, 0), 32);
      bf16x8 qf[2];
#pragma unroll
      for (int ks = 0; ks < 2; ++ks) qf[ks] = *(const bf16x8*)(Qb + (size_t)qtok * D + h * 64 + ks * 32 + g * 8);
      float m_run = -1e30f, l_run = 0.f;
      f32x4 o[4];
#pragma unroll
      for (int db = 0; db < 4; ++db) o[db] = (f32x4){0.f, 0.f, 0.f, 0.f};
      __syncthreads();
      if (lat) for (int e = tid; e < 465; e += 256) rp[e] = p.na_rpb[(size_t)h * 465 + e];
      const char* const kbase = (const char*)Kb + (size_t)h * 128; const char* const vbase = (const char*)VT + (size_t)h * 64 * R * 2;
      for (int c = lat ? 0 : 2; c < 4; ++c) {
        __syncthreads();
        {
          const int nkeys = c < 2 ? 256 : 128, tok0 = c < 2 ? (rs + 4 * c) * 64 : S + (c - 2) * 128, psh = c < 2 ? 5 : 4, pmk = (1 << psh) - 1, ni = nkeys >> 5;
          u32x4 kreg[8], vreg[8];
#pragma unroll
          for (int i = 0; i < 8; ++i) if (i < ni) {
            const int ch = tid + 256 * i;
            const unsigned ko = (unsigned)((tok0 + (ch >> 3)) * D + (ch & 7) * 8) * 2u, vo = (unsigned)((ch >> psh) * R + tok0 + (ch & pmk) * 8) * 2u;
            kreg[i] = *(const u32x4*)(kbase + ko);
            vreg[i] = *(const u32x4*)(vbase + vo);
          }
#pragma unroll
          for (int i = 0; i < 8; ++i) if (i < ni) {
            const int ch = tid + 256 * i;
            *(u32x4*)(Ks + (ch >> 3) * 72 + (ch & 7) * 8) = kreg[i];
            *(u32x4*)(VTs + (ch >> psh) * 264 + (ch & pmk) * 8) = vreg[i];
          }
        }
        __syncthreads();
        f32x4 s[8];
#pragma unroll
        for (int kb = 0; kb < 8; ++kb) {
          const int kbase = c < 2 ? (kb >> 1) * 64 + cs0 + 16 * (kb & 1) : kb * 16;
          s[kb] = (f32x4){0.f, 0.f, 0.f, 0.f};
#pragma unroll
          for (int ks = 0; ks < 2; ++ks) { const bf16x8 kf = *(const bf16x8*)(Ks + (kbase + ql) * 72 + ks * 32 + g * 8); s[kb] = MFMA16(kf, qf[ks], s[kb]); }
        }
        if (c < 2) {
#pragma unroll
          for (int kb = 0; kb < 8; ++kb) {
            const int krow = rs + 4 * c + (kb >> 1), rbi = krow - r + 7;
#pragma unroll
            for (int q = 0; q < 4; ++q) {
              const int kc = cs0 + 16 * (kb & 1) + 4 * g + q;
              const bool valid = (kc >= cst) && (kc < cst + 16);
              const int cbi = min(max(kc - qc + 15, 0), 30);
              s[kb][q] = valid ? s[kb][q] + rp[rbi * 31 + cbi] : -1e30f;
            }
          }
        }
        float mx = -1e30f;
#pragma unroll
        for (int kb = 0; kb < 8; ++kb)
#pragma unroll
          for (int q = 0; q < 4; ++q) mx = fmaxf(mx, s[kb][q]);
        mx = fmaxf(mx, __shfl_xor(mx, 16)); mx = fmaxf(mx, __shfl_xor(mx, 32));
        const float m_new = fmaxf(m_run, mx), alpha = __expf(m_run - m_new);
        float ls = 0.f;
#pragma unroll
        for (int kb = 0; kb < 8; ++kb)
#pragma unroll
          for (int q = 0; q < 4; ++q) { s[kb][q] = __expf(s[kb][q] - m_new); ls += s[kb][q]; }
        l_run = l_run * alpha + ls; m_run = m_new;
#pragma unroll
        for (int db = 0; db < 4; ++db) { o[db][0] *= alpha; o[db][1] *= alpha; o[db][2] *= alpha; o[db][3] *= alpha; }
#pragma unroll
        for (int t = 0; t < 4; ++t) {
          const int kb0 = c < 2 ? ((2 * t) >> 1) * 64 + cs0 : (2 * t) * 16, kb1 = c < 2 ? kb0 + 16 : kb0 + 16;
          const uint2 p0 = pack4(s[2 * t]), p1 = pack4(s[2 * t + 1]);
          const uint4 pu = make_uint4(p0.x, p0.y, p1.x, p1.y);
          const bf16x8 pf = __builtin_bit_cast(bf16x8, pu);
#pragma unroll
          for (int db = 0; db < 4; ++db) {
            const s16x4 v0 = *(const s16x4*)(VTs + (db * 16 + ql) * 264 + kb0 + 4 * g), v1 = *(const s16x4*)(VTs + (db * 16 + ql) * 264 + kb1 + 4 * g);
            const bf16x8 vf = __builtin_shufflevector(v0, v1, 0, 1, 2, 3, 4, 5, 6, 7);
            o[db] = MFMA16(vf, pf, o[db]);
          }
        }
      }
      l_run += __shfl_xor(l_run, 16); l_run += __shfl_xor(l_run, 32);
      const float inv = 1.f / l_run;
#pragma unroll
      for (int db = 0; db < 4; ++db) { f32x4 v = o[db]; v[0] *= inv; v[1] *= inv; v[2] *= inv; v[3] *= inv; *(uint2*)(Ob + (size_t)qtok * D + h * 64 + db * 16 + 4 * g) = pack4(v); }
    }
  }
}

DI void ft_chan(const Prm& p, bf16_t* sm) {
  const bf16_t* H = (const bf16_t*)(p.ws + O_H); const bf16_t* Bc = (const bf16_t*)(p.ws + W_BC);
  bf16_t* UT = (bf16_t*)(p.ws + M_UT); bf16_t* UTC = (bf16_t*)(p.ws + M_UTC);
  gemm_stream<true, 4, 2, 4>(130, 8, 256, sm, p.ws, [&](int mt, int nt, auto&& use) {
    const int grp = nt >> 1;
    use(
        [&](int r0) { const int r = perm8(r0); const int tok = mt < 128 ? 128 * r + mt : S + (mt - 128) * 128 + r; return H + (size_t)tok * D + grp * 256; },
        [&](int r) { return Bc + (size_t)((nt & 1) * 256 + r) * 256; },
        [&](f32x4 (&acc)[4][4], int wm, int wn, int lane) {
#pragma unroll
          for (int i = 0; i < 4; i += 2) {
            const int tr = wm * 64 + (i >> 1) * 32 + 8 * (lane >> 4);
#pragma unroll
            for (int jj = 0; jj < 4; ++jj) {
              const int cc = (nt & 1) * 256 + wn * 64 + jj * 16 + (lane & 15), ri = cc >> 8, ch = grp * 256 + (cc & 255);
              const uint4 w = pack8(acc[i][jj], acc[i + 1][jj]);
              if (mt < 128) *(uint4*)(UT + (((size_t)mt * D + ch) * 2 + ri) * 128 + tr) = w;
              else *(uint4*)(UTC + ((size_t)ch * 2 + ri) * 256 + (mt - 128) * 128 + tr) = w;
            }
          }
        });
  });
}
DI void ft_step1(const Prm& p, bf16_t* sm) {
  const bf16_t* UT = (const bf16_t*)(p.ws + M_UT); const bf16_t* UTC = (const bf16_t*)(p.ws + M_UTC);
  const bf16_t* D1 = (const bf16_t*)(p.ws + W_D1); const bf16_t* Dc = (const bf16_t*)(p.ws + W_DC);
  bf16_t* AT = (bf16_t*)(p.ws + M_AT); bf16_t* F = (bf16_t*)(p.ws + M_F);
  gemm_stream<true, 4, 2, 4>(1024, 1, 256, sm, p.ws, [&](int mt, int nt, auto&& use) {
    const int ch = mt;
    use(
        [&](int r) { return UT + ((size_t)perm8(r) * D + ch) * 256; },
        [&](int r) { return D1 + (size_t)ileave(r, 128) * 256; },
        [&](f32x4 (&acc)[4][4], int wm, int wn, int lane) {
#pragma unroll
          for (int i = 0; i < 4; i += 2) {
            const int t2 = wm * 64 + (i >> 1) * 32 + 8 * (lane >> 4);
#pragma unroll
            for (int jj = 0; jj < 2; ++jj) {
              const int k1 = wn * 32 + jj * 16 + (lane & 15);
              f32x4 orr[2], oi[2];
#pragma unroll
              for (int u = 0; u < 2; ++u)
#pragma unroll
                for (int q = 0; q < 4; ++q) {
                  float st, ct; sincos_rev((float)(k1 * (t2 + 4 * u + q)) * (1.f / 16384.f), &st, &ct);
                  const float ar = acc[i + u][jj][q], ai = acc[i + u][jj + 2][q];
                  orr[u][q] = ar * ct + ai * st; oi[u][q] = ai * ct - ar * st;
                }
              *(uint4*)(AT + (((size_t)k1 * D + ch) * 2 + 0) * 128 + t2) = pack8(orr[0], orr[1]);
              *(uint4*)(AT + (((size_t)k1 * D + ch) * 2 + 1) * 128 + t2) = pack8(oi[0], oi[1]);
            }
          }
        });
  });
  gemm_stream<true, 4, 2, 4>(8, 1, 512, sm, p.ws, [&](int mt, int nt, auto&& use) {
    const int ch0 = mt * 128;
    use(
        [&](int r) { return UTC + (size_t)(ch0 + perm8(r)) * 512; },
        [&](int r) { return Dc + (size_t)r * 512; },
        [&](f32x4 (&acc)[4][4], int wm, int wn, int lane) {
#pragma unroll
          for (int i = 0; i < 4; i += 2) {
            const int ch = ch0 + wm * 64 + (i >> 1) * 32 + 8 * (lane >> 4);
#pragma unroll
            for (int jj = 0; jj < 4; ++jj) {
              const int k = wn * 64 + jj * 16 + (lane & 15);
              *(uint4*)(F + (size_t)(S + k) * D + ch) = pack8(acc[i][jj], acc[i + 1][jj]);
            }
          }
        });
  });
}
DI void ft_step3(const Prm& p, bf16_t* sm) {
  const bf16_t* AT = (const bf16_t*)(p.ws + M_AT); const bf16_t* D3 = (const bf16_t*)(p.ws + W_D3); bf16_t* F = (bf16_t*)(p.ws + M_F);
  gemm_stream<true, 4, 4, 2>(512, 1, 256, sm, p.ws, [&](int mt, int nt, auto&& use) {
    const int k1 = mt >> 2, ch0 = (mt & 3) * 256;
    use(
        [&](int r) { return AT + ((size_t)k1 * D + ch0 + perm8(r)) * 256; },
        [&](int r) { return D3 + (size_t)r * 256; },
        [&](f32x4 (&acc)[4][4], int wm, int wn, int lane) {
#pragma unroll
          for (int i = 0; i < 4; i += 2) {
            const int ch = ch0 + wm * 64 + (i >> 1) * 32 + 8 * (lane >> 4);
#pragma unroll
            for (int jj = 0; jj < 4; ++jj) {
              const int k2 = wn * 64 + jj * 16 + (lane & 15);
              *(uint4*)(F + (size_t)(128 * k2 + k1) * D + ch) = pack8(acc[i][jj], acc[i + 1][jj]);
            }
          }
        });
  });
}

#define XB_TMO      128
#define XB_XCNT(j)  (256  + 64 * (j))
#define XB_XSUB(j)  (1280 + 64 * (j))
#define XB_XGEN(j)  (2304 + 64 * (j))
#define XB_TOP      3328
#define XB_TOPGEN   3392
#define XCD_BAR_WORDS 3456
#define XB_SPIN_CAP (1u << 18)
#define LAS __attribute__((address_space(3)))

__device__ __forceinline__ unsigned xb_ld(unsigned* p)              { return __hip_atomic_load(p, __ATOMIC_RELAXED, __HIP_MEMORY_SCOPE_AGENT); }
__device__ __forceinline__ unsigned xb_add(unsigned* p, unsigned v) { return __hip_atomic_fetch_add(p, v, __ATOMIC_RELAXED, __HIP_MEMORY_SCOPE_AGENT); }
__device__ __forceinline__ unsigned xb_xcc_id() { return (unsigned)__builtin_amdgcn_s_getreg((3 << 11) | 20) & 0xFu; }
#define XB_SPIN(cond, bar) do { unsigned _sp = 0; while (cond) { __builtin_amdgcn_s_sleep(1); \
    if ((++_sp & 255u) == 0u) { if (xb_ld(&(bar)[XB_TMO])) break; if (_sp > XB_SPIN_CAP) { atomicAdd(&(bar)[XB_TMO], 1u); break; } } } } while (0)

struct XcdBarrier {
    unsigned* bar; unsigned x;
    volatile LAS unsigned* st;
};

__device__ __forceinline__ XcdBarrier xcd_barrier_post(unsigned* bar, volatile LAS unsigned* st) {
    XcdBarrier b; b.bar = bar; b.x = xb_xcc_id(); b.st = st;
    if (threadIdx.x == 0) (void)xb_add(&bar[XB_XCNT(b.x)], 1u);
    return b;
}
__device__ __forceinline__ void xcd_barrier_complete(unsigned* bar, unsigned x, unsigned& nloc, unsigned& nx) {
    const unsigned G = gridDim.x * gridDim.y * gridDim.z;
    unsigned sum, cnt, mine, sp = 0u;
    for (;;) {
        sum = 0u; cnt = 0u; mine = 0u;
#pragma unroll
        for (unsigned j = 0; j < 16; ++j) { const unsigned c = xb_ld(&bar[XB_XCNT(j)]); sum += c; cnt += (c > 0u) ? 1u : 0u; mine = (j == x) ? c : mine; }
        if (sum == G) break;
        __builtin_amdgcn_s_sleep(1);
        if ((++sp & 255u) == 0u) { if (xb_ld(&bar[XB_TMO])) break; if (sp > XB_SPIN_CAP) { atomicAdd(&bar[XB_TMO], 1u); break; } }
    }
    nloc = mine > 0u ? mine : 1u; nx = cnt > 0u ? cnt : 1u;
}

__device__ __forceinline__ void xcd_barrier(const XcdBarrier& b) {
    asm volatile("s_waitcnt vmcnt(0)" ::: "memory");
    __syncthreads();
    if (threadIdx.x == 0) {
        unsigned* bar = b.bar;
        __builtin_amdgcn_s_waitcnt(0);
        unsigned nloc = b.st[0], nx = b.st[1];
        if (nloc == 0u) { xcd_barrier_complete(bar, b.x, nloc, nx); b.st[0] = nloc; b.st[1] = nx; }
        const unsigned old = xb_add(&bar[XB_XSUB(b.x)], 1u);
        const unsigned gen = old / nloc;
        if (old + 1u == (gen + 1u) * nloc) {
            __builtin_amdgcn_fence(__ATOMIC_RELEASE, "agent");
            asm volatile("s_waitcnt vmcnt(0)" ::: "memory");
            const unsigned og = xb_add(&bar[XB_TOP], 1u);
            const unsigned tg = og / nx;
            if (og + 1u == (tg + 1u) * nx) xb_add(&bar[XB_TOPGEN], 1u);
            else XB_SPIN(xb_ld(&bar[XB_TOPGEN]) == tg, bar);
            __builtin_amdgcn_fence(__ATOMIC_ACQUIRE, "agent");
            xb_add(&bar[XB_XGEN(b.x)], 1u);
            asm volatile("s_waitcnt vmcnt(0)" ::: "memory");
        } else {
            XB_SPIN(xb_ld(&bar[XB_XGEN(b.x)]) == gen, bar);
            __builtin_amdgcn_fence(__ATOMIC_ACQUIRE, "agent");
            asm volatile("s_waitcnt vmcnt(0)" ::: "memory");
        }
    }
    __syncthreads();
}


__global__ void __launch_bounds__(512) fwd_megakernel(Prm p) {
  __shared__ __attribute__((aligned(16))) unsigned char smem_raw[SMEM_BYTES];
  bf16_t* sm = (bf16_t*)smem_raw;
  __shared__ uint4 xb_words;
  if (threadIdx.x == 0) {
    xb_words = make_uint4(0u, 0u, 0u, 0u);
#pragma unroll
    for (int j = 0; j < NJOB; ++j) g_jobs_s[j] = p.jobs[j];
  }
  __syncthreads();
  XcdBarrier xb = xcd_barrier_post((unsigned*)(p.ws + O_BAR), (volatile LAS unsigned*)&xb_words);
  if (p.never) { cg::grid_group grid = cg::this_grid(); grid.sync(); }
#define GSYNC() do { for (int rs_ = 0; rs_ < REP_SYNC; ++rs_) xcd_barrier(xb); } while (0)
#define WITH_CONV(c0, c1, call) do { const bool cf_ = ((obid() >> 3) & 1) == 0; if (cf_) conv_range(p, (c0), (c1), sm); call; if (!cf_) conv_range(p, (c0), (c1), sm); } while (0)
  phase0(p, sm); GSYNC();
  int rg_j = 0, dense_j = 0, moe_j = 0;
  for (int l = 0; l < 4; ++l) {
    norm_phase(p, l, 0, -1, sm, l == 2 ? 1 : -1); GSYNC();
    const int kind = l % 3;
    if (kind == 0) {
      const int c0 = l == 0 ? CV_P0 : CV_L2_DN, c1 = l == 0 ? CV_L0_IN : CV_L3_IN, c2 = l == 0 ? CV_L0_GATES : CV_L3_GATES, c3 = l == 0 ? CV_L0_OUT : CV_L3_OUT;
      for (int q_ = 0; q_ < REP_OG; ++q_) { rg_inproj(p, rg_j, sm, c0, c1); GSYNC(); }
      for (int q_ = 0; q_ < REP_ATT; ++q_) { rg_conv(p, rg_j); GSYNC(); }
      for (int q_ = 0; q_ < REP_OG; ++q_) { rg_gates(p, rg_j, sm, c1, c2); GSYNC(); }
      for (int q_ = 0; q_ < REP_SCAN; ++q_) { rg_scan1(p); GSYNC(); rg_scan2(p); GSYNC(); }
      resid_gemm(p, (const bf16_t*)(p.ws + M_YIN), D, (const bf16_t*)(p.ws + W_RGOUT) + (size_t)rg_j * D * D, l, 2, sm, c2, c3);
      ++rg_j;
    } else if (kind == 1) {
      for (int q_ = 0; q_ < REP_OG; ++q_) { na_qkv(p, sm, CV_L0_DN, CV_L1_QKV); GSYNC(); }
      for (int q_ = 0; q_ < REP_ATT; ++q_) { na_attn(p, sm); GSYNC(); }
      resid_gemm(p, (const bf16_t*)(p.ws + M_O), D, (const bf16_t*)(p.ws + W_O), l, 2, sm, CV_L1_QKV, CV_L1_O);
    } else {
      for (int q_ = 0; q_ < REP_OG; ++q_) { ft_chan(p, sm); GSYNC(); ft_step1(p, sm); GSYNC(); ft_step3(p, sm); GSYNC(); }
      resid_gemm(p, (const bf16_t*)(p.ws + M_F), D, (const bf16_t*)(p.ws + W_FT), l, 2, sm);
    }
    GSYNC();
    const bool moe = (l & 1);
    norm_phase(p, l, 1, moe ? moe_j : -1, sm); GSYNC();
    if (!moe) {
      const int c0 = l == 0 ? CV_L0_OUT : CV_L1_MDN, c1 = l == 0 ? CV_L0_GU : CV_L2_GU, c2 = l == 0 ? CV_L0_DN : CV_L2_DN;
      ffn_gu(p, (const bf16_t*)(p.ws + W_FGU) + (size_t)dense_j * 2 * FF * D, sm, c0, c1); GSYNC();
      resid_gemm(p, (const bf16_t*)(p.ws + O_ACT), FF, (const bf16_t*)(p.ws + W_FDN) + (size_t)dense_j * D * FF, l, 5, sm, c1, c2);
      ++dense_j;
    } else {
      for (int q_ = 0; q_ < REP_ATT; ++q_) { moe_route(p, moe_j, sm); GSYNC(); }
      if (l == 1) moe_gu(p, moe_j, sm, CV_L1_O, CV_L1_MGU); else moe_gu(p, moe_j, sm);
      GSYNC();
      for (int q_ = 0; q_ < REP_MDN; ++q_) { if (l == 1) moe_down(p, moe_j, l, sm, CV_L1_MGU, CV_L1_MDN); else moe_down(p, moe_j, l, sm);
      GSYNC(); }
      if (l == 3) moe_combine(p, l);
      ++moe_j;
    }
    if (l < 3 && l != 1) GSYNC();
  }
}

static void add_job(Prm& p, const float* src, size_t dst_off, int K, int N, int nb, long long ss, long long ds) {
  Job& j = p.jobs[p.njob++];
  j.src = src; j.dst = (bf16_t*)(p.ws + dst_off); j.K = K; j.N = N; j.nb = nb; j.tiles = (K / 64) * (N / 64) * nb; j.ss = ss; j.ds = ds;
}

extern "C" void kernel_launch(void* const* d_in, const int* in_sizes, int n_in, void* d_out, int out_size, void* d_ws, size_t ws_size, hipStream_t stream) {
  static int grid_blocks = 0;
  if (!grid_blocks) {
    int dev = 0, cus = 0, per_cu = 0;
    hipGetDevice(&dev);
    hipDeviceGetAttribute(&cus, hipDeviceAttributeMultiprocessorCount, dev);
    hipOccupancyMaxActiveBlocksPerMultiprocessor(&per_cu, fwd_megakernel, NTHR, 0);
    if (per_cu < 1) per_cu = 1;
    if (per_cu > 1) per_cu = 1;
    grid_blocks = (cus * per_cu) & ~7;
  }
  Prm p; memset(&p, 0, sizeof(p));
  const float* const* in = (const float* const*)d_in;
  p.x = in[0]; p.c = in[1]; p.ctx = in[2]; p.cctx = in[3]; p.ada_w = in[4]; p.ada_b = in[5]; p.norm_g = in[6];
  p.conv_w = in[8]; p.conv_b = in[9]; p.rg_ba = in[11]; p.rg_bi = in[13]; p.rg_lam = in[14];
  p.na_qg = in[17]; p.na_kg = in[18]; p.na_rpb = in[19]; p.router = in[24];
  p.out = (float*)d_out; p.ws = (unsigned char*)d_ws;
  p.njob = 0;
  const long long GU = (long long)1024 * 7168, DN = (long long)3584 * 1024, SQ = (long long)1024 * 1024;
  auto gates = [&](int j) {
    for (int d = 0; d < 2; ++d) {
      const int jd = j * 2 + d;
      add_job(p, in[10] + (size_t)jd * 4 * 65536, W_GATE + ((size_t)(jd * 2 + 0) * 4 * 65536) * 2, 256, 256, 4, 65536, 65536);
      add_job(p, in[12] + (size_t)jd * 4 * 65536, W_GATE + ((size_t)(jd * 2 + 1) * 4 * 65536) * 2, 256, 256, 4, 65536, 65536);
    }
  };
  add_job(p, in[7], W_RGIN, 1024, 2048, 1, 0, 0); gates(0); add_job(p, in[15], W_RGOUT, 1024, 1024, 1, 0, 0);
  add_job(p, in[22], W_FGU, 1024, 7168, 1, 0, 0); add_job(p, in[23], W_FDN, 3584, 1024, 1, 0, 0);
  add_job(p, in[16], W_QKV, 1024, 3072, 1, 0, 0); add_job(p, in[20], W_O, 1024, 1024, 1, 0, 0);
  add_job(p, in[25], W_MGU, 1024, 7168, 8, GU, GU); add_job(p, in[26], W_MDN, 3584, 1024, 8, DN, DN);
  add_job(p, in[21], W_FT, 1024, 1024, 1, 0, 0);
  add_job(p, in[22] + GU, W_FGU + (size_t)GU * 2, 1024, 7168, 1, 0, 0); add_job(p, in[23] + DN, W_FDN + (size_t)DN * 2, 3584, 1024, 1, 0, 0);
  add_job(p, in[7] + 2 * SQ, W_RGIN + (size_t)2 * SQ * 2, 1024, 2048, 1, 0, 0); gates(1); add_job(p, in[15] + SQ, W_RGOUT + (size_t)SQ * 2, 1024, 1024, 1, 0, 0);
  add_job(p, in[25] + 8 * GU, W_MGU + (size_t)8 * GU * 2, 1024, 7168, 8, GU, GU); add_job(p, in[26] + 8 * DN, W_MDN + (size_t)8 * DN * 2, 3584, 1024, 8, DN, DN);
  {
    int tot = 0; for (int j = 0; j < p.njob; ++j) tot += p.jobs[j].tiles;
    if (tot != CV_TOTAL) fprintf(stderr, "conversion tile count %d != %d\n", tot, CV_TOTAL);
  }
  (void)hipMemsetAsync((unsigned char*)d_ws + O_BAR, 0, XCD_BAR_WORDS * 4, stream);
  void* args[] = {&p};
  hipError_t e = hipLaunchCooperativeKernel((void*)fwd_megakernel, dim3(grid_blocks), dim3(NTHR), args, 0, stream);
  if (e != hipSuccess) fprintf(stderr, "cooperative launch failed: %s (grid %d)\n", hipGetErrorString(e), grid_blocks);
}
```
